# Optimizing an MI355X kernel written in HIP

```python
import math
import jax, jax.numpy as jnp
from jax import lax
import numpy as np

D_MODEL = 4096
BATCH = 4
SEQ = 2048
DEPTH = 2

D_SSM = D_MODEL // 2
D_RET = D_MODEL // 2
D_MIX = D_SSM + D_RET
SSM_GROUP = 16
N_SSM_GROUPS = D_SSM // SSM_GROUP
SSM_STATE = 64
RET_HEADS = 8
RET_HEAD_DIM = D_RET // RET_HEADS
RET_CHUNK = 128
ROPE_BASE = 10000.0
EPS = 1e-6
DT_MIN = 0.001
DT_MAX = 0.1
D_IN_PROJ = 2 * D_SSM + 4 * D_RET

kernel_name = "hymba_s5_retnet_hybrid"


def rmsnorm(x, w):
    xf = x.astype(jnp.float32)
    y = xf * lax.rsqrt(jnp.mean(xf * xf, axis=-1, keepdims=True) + EPS)
    return (y * w.astype(jnp.float32)).astype(x.dtype)


def s5_mixer(u, lam_re, lam_im, b_re, b_im, c_re, c_im, d_skip, log_dt, w_glu, b_glu):
    f32 = jnp.float32
    bsz, seq, _ = u.shape
    ug = u.astype(f32).reshape(bsz, seq, N_SSM_GROUPS, SSM_GROUP)
    lr = lam_re.astype(f32)
    li = lam_im.astype(f32)
    dt = jnp.exp(log_dt.astype(f32))[:, None]
    mag = jnp.exp(lr * dt)
    ab_re = mag * jnp.cos(li * dt)
    ab_im = mag * jnp.sin(li * dt)
    num_re = ab_re - 1.0
    num_im = ab_im
    den = lr * lr + li * li
    co_re = (num_re * lr + num_im * li) / den
    co_im = (num_im * lr - num_re * li) / den
    br = b_re.astype(f32)
    bi = b_im.astype(f32)
    bb_re = co_re[..., None] * br - co_im[..., None] * bi
    bb_im = co_re[..., None] * bi + co_im[..., None] * br
    bu_re = jnp.einsum('blgh,gnh->blgn', ug, bb_re)
    bu_im = jnp.einsum('blgh,gnh->blgn', ug, bb_im)
    a_re = jnp.broadcast_to(ab_re, (1, seq) + ab_re.shape)
    a_im = jnp.broadcast_to(ab_im, (1, seq) + ab_im.shape)

    def combine(e1, e2):
        a1r, a1i, b1r, b1i = e1
        a2r, a2i, b2r, b2i = e2
        return (a2r * a1r - a2i * a1i,
                a2r * a1i + a2i * a1r,
                a2r * b1r - a2i * b1i + b2r,
                a2r * b1i + a2i * b1r + b2i)

    _, _, s_re, s_im = lax.associative_scan(combine, (a_re, a_im, bu_re, bu_im), axis=1)
    y = (jnp.einsum('blgn,ghn->blgh', s_re, c_re.astype(f32))
         - jnp.einsum('blgn,ghn->blgh', s_im, c_im.astype(f32))
         + d_skip.astype(f32).reshape(N_SSM_GROUPS, SSM_GROUP) * ug)
    y = jax.nn.gelu(y.reshape(bsz, seq, D_SSM))
    y = y * jax.nn.sigmoid(y @ w_glu.astype(f32) + b_glu.astype(f32))
    return y


def rope(t, cos, sin):
    half = t.shape[-1] // 2
    t1, t2 = t[..., :half], t[..., half:]
    return jnp.concatenate([t1 * cos - t2 * sin, t2 * cos + t1 * sin], axis=-1)


def retention_mixer(q, k, v):
    f32 = jnp.float32
    bsz, seq, _ = q.shape
    nc = seq // RET_CHUNK

    def heads(t):
        return t.astype(f32).reshape(bsz, seq, RET_HEADS, RET_HEAD_DIM).transpose(0, 2, 1, 3)

    q, k, v = heads(q), heads(k), heads(v)
    pos = jnp.arange(seq, dtype=f32)
    inv_freq = ROPE_BASE ** (-jnp.arange(0, RET_HEAD_DIM, 2, dtype=f32) / RET_HEAD_DIM)
    ang = pos[:, None] * inv_freq[None, :]
    cos, sin = jnp.cos(ang), jnp.sin(ang)
    q = rope(q, cos, sin)
    k = rope(k, cos, sin) * (RET_HEAD_DIM ** -0.5)
    log_gamma = jnp.log1p(-jnp.power(2.0, -5.0 - jnp.arange(RET_HEADS, dtype=f32)))

    qc = q.reshape(bsz, RET_HEADS, nc, RET_CHUNK, RET_HEAD_DIM)
    kc = k.reshape(bsz, RET_HEADS, nc, RET_CHUNK, RET_HEAD_DIM)
    vc = v.reshape(bsz, RET_HEADS, nc, RET_CHUNK, RET_HEAD_DIM)
    idx = jnp.arange(RET_CHUNK, dtype=f32)
    rel = idx[:, None] - idx[None, :]
    causal = rel >= 0
    decay_in = jnp.where(causal[None],
                         jnp.exp(jnp.where(causal, rel, 0.0)[None] * log_gamma[:, None, None]),
                         0.0)
    scores = jnp.einsum('bhnid,bhnjd->bhnij', qc, kc) * decay_in[None, :, None]
    out_intra = jnp.einsum('bhnij,bhnje->bhnie', scores, vc)
    zeta = jnp.exp((RET_CHUNK - 1.0 - idx)[None, :] * log_gamma[:, None])
    u_chunk = jnp.einsum('bhnjd,bhnje,hj->bhnde', kc, vc, zeta)
    gamma_c = jnp.exp(RET_CHUNK * log_gamma)

    def step(r, u_i):
        return r * gamma_c[None, :, None, None] + u_i, r

    r0 = jnp.zeros((bsz, RET_HEADS, RET_HEAD_DIM, RET_HEAD_DIM), f32)
    _, r_prev = lax.scan(step, r0, jnp.moveaxis(u_chunk, 2, 0))
    xi = jnp.exp((idx + 1.0)[None, :] * log_gamma[:, None])
    out_cross = jnp.einsum('bhnid,nbhde->bhnie', qc, r_prev) * xi[None, :, None, :, None]
    out = (out_intra + out_cross).reshape(bsz, RET_HEADS, seq, RET_HEAD_DIM)
    out = out * lax.rsqrt(jnp.mean(out * out, axis=-1, keepdims=True) + EPS)
    return out.transpose(0, 2, 1, 3).reshape(bsz, seq, D_RET)


def hybrid_layer(x, norm_w, w_in, lam_re, lam_im, b_re, b_im, c_re, c_im, d_skip,
                 log_dt, w_glu, b_glu, ssm_norm_w, ret_norm_w, w_out):
    f32 = jnp.float32
    h = rmsnorm(x, norm_w)
    proj = h @ w_in
    o1 = D_SSM
    o2 = o1 + D_SSM
    o3 = o2 + D_RET
    o4 = o3 + D_RET
    o5 = o4 + D_RET
    u, g_ssm, q, k, v, g_ret = (proj[..., :o1], proj[..., o1:o2], proj[..., o2:o3],
                                proj[..., o3:o4], proj[..., o4:o5], proj[..., o5:])
    y_ssm = s5_mixer(u, lam_re, lam_im, b_re, b_im, c_re, c_im, d_skip, log_dt, w_glu, b_glu)
    y_ssm = rmsnorm(y_ssm, ssm_norm_w) * jax.nn.silu(g_ssm.astype(f32))
    y_ret = retention_mixer(q, k, v) * ret_norm_w.astype(f32) * jax.nn.silu(g_ret.astype(f32))
    y = jnp.concatenate([y_ssm, y_ret], axis=-1).astype(x.dtype)
    return x + y @ w_out


def setup_inputs(seed: int = 0) -> dict:
    key = jax.random.key(seed)
    ks = jax.random.split(key, 20)
    f32 = jnp.float32
    G, N, H = N_SSM_GROUPS, SSM_STATE, SSM_GROUP
    x = jax.random.normal(ks[0], (BATCH, SEQ, D_MODEL), f32)
    norm_w = 1.0 + 0.02 * jax.random.normal(ks[1], (DEPTH, D_MODEL), f32)
    w_in = jax.random.normal(ks[2], (DEPTH, D_MODEL, D_IN_PROJ), f32) * (D_MODEL ** -0.5)
    ssm_lambda_re = -0.5 + 0.01 * jax.random.normal(ks[3], (DEPTH, G, N), f32)
    ssm_lambda_im = (jnp.pi * jnp.arange(N, dtype=f32))[None, None, :] \
        + 0.01 * jax.random.normal(ks[4], (DEPTH, G, N), f32)
    ssm_b_re = jax.random.normal(ks[5], (DEPTH, G, N, H), f32) * ((2.0 * H) ** -0.5)
    ssm_b_im = jax.random.normal(ks[6], (DEPTH, G, N, H), f32) * ((2.0 * H) ** -0.5)
    ssm_c_re = jax.random.normal(ks[7], (DEPTH, G, H, N), f32) * (0.5 ** 0.5)
    ssm_c_im = jax.random.normal(ks[8], (DEPTH, G, H, N), f32) * (0.5 ** 0.5)
    ssm_d = jax.random.normal(ks[9], (DEPTH, D_SSM), f32)
    ssm_log_dt = jax.random.uniform(ks[10], (DEPTH, G), f32,
                                    minval=math.log(DT_MIN), maxval=math.log(DT_MAX))
    ssm_w_glu = jax.random.normal(ks[11], (DEPTH, D_SSM, D_SSM), f32) * (D_SSM ** -0.5)
    ssm_b_glu = 0.01 * jax.random.normal(ks[12], (DEPTH, D_SSM), f32)
    ssm_norm_w = 1.0 + 0.02 * jax.random.normal(ks[13], (DEPTH, D_SSM), f32)
    ret_norm_w = 1.0 + 0.02 * jax.random.normal(ks[14], (DEPTH, D_RET), f32)
    w_out = jax.random.normal(ks[15], (DEPTH, D_MIX, D_MODEL), f32) * (D_MIX ** -0.5)
    final_norm_w = 1.0 + 0.02 * jax.random.normal(ks[16], (D_MODEL,), f32)
    return {"x": x, "norm_w": norm_w, "w_in": w_in,
            "ssm_lambda_re": ssm_lambda_re, "ssm_lambda_im": ssm_lambda_im,
            "ssm_b_re": ssm_b_re, "ssm_b_im": ssm_b_im,
            "ssm_c_re": ssm_c_re, "ssm_c_im": ssm_c_im,
            "ssm_d": ssm_d, "ssm_log_dt": ssm_log_dt,
            "ssm_w_glu": ssm_w_glu, "ssm_b_glu": ssm_b_glu,
            "ssm_norm_w": ssm_norm_w, "ret_norm_w": ret_norm_w,
            "w_out": w_out, "final_norm_w": final_norm_w}


def reference(x, norm_w, w_in, ssm_lambda_re, ssm_lambda_im, ssm_b_re, ssm_b_im,
              ssm_c_re, ssm_c_im, ssm_d, ssm_log_dt, ssm_w_glu, ssm_b_glu,
              ssm_norm_w, ret_norm_w, w_out, final_norm_w):
    h = x
    for layer in range(DEPTH):
        h = hybrid_layer(h, norm_w[layer], w_in[layer],
                         ssm_lambda_re[layer], ssm_lambda_im[layer],
                         ssm_b_re[layer], ssm_b_im[layer],
                         ssm_c_re[layer], ssm_c_im[layer],
                         ssm_d[layer], ssm_log_dt[layer],
                         ssm_w_glu[layer], ssm_b_glu[layer],
                         ssm_norm_w[layer], ret_norm_w[layer], w_out[layer])
    return rmsnorm(h, final_norm_w)
```

```cpp
#include <hip/hip_runtime.h>
#include <hip/hip_cooperative_groups.h>
#include <cstdio>
#include <cstdint>
namespace cg = cooperative_groups;

#ifndef FAST_SSM
#define FAST_SSM 0
#endif
#ifndef FAST_RET
#define FAST_RET 0
#endif

#define LAS __attribute__((address_space(3)))
typedef unsigned short bf16_t;
typedef short bf16x8 __attribute__((ext_vector_type(8)));
typedef float f32x4 __attribute__((ext_vector_type(4)));
typedef float f32x2 __attribute__((ext_vector_type(2)));
typedef unsigned u32x4 __attribute__((ext_vector_type(4)));
typedef unsigned u32x2 __attribute__((ext_vector_type(2)));

constexpr int BATCH = 4, SEQ = 2048, DM = 4096, DEPTH = 2, DS = 2048, DR = 2048, NG = 128, SG = 16, NST = 64, RH = 8, RD = 256;
constexpr int NPROJ = 12288, MTOK = BATCH * SEQ;
constexpr float EPS = 1e-6f;
constexpr int TCH = 16;
constexpr int A2LD = 384;

constexpr size_t MiB = 1u << 20;
constexpr size_t WS_CTL = 0;
constexpr size_t WS_WTIN = 16 * MiB;
constexpr size_t WS_WTGLU = 208 * MiB;
constexpr size_t WS_WTOUT = 224 * MiB;
constexpr size_t WS_BT2 = 288 * MiB;
constexpr size_t WS_PM = 336 * MiB;
constexpr size_t WS_A16 = 368 * MiB;
constexpr size_t WS_ROPE = 369 * MiB;
constexpr size_t WS_SSQX = 371 * MiB;
constexpr size_t WS_SSQ2 = 373 * MiB;
constexpr size_t WS_XB = 384 * MiB;
constexpr size_t WS_X1 = 448 * MiB;
constexpr size_t WS_A2U = 576 * MiB;
constexpr size_t WS_GS = 624 * MiB, WS_Q = 656 * MiB, WS_K = 688 * MiB, WS_VT = 720 * MiB, WS_GR = 752 * MiB, WS_YG = 784 * MiB;
constexpr size_t WS_YCAT = 816 * MiB;
constexpr size_t WS_END = 880 * MiB;

constexpr int RING_BYTES = 131072;
constexpr int STASH_OFF = 155648;
constexpr int LDS_BYTES = 163840 - 4096;

__device__ __forceinline__ unsigned f2bf(float f) { unsigned u = __builtin_bit_cast(unsigned, f); return (u + 0x7fffu + ((u >> 16) & 1u)) >> 16; }
__device__ __forceinline__ unsigned pk2(float lo, float hi) { return f2bf(lo) | (f2bf(hi) << 16); }
__device__ __forceinline__ float bf2f(unsigned v) { return __builtin_bit_cast(float, v << 16); }
__device__ __forceinline__ unsigned cvt_pk_bf16(float lo, float hi) { unsigned r; asm volatile("v_cvt_pk_bf16_f32 %0, %1, %2" : "=v"(r) : "v"(lo), "v"(hi)); return r; }
__device__ __forceinline__ float silu_f(float x) { return x * __builtin_amdgcn_rcpf(1.f + __expf(-x)); }
__device__ __forceinline__ float sigmoid_f(float x) { return __builtin_amdgcn_rcpf(1.f + __expf(-x)); }
__device__ __forceinline__ float gelu_tanh_f(float x) {
    const float z = 0.7978845608028654f * (x + 0.044715f * x * x * x);
    const float th = 1.f - 2.f * __builtin_amdgcn_rcpf(1.f + __expf(2.f * z));
    return 0.5f * x * (1.f + th);
}
__device__ __forceinline__ float wave_sum(float v) {
#pragma unroll
    for (int o = 1; o < 64; o <<= 1) v += __shfl_xor(v, o);
    return v;
}
__device__ __forceinline__ void cis_d(double ph, float& c, float& s) {
    const double k = __builtin_rint(ph * 0.15915494309189535);
    const float r = (float)(ph - k * 6.283185307179586);
    c = cosf(r); s = sinf(r);
}
#define LDS_WAIT() asm volatile("s_waitcnt lgkmcnt(0)" ::: "memory")
#define VM_WAIT() asm volatile("s_waitcnt vmcnt(0)" ::: "memory")

namespace pg8 {
constexpr int BM = 256, BK = 64, HALF = 128, HTB = HALF * BK * 2, STAGE_BYTES = 8 * HTB, NXCD = 8, WGM = 8;
__host__ __device__ __forceinline__ int lds_byte(int r, int c) { const int st = (r >> 4) * 2 + (c >> 5), rr = r & 15, cc = c & 31, ob = rr * 64 + cc * 2; return st * 1024 + (ob ^ (((ob >> 9) & 1) << 5)); }
__host__ __device__ __forceinline__ void stage_rc(int b, int& R, int& C) { const int st = b / 1024, sb = b % 1024, swz = sb ^ (((sb >> 9) & 1) << 5); R = (st >> 1) * 16 + swz / 64; C = (st & 1) * 32 + (swz % 64) / 2; }
__host__ __device__ __forceinline__ int perm32(int rho) { const int n = rho >> 4, i = rho & 15; return 8 * (i >> 2) + 4 * n + (i & 3); }

struct Unit { int pm, pn; };
struct Gemm { const bf16_t* A; const bf16_t* Bt; int K, lda, ldb, kmid; };

struct StaticOrder {
    int nM, nN, nwg, G, c;
    __host__ __device__ void init(int M, int N, int G_, int c_) { nM = M / BM; nN = N / BM; nwg = nM * nN; G = G_; c = c_; }
    __host__ __device__ bool next(int i, Unit& u) const {
        const long L = (long)i * G + c; if (L >= nwg) return false;
        int wgid = (int)L; { const int q = nwg / NXCD, r = nwg % NXCD, xcd = wgid % NXCD, off = wgid / NXCD; wgid = (xcd < r ? xcd * (q + 1) : r * (q + 1) + (xcd - r) * q) + off; }
        const int nig = WGM * nN, gid = wgid / nig, fm = gid * WGM, gsz = (nM - fm) < WGM ? (nM - fm) : WGM;
        u.pm = fm + ((wgid % nig) % gsz); u.pn = (wgid % nig) / gsz; return true;
    }
};
struct OneUnit {
    int pm, pn;
    __device__ __forceinline__ bool next(int i, Unit& u) const { if (i) return false; u.pm = pm; u.pn = pn; return true; }
};

template <class Epi, class Sched, bool ALIGN_EPI, bool SP2>
__device__ __forceinline__ void gemm_phase(LAS unsigned char* lds, const Gemm g, const Sched& S, const Epi& E) {
    int tid_ = threadIdx.x; asm volatile("" : "+v"(tid_));
    const int tid = tid_, wid = __builtin_amdgcn_readfirstlane(tid >> 6), lane = tid & 63, wr = wid >> 2, wc = wid & 3, fr = lane & 15, fq = lane >> 4;
    const int K = g.K, nt = K / BK;
    unsigned voffA[2], voffB[2];
#pragma unroll
    for (int i = 0; i < 2; ++i) { int R, C; stage_rc(tid * 16 + i * 8192, R, C); const int Rb = Epi::PERM ? ((R & ~31) + perm32(R & 31)) : R;
        voffA[i] = (unsigned)(R * g.lda + C) * 2u; voffB[i] = (unsigned)(Rb * g.ldb + C) * 2u; }
    const size_t kstep = (size_t)(BK * 2);
    const size_t hstepA = (size_t)HALF * g.lda * 2, hstepB = (size_t)HALF * g.ldb * 2;
    const size_t tstepA = 2 * hstepA, tstepB = 2 * hstepB;
    const unsigned ldsw = (unsigned)wid * 1024u;
    const int aoff = lds_byte(wr * 64 + fr, fq * 8), boff = lds_byte(wc * 32 + fr, fq * 8);
#define PG8_SA(b, h) (((b) * 2 + (h)) * HTB)
#define PG8_SB(b, h) ((4 + (b) * 2 + (h)) * HTB)
#define PG8_STAGE(bufoff, gbase, voff) do { _Pragma("unroll") for (int _i = 0; _i < 2; ++_i) \
        __builtin_amdgcn_global_load_lds((const unsigned*)((const char*)(gbase) + (voff)[_i]), (LAS unsigned*)(lds + (bufoff) + ldsw + _i * 8192), 16, 0, 0); } while (0)
#define PG8_LDA(dst, b, h) do { _Pragma("unroll") for (int m = 0; m < 4; ++m) _Pragma("unroll") for (int k = 0; k < 2; ++k) dst[m][k] = *(const LAS bf16x8*)(lds + PG8_SA(b, h) + aoff + m * 2048 + k * 1024); } while (0)
#define PG8_LDB(dst, b, h) do { _Pragma("unroll") for (int n = 0; n < 2; ++n) _Pragma("unroll") for (int k = 0; k < 2; ++k) dst[n][k] = *(const LAS bf16x8*)(lds + PG8_SB(b, h) + boff + n * 2048 + k * 1024); } while (0)
#define PG8_MMA(ai, bj, At, Bt) do { __builtin_amdgcn_s_setprio(1); _Pragma("unroll") for (int m = 0; m < 4; ++m) _Pragma("unroll") for (int n = 0; n < 2; ++n) _Pragma("unroll") for (int k = 0; k < 2; ++k) \
        acc[ai][bj][m][n] = __builtin_amdgcn_mfma_f32_16x16x32_bf16(Bt[n][k], At[m][k], acc[ai][bj][m][n], 0, 0, 0); __builtin_amdgcn_s_setprio(0); } while (0)
#define PG8_WAIT_V(n) asm volatile("s_waitcnt vmcnt(" #n ")" ::: "memory")
#define PG8_WAIT_L(n) asm volatile("s_waitcnt lgkmcnt(" #n ")" ::: "memory")
#define PG8_BAR __builtin_amdgcn_s_barrier()
#define PG8_SCHED __builtin_amdgcn_sched_barrier(0)
    Unit cur, nxt; int ui = 0;
    if (!S.next(0, cur)) return;
    f32x4 acc[2][2][4][2];
#pragma unroll
    for (int a = 0; a < 2; ++a)
#pragma unroll
        for (int b = 0; b < 2; ++b)
#pragma unroll
            for (int m = 0; m < 4; ++m)
#pragma unroll
                for (int n = 0; n < 2; ++n) acc[a][b][m][n] = (f32x4){0.f, 0.f, 0.f, 0.f};
    bf16x8 At[4][2], B0[2][2], B1[2][2];
    const char* cA = (const char*)g.A + (size_t)cur.pm * tstepA; const char* cB = (const char*)g.Bt + (size_t)cur.pn * tstepB;
    if constexpr (SP2) {
        PG8_STAGE(PG8_SB(0, 0), cB, voffB); PG8_STAGE(PG8_SB(0, 1), cB + hstepB, voffB); PG8_STAGE(PG8_SA(0, 0), cA, voffA); PG8_STAGE(PG8_SA(0, 1), cA + hstepA, voffA);
        if (wr == 1) PG8_BAR;
        PG8_WAIT_V(2); PG8_BAR;
        PG8_STAGE(PG8_SB(1, 0), cB + kstep, voffB); PG8_STAGE(PG8_SA(1, 0), cA + kstep, voffA); PG8_STAGE(PG8_SB(1, 1), cB + hstepB + kstep, voffB);
        PG8_WAIT_V(6); PG8_BAR;
    } else {
        PG8_STAGE(PG8_SB(0, 0), cB, voffB); PG8_STAGE(PG8_SA(0, 0), cA, voffA); PG8_STAGE(PG8_SB(0, 1), cB + hstepB, voffB); PG8_STAGE(PG8_SA(0, 1), cA + hstepA, voffA);
        if (wr == 1) PG8_BAR;
        PG8_WAIT_V(4); PG8_BAR;
        PG8_STAGE(PG8_SB(1, 0), cB + kstep, voffB); PG8_STAGE(PG8_SA(1, 0), cA + kstep, voffA); PG8_STAGE(PG8_SB(1, 1), cB + hstepB + kstep, voffB);
        PG8_WAIT_V(6); PG8_BAR;
    }
    for (;;) {
        const bool has_next = S.next(ui + 1, nxt);
        const char* nA = has_next ? (const char*)g.A + (size_t)nxt.pm * tstepA : cA; const char* nB = has_next ? (const char*)g.Bt + (size_t)nxt.pn * tstepB : cB;
        for (int t = 0; t < nt; t += 2) {
            const bool last = (t == nt - 2);
            const char* a1 = cA + (size_t)(t + 1) * kstep;
            const char* a2 = last ? nA : cA + (size_t)(t + 2) * kstep; const char* b2 = last ? nB : cB + (size_t)(t + 2) * kstep;
            const char* a3 = a2 + kstep; const char* b3 = b2 + kstep;
            if constexpr (Epi::MIDK) { if (t == g.kmid) E.midk(acc, wr, fr); }
            if constexpr (SP2) {
            PG8_LDB(B0, 0, 0); PG8_LDB(B1, 0, 1); PG8_SCHED; PG8_LDA(At, 0, 0); PG8_STAGE(PG8_SA(1, 1), a1 + hstepA, voffA);
            PG8_WAIT_V(8); PG8_WAIT_L(0); PG8_BAR; PG8_MMA(0, 0, At, B0); PG8_MMA(0, 1, At, B1); PG8_BAR; PG8_SCHED;
            PG8_LDA(At, 0, 1); PG8_STAGE(PG8_SB(0, 0), b2, voffB); PG8_STAGE(PG8_SB(0, 1), b2 + hstepB, voffB); PG8_STAGE(PG8_SA(0, 0), a2, voffA);
            PG8_WAIT_V(8); PG8_WAIT_L(0); PG8_BAR; PG8_MMA(1, 0, At, B0); PG8_MMA(1, 1, At, B1); PG8_BAR; PG8_SCHED;
            PG8_LDB(B0, 1, 0); PG8_LDB(B1, 1, 1); PG8_SCHED; PG8_LDA(At, 1, 0); PG8_STAGE(PG8_SA(0, 1), a2 + hstepA, voffA);
            PG8_WAIT_V(8); PG8_WAIT_L(0); PG8_BAR; PG8_MMA(0, 0, At, B0); PG8_MMA(0, 1, At, B1); PG8_BAR; PG8_SCHED;
            PG8_LDA(At, 1, 1); PG8_STAGE(PG8_SB(1, 0), b3, voffB); PG8_STAGE(PG8_SB(1, 1), b3 + hstepB, voffB); PG8_STAGE(PG8_SA(1, 0), a3, voffA);
            PG8_WAIT_V(8); PG8_WAIT_L(0); PG8_BAR; PG8_MMA(1, 0, At, B0); PG8_MMA(1, 1, At, B1); PG8_BAR; PG8_SCHED;
            } else {
            PG8_LDB(B0, 0, 0); PG8_SCHED; PG8_LDA(At, 0, 0); PG8_STAGE(PG8_SA(1, 1), a1 + hstepA, voffA);
            PG8_WAIT_L(8); PG8_BAR; PG8_WAIT_L(0); PG8_MMA(0, 0, At, B0); PG8_BAR; PG8_SCHED;
            PG8_LDB(B1, 0, 1); PG8_STAGE(PG8_SB(0, 0), b2, voffB);
            PG8_BAR; PG8_WAIT_L(0); PG8_MMA(0, 1, At, B1); PG8_BAR;
            PG8_LDA(At, 0, 1); PG8_STAGE(PG8_SA(0, 0), a2, voffA);
            PG8_BAR; PG8_WAIT_L(0); PG8_MMA(1, 0, At, B0); PG8_BAR; PG8_SCHED;
            PG8_STAGE(PG8_SB(0, 1), b2 + hstepB, voffB);
            PG8_WAIT_V(6); PG8_BAR; PG8_MMA(1, 1, At, B1); PG8_BAR;
            PG8_LDB(B0, 1, 0); PG8_SCHED; PG8_LDA(At, 1, 0); PG8_STAGE(PG8_SA(0, 1), a2 + hstepA, voffA);
            PG8_WAIT_L(8); PG8_BAR; PG8_WAIT_L(0); PG8_MMA(0, 0, At, B0); PG8_BAR; PG8_SCHED;
            PG8_LDB(B1, 1, 1); PG8_STAGE(PG8_SB(1, 0), b3, voffB);
            PG8_BAR; PG8_WAIT_L(0); PG8_MMA(0, 1, At, B1); PG8_BAR;
            PG8_LDA(At, 1, 1); PG8_STAGE(PG8_SA(1, 0), a3, voffA);
            PG8_BAR; PG8_WAIT_L(0); PG8_MMA(1, 0, At, B0); PG8_BAR; PG8_SCHED;
            PG8_STAGE(PG8_SB(1, 1), b3 + hstepB, voffB);
            PG8_WAIT_V(6); PG8_BAR; PG8_MMA(1, 1, At, B1); PG8_BAR;
            }
        }
        if constexpr (ALIGN_EPI) { if (wr == 0) PG8_BAR; }
        if constexpr (!Epi::AFTER_DRAIN) { E(acc, cur, wr, wc, fr, fq); }
        if (!has_next) break;
#pragma unroll
        for (int a = 0; a < 2; ++a)
#pragma unroll
            for (int b = 0; b < 2; ++b)
#pragma unroll
                for (int m = 0; m < 4; ++m)
#pragma unroll
                    for (int n = 0; n < 2; ++n) acc[a][b][m][n] = (f32x4){0.f, 0.f, 0.f, 0.f};
        cur = nxt; cA = nA; cB = nB; ++ui;
        if constexpr (ALIGN_EPI) { if (wr == 1) PG8_BAR; }
    }
    PG8_WAIT_V(0);
    if constexpr (!ALIGN_EPI) { if (wr == 0) PG8_BAR; }
    PG8_BAR;
    if constexpr (Epi::AFTER_DRAIN) { E.fused(acc, cur, wr, wc, fr, fq, lds); }
#undef PG8_SA
#undef PG8_SB
#undef PG8_STAGE
#undef PG8_LDA
#undef PG8_LDB
#undef PG8_MMA
#undef PG8_WAIT_V
#undef PG8_WAIT_L
#undef PG8_BAR
#undef PG8_SCHED
}
}
using pg8::Unit;
typedef f32x4 Acc[2][2][4][2];

struct EpiInProj {
    static constexpr bool PERM = true, AFTER_DRAIN = false, MIDK = false;
    const LAS float* rs; bf16_t *a2u, *gs, *q, *k, *gr; const float* rope;
    __device__ __forceinline__ void operator()(const Acc& acc, const Unit& u, int wr, int wc, int fr, int fq) const {
        asm volatile("" : "+v"(fr), "+v"(fq));
        const int type = u.pn >> 3, colt = (u.pn & 7) << 8, c8 = wc * 32 + 8 * fq;
#pragma unroll
        for (int ai = 0; ai < 2; ++ai)
#pragma unroll
            for (int m = 0; m < 4; ++m) {
                const int lr = wr * 64 + fr + ai * 128 + m * 16, r = u.pm * 256 + lr; const float s = rs[lr];
                f32x4 v[2][2];
#pragma unroll
                for (int bj = 0; bj < 2; ++bj)
#pragma unroll
                    for (int n = 0; n < 2; ++n) v[bj][n] = acc[ai][bj][m][n] * s;
                if (type == 0) {
#pragma unroll
                    for (int bj = 0; bj < 2; ++bj) { const int col = colt + bj * 128 + c8;
                        u32x4 w; w.x = cvt_pk_bf16(v[bj][0][0], v[bj][0][1]); w.y = cvt_pk_bf16(v[bj][0][2], v[bj][0][3]); w.z = cvt_pk_bf16(v[bj][1][0], v[bj][1][1]); w.w = cvt_pk_bf16(v[bj][1][2], v[bj][1][3]);
                        *(u32x4*)(a2u + ((size_t)((col >> 4) * 512 + (r >> 4)) * A2LD + (r & 15) * 16 + (col & 15))) = w; }
                } else if (type == 1 || type == 4) {
                    bf16_t* dst = (type == 1 ? gs : gr) + (size_t)r * 2048 + colt + c8;
#pragma unroll
                    for (int bj = 0; bj < 2; ++bj) {
                        u32x4 w; w.x = cvt_pk_bf16(silu_f(v[bj][0][0]), silu_f(v[bj][0][1])); w.y = cvt_pk_bf16(silu_f(v[bj][0][2]), silu_f(v[bj][0][3]));
                        w.z = cvt_pk_bf16(silu_f(v[bj][1][0]), silu_f(v[bj][1][1])); w.w = cvt_pk_bf16(silu_f(v[bj][1][2]), silu_f(v[bj][1][3]));
                        *(u32x4*)(dst + bj * 128) = w; }
                } else {
                    const float sc = (type == 3) ? 0.0625f : 1.f;
                    const f32x4* cs = (const f32x4*)(rope + ((size_t)(r & 2047) * 128 + c8) * 2);
                    float o1[8], o2[8];
#pragma unroll
                    for (int jj = 0; jj < 4; ++jj) { const f32x4 t = cs[jj];
                        const float a0 = v[0][jj >> 1][(jj & 1) * 2], b0 = v[1][jj >> 1][(jj & 1) * 2], a1 = v[0][jj >> 1][(jj & 1) * 2 + 1], b1 = v[1][jj >> 1][(jj & 1) * 2 + 1];
                        o1[2 * jj] = (a0 * t[0] - b0 * t[1]) * sc; o2[2 * jj] = (b0 * t[0] + a0 * t[1]) * sc;
                        o1[2 * jj + 1] = (a1 * t[2] - b1 * t[3]) * sc; o2[2 * jj + 1] = (b1 * t[2] + a1 * t[3]) * sc; }
                    bf16_t* dst = (type == 2 ? q : k) + (size_t)r * 2048 + colt + c8;
                    u32x4 w; w.x = cvt_pk_bf16(o1[0], o1[1]); w.y = cvt_pk_bf16(o1[2], o1[3]); w.z = cvt_pk_bf16(o1[4], o1[5]); w.w = cvt_pk_bf16(o1[6], o1[7]);
                    *(u32x4*)dst = w;
                    w.x = cvt_pk_bf16(o2[0], o2[1]); w.y = cvt_pk_bf16(o2[2], o2[3]); w.z = cvt_pk_bf16(o2[4], o2[5]); w.w = cvt_pk_bf16(o2[6], o2[7]);
                    *(u32x4*)(dst + 128) = w;
                }
                asm volatile("" ::: "memory");
            }
    }
};
struct EpiVT {
    static constexpr bool PERM = true, AFTER_DRAIN = false, MIDK = false;
    const LAS float* rs; bf16_t* vt;
    __device__ __forceinline__ void operator()(const Acc& acc, const Unit& u, int wr, int wc, int fr, int fq) const {
        asm volatile("" : "+v"(fr), "+v"(fq));
        f32x4 sv[2][2];
#pragma unroll
        for (int bj = 0; bj < 2; ++bj)
#pragma unroll
            for (int n = 0; n < 2; ++n) sv[bj][n] = *(const LAS f32x4*)(rs + bj * 128 + wc * 32 + 8 * fq + 4 * n);
#pragma unroll
        for (int ai = 0; ai < 2; ++ai)
#pragma unroll
            for (int m = 0; m < 4; ++m) { bf16_t* dst = vt + (size_t)(u.pm * 256 + wr * 64 + fr + ai * 128 + m * 16) * MTOK + u.pn * 256 + wc * 32 + 8 * fq;
#pragma unroll
                for (int bj = 0; bj < 2; ++bj) { const f32x4 a = acc[ai][bj][m][0] * sv[bj][0], b = acc[ai][bj][m][1] * sv[bj][1];
                    u32x4 w; w.x = cvt_pk_bf16(a[0], a[1]); w.y = cvt_pk_bf16(a[2], a[3]); w.z = cvt_pk_bf16(b[0], b[1]); w.w = cvt_pk_bf16(b[2], b[3]);
                    *(u32x4*)(dst + bj * 128) = w; } }
    }
};
constexpr int SLD = 132;
struct EpiSloc {
    static constexpr bool PERM = false, AFTER_DRAIN = true, MIDK = false;
    __device__ __forceinline__ void fused(const Acc& acc, const Unit&, int wr, int wc, int fr, int fq, LAS unsigned char* lds) const {
        asm volatile("" : "+v"(fr), "+v"(fq));
        LAS float* S = (LAS float*)lds;
#pragma unroll
        for (int ai = 0; ai < 2; ++ai)
#pragma unroll
            for (int m = 0; m < 4; ++m)
#pragma unroll
                for (int n = 0; n < 2; ++n) *(LAS f32x4*)(S + (ai * 128 + wr * 64 + m * 16 + fr) * SLD + wc * 32 + n * 16 + 4 * fq) = acc[ai][0][m][n];
    }
};
struct EpiSsmOut {
    static constexpr bool PERM = true, AFTER_DRAIN = false, MIDK = false;
    const bf16_t* a2g; const float* dsk; bf16_t* yg; int g;
    __device__ __forceinline__ void operator()(const Acc& acc, const Unit& u, int wr, int wc, int fr, int fq) const {
        asm volatile("" : "+v"(fr), "+v"(fq));
        const int h0 = 8 * (fq & 1);
        const f32x4 d0 = *(const f32x4*)(dsk + h0), d1 = *(const f32x4*)(dsk + h0 + 4);
#pragma unroll
        for (int ai = 0; ai < 2; ++ai)
#pragma unroll
            for (int m = 0; m < 4; ++m) { const int row = u.pm * 256 + ai * 128 + wr * 64 + m * 16 + fr;
#pragma unroll
                for (int bj = 0; bj < 2; ++bj) { const int col = bj * 128 + wc * 32 + 8 * fq, tl = col >> 4;
                    const u32x4 uu = *(const u32x4*)(a2g + (size_t)row * A2LD + col);
                    const f32x4 a = acc[ai][bj][m][0], b = acc[ai][bj][m][1];
                    float y[8];
                    y[0] = a[0] + d0[0] * bf2f(uu.x & 0xffffu); y[1] = a[1] + d0[1] * bf2f(uu.x >> 16); y[2] = a[2] + d0[2] * bf2f(uu.y & 0xffffu); y[3] = a[3] + d0[3] * bf2f(uu.y >> 16);
                    y[4] = b[0] + d1[0] * bf2f(uu.z & 0xffffu); y[5] = b[1] + d1[1] * bf2f(uu.z >> 16); y[6] = b[2] + d1[2] * bf2f(uu.w & 0xffffu); y[7] = b[3] + d1[3] * bf2f(uu.w >> 16);
#pragma unroll
                    for (int j = 0; j < 8; ++j) y[j] = gelu_tanh_f(y[j]);
                    u32x4 w; w.x = cvt_pk_bf16(y[0], y[1]); w.y = cvt_pk_bf16(y[2], y[3]); w.z = cvt_pk_bf16(y[4], y[5]); w.w = cvt_pk_bf16(y[6], y[7]);
                    *(u32x4*)(yg + (size_t)(row * 16 + tl) * DS + g * 16 + h0) = w; }
                asm volatile("" ::: "memory"); }
    }
};
struct EpiGlu {
    static constexpr bool PERM = true, AFTER_DRAIN = false, MIDK = false;
    const bf16_t* yg; const bf16_t* gs; const float* bias; bf16_t* ycat; float* ssq2;
    __device__ __forceinline__ void operator()(const Acc& acc, const Unit& u, int wr, int wc, int fr, int fq) const {
        asm volatile("" : "+v"(fr), "+v"(fq));
        const int col0 = u.pn * 256 + wc * 32 + 8 * fq;
        f32x4 bv[2][2];
#pragma unroll
        for (int bj = 0; bj < 2; ++bj)
#pragma unroll
            for (int n = 0; n < 2; ++n) bv[bj][n] = *(const f32x4*)(bias + col0 + bj * 128 + 4 * n);
#pragma unroll
        for (int ai = 0; ai < 2; ++ai)
#pragma unroll
            for (int m = 0; m < 4; ++m) { const int r = u.pm * 256 + ai * 128 + wr * 64 + m * 16 + fr; float ss = 0.f;
#pragma unroll
                for (int bj = 0; bj < 2; ++bj) { const size_t off = (size_t)r * DS + col0 + bj * 128;
                    const u32x4 yy = *(const u32x4*)(yg + off), gg = *(const u32x4*)(gs + off);
                    const f32x4 a = acc[ai][bj][m][0] + bv[bj][0], b = acc[ai][bj][m][1] + bv[bj][1];
                    float z[8];
                    z[0] = bf2f(yy.x & 0xffffu) * sigmoid_f(a[0]); z[1] = bf2f(yy.x >> 16) * sigmoid_f(a[1]); z[2] = bf2f(yy.y & 0xffffu) * sigmoid_f(a[2]); z[3] = bf2f(yy.y >> 16) * sigmoid_f(a[3]);
                    z[4] = bf2f(yy.z & 0xffffu) * sigmoid_f(b[0]); z[5] = bf2f(yy.z >> 16) * sigmoid_f(b[1]); z[6] = bf2f(yy.w & 0xffffu) * sigmoid_f(b[2]); z[7] = bf2f(yy.w >> 16) * sigmoid_f(b[3]);
#pragma unroll
                    for (int j = 0; j < 8; ++j) ss += z[j] * z[j];
                    z[0] *= bf2f(gg.x & 0xffffu); z[1] *= bf2f(gg.x >> 16); z[2] *= bf2f(gg.y & 0xffffu); z[3] *= bf2f(gg.y >> 16);
                    z[4] *= bf2f(gg.z & 0xffffu); z[5] *= bf2f(gg.z >> 16); z[6] *= bf2f(gg.w & 0xffffu); z[7] *= bf2f(gg.w >> 16);
                    u32x4 w; w.x = cvt_pk_bf16(z[0], z[1]); w.y = cvt_pk_bf16(z[2], z[3]); w.z = cvt_pk_bf16(z[4], z[5]); w.w = cvt_pk_bf16(z[6], z[7]);
                    *(u32x4*)(ycat + (size_t)r * DM + col0 + bj * 128) = w; }
                ss += __shfl_xor(ss, 16); ss += __shfl_xor(ss, 32);
                if (fq == 0) ssq2[(size_t)r * 32 + u.pn * 4 + wc] = ss;
                asm volatile("" ::: "memory"); }
    }
};
struct EpiOut {
    static constexpr bool PERM = false, AFTER_DRAIN = false, MIDK = true;
    const LAS float* rs2; const float* res; float* out; bf16_t* xb; float* ssq;
    __device__ __forceinline__ void midk(Acc& acc, int wr, int fr) const {
        asm volatile("" : "+v"(fr));
#pragma unroll
        for (int ai = 0; ai < 2; ++ai)
#pragma unroll
            for (int m = 0; m < 4; ++m) { const float s = rs2[ai * 128 + wr * 64 + m * 16 + fr];
#pragma unroll
                for (int bj = 0; bj < 2; ++bj)
#pragma unroll
                    for (int n = 0; n < 2; ++n) acc[ai][bj][m][n] *= s; }
    }
    __device__ __forceinline__ void operator()(const Acc& acc, const Unit& u, int wr, int wc, int fr, int fq) const {
        asm volatile("" : "+v"(fr), "+v"(fq));
        const int col0 = u.pn * 256 + wc * 32 + 4 * fq;
#pragma unroll
        for (int ai = 0; ai < 2; ++ai)
#pragma unroll
            for (int m = 0; m < 4; ++m) { const int r = u.pm * 256 + ai * 128 + wr * 64 + m * 16 + fr; float ss = 0.f;
#pragma unroll
                for (int bj = 0; bj < 2; ++bj)
#pragma unroll
                    for (int n = 0; n < 2; ++n) { const size_t off = (size_t)r * DM + col0 + bj * 128 + n * 16;
                        const f32x4 x = *(const f32x4*)(res + off) + acc[ai][bj][m][n];
                        *(f32x4*)(out + off) = x; ss += (x[0] * x[0] + x[1] * x[1]) + (x[2] * x[2] + x[3] * x[3]);
                        if (xb) { u32x2 w; w.x = cvt_pk_bf16(x[0], x[1]); w.y = cvt_pk_bf16(x[2], x[3]); *(u32x2*)(xb + off) = w; } }
                ss += __shfl_xor(ss, 16); ss += __shfl_xor(ss, 32);
                if (fq == 0) ssq[(size_t)r * 64 + u.pn * 4 + wc] = ss;
                asm volatile("" ::: "memory"); }
    }
};

struct Args { const float* in[17]; float* out; unsigned char* ws; int ph_lo, ph_hi; };
enum { I_X = 0, I_NORMW, I_WIN, I_LRE, I_LIM, I_BRE, I_BIM, I_CRE, I_CIM, I_D, I_LOGDT, I_WGLU, I_BGLU, I_SNW, I_RNW, I_WOUT, I_FNW };

struct Frame {
    LAS unsigned char* lds; int tid, lane, wave, vcu, G; unsigned char* ws;
};

__device__ __forceinline__ void transpose_item(const float* W, int K, int N, bf16_t* WT, const float* ks0, const float* ks1, int ksplit, int remap, LAS float* scr, int item, int lane) {
    const int nblk = N / 32, kb = item / nblk, nb = item % nblk, k0 = 64 * kb; int n0 = 32 * nb;
    const float* ks = (k0 < ksplit) ? ks0 + k0 : ks1 + (k0 - ksplit);
#pragma unroll 8
    for (int i = 0; i < 32; ++i) { const int kk = 2 * i + (lane >> 5); scr[kk * 33 + (lane & 31)] = W[(size_t)(k0 + kk) * N + n0 + (lane & 31)] * (ks0 ? ks[kk] : 1.f); }
    LDS_WAIT(); asm volatile("" ::: "memory");
    if (remap) { if (n0 >= 10240) n0 -= 2048; else if (n0 >= 8192) n0 += 2048; }
    const int c = lane & 7;
#pragma unroll
    for (int j = 0; j < 4; ++j) { const int n = (lane >> 3) + 8 * j; const LAS float* s = scr + (8 * c) * 33 + n;
        u32x4 o; o.x = pk2(s[0 * 33], s[1 * 33]); o.y = pk2(s[2 * 33], s[3 * 33]); o.z = pk2(s[4 * 33], s[5 * 33]); o.w = pk2(s[6 * 33], s[7 * 33]);
        *(u32x4*)(WT + (size_t)(n0 + n) * K + k0 + 8 * c) = o; }
    LDS_WAIT(); asm volatile("" ::: "memory");
}

__device__ __forceinline__ void ssm_mats_item(const Frame& F, const Args& a, int l, int g) {
    const int lg = l * NG + g, tid = F.tid;
    LAS float* apr = (LAS float*)F.lds;
    LAS float* api = apr + 17 * 64;
    LAS float* bbr = api + 17 * 64;
    LAS float* bbi = bbr + 1024;
    LAS float* Kt = bbi + 1024;
    if (tid < 64) {
        const int n = tid; const double dt = exp((double)a.in[I_LOGDT][lg]);
        const float lr = a.in[I_LRE][lg * 64 + n], li = a.in[I_LIM][lg * 64 + n];
        for (int tau = 0; tau <= 16; ++tau) { float c, s; cis_d((double)li * dt * tau, c, s); const float mag = (float)exp((double)lr * dt * tau); apr[tau * 64 + n] = mag * c; api[tau * 64 + n] = mag * s; }
        const float abr = apr[64 + n], abi = api[64 + n], nr = abr - 1.f, ni = abi, den = lr * lr + li * li;
        const float cor = (nr * lr + ni * li) / den, coi = (ni * lr - nr * li) / den;
        for (int h = 0; h < 16; ++h) { const float br = a.in[I_BRE][(size_t)(lg * 64 + n) * 16 + h], bi = a.in[I_BIM][(size_t)(lg * 64 + n) * 16 + h];
            bbr[n * 16 + h] = cor * br - coi * bi; bbi[n * 16 + h] = cor * bi + coi * br; }
        ((float2*)(F.ws + WS_A16))[lg * 64 + n] = make_float2(apr[16 * 64 + n], api[16 * 64 + n]);
    }
    __syncthreads();
    const float* cre = a.in[I_CRE] + (size_t)lg * 1024; const float* cim = a.in[I_CIM] + (size_t)lg * 1024;
    for (int o = tid; o < 4096; o += 512) { const int tau = o >> 8, hp = (o >> 4) & 15, h = o & 15; float sum = 0.f;
        for (int n = 0; n < 64; ++n) { const float cr = cre[hp * 64 + n], ci = cim[hp * 64 + n], ar = apr[tau * 64 + n], ai = api[tau * 64 + n];
            sum += (cr * ar - ci * ai) * bbr[n * 16 + h] - (cr * ai + ci * ar) * bbi[n * 16 + h]; }
        Kt[o] = sum; }
    __syncthreads();
    bf16_t* bt2 = (bf16_t*)(F.ws + WS_BT2) + (size_t)lg * 256 * A2LD;
    for (int e = tid; e < 256 * A2LD / 8; e += 512) { const int row = e / 48, c0 = (e % 48) * 8, t = row >> 4, hp = row & 15; float v[8];
        if (c0 < 256) { const int j = c0 >> 4, h0 = c0 & 15;
#pragma unroll
            for (int i = 0; i < 8; ++i) v[i] = (t >= j) ? Kt[((t - j) << 8) + (hp << 4) + h0 + i] : 0.f;
        } else { const int nn = c0 - 256;
#pragma unroll
            for (int i = 0; i < 8; ++i) { const int n = (nn + i) & 63; const float cr = cre[hp * 64 + n], ci = cim[hp * 64 + n], ar = apr[(t + 1) * 64 + n], ai = api[(t + 1) * 64 + n];
                v[i] = (nn < 64) ? (cr * ar - ci * ai) : -(cr * ai + ci * ar); } }
        u32x4 w; w.x = pk2(v[0], v[1]); w.y = pk2(v[2], v[3]); w.z = pk2(v[4], v[5]); w.w = pk2(v[6], v[7]);
        *(u32x4*)(bt2 + (size_t)row * A2LD + c0) = w; }
    bf16_t* pm = (bf16_t*)(F.ws + WS_PM) + (size_t)lg * 256 * 256;
    for (int e = tid; e < 256 * 256 / 8; e += 512) { const int row = e >> 5, c0 = (e & 31) * 8; float v[8];
        if (row < 128) { const int n = row & 63, im = row >> 6, j = c0 >> 4, h0 = c0 & 15; const float ar = apr[(15 - j) * 64 + n], ai = api[(15 - j) * 64 + n];
#pragma unroll
            for (int i = 0; i < 8; ++i) { const float br = bbr[n * 16 + h0 + i], bi = bbi[n * 16 + h0 + i]; v[i] = im ? (ar * bi + ai * br) : (ar * br - ai * bi); }
        } else {
#pragma unroll
            for (int i = 0; i < 8; ++i) v[i] = 0.f; }
        u32x4 w; w.x = pk2(v[0], v[1]); w.y = pk2(v[2], v[3]); w.z = pk2(v[4], v[5]); w.w = pk2(v[6], v[7]);
        *(u32x4*)(pm + (size_t)row * 256 + c0) = w; }
    __syncthreads();
}

__device__ __forceinline__ void p0_prologue(const Frame& F, const Args& a) {
    for (int it = F.vcu; it < DEPTH * NG; it += F.G) ssm_mats_item(F, a, it / NG, it % NG);
    { float2* rope = (float2*)(F.ws + WS_ROPE);
      for (int e = F.vcu * 512 + F.tid; e < SEQ * 128; e += F.G * 512) { const int pos = e >> 7, i = e & 127;
          const double inv = exp(-(double)(2 * i) * (9.210340371976184 / 256.0)); float c, s; cis_d((double)pos * inv, c, s); rope[e] = make_float2(c, s); } }
    const int gw = F.vcu * 8 + F.wave, NGW = F.G * 8;
    for (int m = gw; m < MTOK; m += NGW) {
        const f32x4* xr = (const f32x4*)(a.in[I_X] + (size_t)m * DM) + F.lane; float ss = 0.f; f32x4 v[16];
#pragma unroll
        for (int j = 0; j < 16; ++j) { v[j] = xr[64 * j]; ss += (v[j][0] * v[j][0] + v[j][1] * v[j][1]) + (v[j][2] * v[j][2] + v[j][3] * v[j][3]); }
        ss = wave_sum(ss);
        u32x2* o = (u32x2*)((bf16_t*)(F.ws + WS_XB) + (size_t)m * DM) + F.lane;
#pragma unroll
        for (int j = 0; j < 16; ++j) { u32x2 w; w.x = pk2(v[j][0], v[j][1]); w.y = pk2(v[j][2], v[j][3]); o[64 * j] = w; }
        ((float*)(F.ws + WS_SSQX))[(size_t)m * 64 + F.lane] = (F.lane == 0) ? ss : 0.f;
    }
    LAS float* scr = (LAS float*)(F.lds + F.wave * 16384);
    constexpr int I_IN = (DM / 64) * (NPROJ / 32), I_GLU = (DS / 64) * (DS / 32), I_OUT = (DM / 64) * (DM / 32), I_L = I_IN + I_GLU + I_OUT;
    for (int it = gw; it < DEPTH * I_L; it += NGW) {
        const int l = it / I_L; int r = it % I_L;
        if (r < I_IN) { transpose_item(a.in[I_WIN] + (size_t)l * DM * NPROJ, DM, NPROJ, (bf16_t*)(F.ws + WS_WTIN) + (size_t)l * NPROJ * DM, a.in[I_NORMW] + l * DM, a.in[I_NORMW] + l * DM, 1 << 30, 1, scr, r, F.lane); continue; } r -= I_IN;
        if (r < I_GLU) { transpose_item(a.in[I_WGLU] + (size_t)l * DS * DS, DS, DS, (bf16_t*)(F.ws + WS_WTGLU) + (size_t)l * DS * DS, nullptr, nullptr, 1 << 30, 0, scr, r, F.lane); continue; } r -= I_GLU;
        transpose_item(a.in[I_WOUT] + (size_t)l * DM * DM, DM, DM, (bf16_t*)(F.ws + WS_WTOUT) + (size_t)l * DM * DM, a.in[I_SNW] + l * DS, a.in[I_RNW] + l * DR, DS, 0, scr, r, F.lane);
    }
}

__device__ __forceinline__ void stash_rstd(const Frame& F, const float* slots, int nslot, int panel, float inv_dim) {
    __syncthreads();
    if (F.tid < 256) { const f32x4* p = (const f32x4*)(slots + (size_t)(panel * 256 + F.tid) * nslot); float s = 0.f;
        for (int j = 0; j < nslot / 4; ++j) { const f32x4 t = p[j]; s += (t[0] + t[1]) + (t[2] + t[3]); }
        ((LAS float*)(F.lds + STASH_OFF))[F.tid] = __builtin_amdgcn_rsqf(s * inv_dim + EPS); }
    __syncthreads();
}

__device__ __forceinline__ void p1_inproj(const Frame& F, int l) {
    const bf16_t* xb = (const bf16_t*)(F.ws + WS_XB); const bf16_t* wt = (const bf16_t*)(F.ws + WS_WTIN) + (size_t)l * NPROJ * DM;
    const LAS float* rs = (const LAS float*)(F.lds + STASH_OFF);
    { pg8::StaticOrder S; S.init(MTOK, 10240, F.G, (int)blockIdx.x); Unit u0; S.next(0, u0);
      stash_rstd(F, (const float*)(F.ws + WS_SSQX), 64, u0.pm, 1.f / DM);
      pg8::Gemm g{xb, wt, DM, DM, DM, -1};
      EpiInProj E{rs, (bf16_t*)(F.ws + WS_A2U), (bf16_t*)(F.ws + WS_GS), (bf16_t*)(F.ws + WS_Q), (bf16_t*)(F.ws + WS_K), (bf16_t*)(F.ws + WS_GR), (const float*)(F.ws + WS_ROPE)};
      pg8::gemm_phase<EpiInProj, pg8::StaticOrder, true, true>(F.lds, g, S, E); }
    { pg8::StaticOrder S; S.init(DR, MTOK, F.G, (int)blockIdx.x); Unit u0; S.next(0, u0);
      stash_rstd(F, (const float*)(F.ws + WS_SSQX), 64, u0.pn, 1.f / DM);
      pg8::Gemm g{wt + (size_t)10240 * DM, xb, DM, DM, DM, -1};
      EpiVT E{rs, (bf16_t*)(F.ws + WS_VT)};
      pg8::gemm_phase<EpiVT, pg8::StaticOrder, true, true>(F.lds, g, S, E); }
}

__device__ __forceinline__ void p2_ssm(const Frame& F, const Args& a, int l) {
    for (int it = F.vcu; it < NG * 2; it += F.G) {
        const int g = it >> 1, bp = it & 1, lg = l * NG + g;
        bf16_t* a2g = (bf16_t*)(F.ws + WS_A2U) + (size_t)g * 512 * A2LD;
        { pg8::Gemm g1{a2g, (const bf16_t*)(F.ws + WS_PM) + (size_t)lg * 256 * 256, 256, A2LD, 256, -1}; pg8::OneUnit S{bp, 0}; EpiSloc E{};
          pg8::gemm_phase<EpiSloc, pg8::OneUnit, false, true>(F.lds, g1, S, E); }
        LDS_WAIT(); __syncthreads();
        if (F.tid < 128) {
            const int bb = F.tid >> 6, n = F.tid & 63; const float2 a16 = ((const float2*)(F.ws + WS_A16))[lg * 64 + n];
            const LAS float* S = (const LAS float*)F.lds + (bb * 128) * SLD; bf16_t* dst = a2g + (size_t)(bp * 256 + bb * 128) * A2LD + 256 + n;
            float sr = 0.f, si = 0.f;
#pragma unroll 8
            for (int c = 0; c < 128; ++c) { dst[(size_t)c * A2LD] = (bf16_t)f2bf(sr); dst[(size_t)c * A2LD + 64] = (bf16_t)f2bf(si);
                const float lr = S[c * SLD + n], li = S[c * SLD + 64 + n]; const float nr = a16.x * sr - a16.y * si + lr, ni = a16.x * si + a16.y * sr + li; sr = nr; si = ni; }
        }
        VM_WAIT(); __syncthreads();
        if (F.tid == 0) { __builtin_amdgcn_fence(__ATOMIC_ACQUIRE, "agent"); VM_WAIT(); }
        __syncthreads();
        { pg8::Gemm g2{a2g, (const bf16_t*)(F.ws + WS_BT2) + (size_t)lg * 256 * A2LD, A2LD, A2LD, A2LD, -1}; pg8::OneUnit S{bp, 0};
          EpiSsmOut E{a2g, a.in[I_D] + (size_t)l * DS + g * 16, (bf16_t*)(F.ws + WS_YG), g};
          pg8::gemm_phase<EpiSsmOut, pg8::OneUnit, false, true>(F.lds, g2, S, E); }
        __syncthreads();
    }
}

__device__ __forceinline__ void p3_glu(const Frame& F, const Args& a, int l) {
    pg8::StaticOrder S; S.init(MTOK, DS, F.G, (int)blockIdx.x);
    pg8::Gemm g{(const bf16_t*)(F.ws + WS_YG), (const bf16_t*)(F.ws + WS_WTGLU) + (size_t)l * DS * DS, DS, DS, DS, -1};
    EpiGlu E{(const bf16_t*)(F.ws + WS_YG), (const bf16_t*)(F.ws + WS_GS), a.in[I_BGLU] + (size_t)l * DS, (bf16_t*)(F.ws + WS_YCAT), (float*)(F.ws + WS_SSQ2)};
    pg8::gemm_phase<EpiGlu, pg8::StaticOrder, true, true>(F.lds, g, S, E);
}

__device__ __forceinline__ void p4_out(const Frame& F, const Args& a, int l) {
    pg8::StaticOrder S; S.init(MTOK, DM, F.G, (int)blockIdx.x); Unit u0; S.next(0, u0);
    stash_rstd(F, (const float*)(F.ws + WS_SSQ2), 32, u0.pm, 1.f / DS);
    pg8::Gemm g{(const bf16_t*)(F.ws + WS_YCAT), (const bf16_t*)(F.ws + WS_WTOUT) + (size_t)l * DM * DM, DM, DM, DM, DS / 64};
    const bool lastl = (l == DEPTH - 1);
    EpiOut E{(const LAS float*)(F.lds + STASH_OFF), l == 0 ? a.in[I_X] : (const float*)(F.ws + WS_X1), lastl ? a.out : (float*)(F.ws + WS_X1), lastl ? nullptr : (bf16_t*)(F.ws + WS_XB), (float*)(F.ws + WS_SSQX)};
    pg8::gemm_phase<EpiOut, pg8::StaticOrder, true, true>(F.lds, g, S, E);
}

__device__ __forceinline__ void p5_final(const Frame& F, const Args& a) {
    const int gw = F.vcu * 8 + F.wave, NGW = F.G * 8; const f32x4* fw = (const f32x4*)a.in[I_FNW] + F.lane;
    for (int m = gw; m < MTOK; m += NGW) {
        const float s = wave_sum(((const float*)(F.ws + WS_SSQX))[(size_t)m * 64 + F.lane]); const float rstd = __builtin_amdgcn_rsqf(s * (1.f / DM) + EPS);
        f32x4* xr = (f32x4*)(a.out + (size_t)m * DM) + F.lane;
#pragma unroll
        for (int j = 0; j < 16; ++j) xr[64 * j] = xr[64 * j] * rstd * fw[64 * j];
    }
}

constexpr int NPH = 2 + 4 * DEPTH;
__global__ void __launch_bounds__(512, 2) mk_fwd(Args args) {
    extern __shared__ __attribute__((aligned(16))) unsigned char lds_raw[];
    cg::grid_group grid = cg::this_grid();
    Frame F; F.lds = (LAS unsigned char*)lds_raw; F.tid = threadIdx.x; F.lane = F.tid & 63; F.wave = __builtin_amdgcn_readfirstlane(F.tid >> 6);
    F.G = gridDim.x; { const int bx = blockIdx.x; F.vcu = (F.G % 8 == 0) ? (bx % 8) * (F.G / 8) + bx / 8 : bx; }
    F.ws = args.ws;
    for (int ph = args.ph_lo; ph < args.ph_hi; ++ph) {
        { int t_ = threadIdx.x; asm volatile("" : "+v"(t_)); F.tid = t_; F.lane = t_ & 63; F.wave = __builtin_amdgcn_readfirstlane(t_ >> 6);
          unsigned char* w_ = args.ws; asm volatile("" : "+s"(w_)); F.ws = w_; }
#ifndef PHMASK
#define PHMASK 63
#endif
        if (ph == 0) { if (PHMASK & 1) p0_prologue(F, args); }
        else if (ph == NPH - 1) { if (PHMASK & 32) p5_final(F, args); }
        else { const int l = (ph - 1) >> 2, s = (ph - 1) & 3;
            if (s == 0) { if (PHMASK & 2) p1_inproj(F, l); }
            else if (s == 1) {
#if FAST_SSM
                if (PHMASK & 4) p2_ssm(F, args, l);
#endif
            }
            else if (s == 2) { if (PHMASK & 8) p3_glu(F, args, l); }
            else { if (PHMASK & 16) p4_out(F, args, l); } }
        if (ph + 1 < args.ph_hi) grid.sync();
    }
}

__global__ void __launch_bounds__(64) naive_ssm(Args args, int l) {
    const int b = blockIdx.x >> 7, g = blockIdx.x & 127, lg = l * NG + g, n = threadIdx.x;
    const double dt = exp((double)args.in[I_LOGDT][lg]);
    const float lr = args.in[I_LRE][lg * 64 + n], li = args.in[I_LIM][lg * 64 + n];
    float ac, as; cis_d((double)li * dt, ac, as); const float mag = (float)exp((double)lr * dt); const float ar = mag * ac, ai = mag * as;
    const float nr = ar - 1.f, ni = ai, den = lr * lr + li * li, cor = (nr * lr + ni * li) / den, coi = (ni * lr - nr * li) / den;
    float bbr[16], bbi[16], cr[16], ci[16];
#pragma unroll
    for (int h = 0; h < 16; ++h) { const float br = args.in[I_BRE][(size_t)(lg * 64 + n) * 16 + h], bi = args.in[I_BIM][(size_t)(lg * 64 + n) * 16 + h];
        bbr[h] = cor * br - coi * bi; bbi[h] = cor * bi + coi * br; cr[h] = args.in[I_CRE][(size_t)(lg * 16 + h) * 64 + n]; ci[h] = args.in[I_CIM][(size_t)(lg * 16 + h) * 64 + n]; }
    const float dsk = args.in[I_D][(size_t)l * DS + g * 16 + (n & 15)];
    const bf16_t* a2g = (const bf16_t*)(args.ws + WS_A2U) + (size_t)g * 512 * A2LD; bf16_t* yg = (bf16_t*)(args.ws + WS_YG);
    float sr = 0.f, si = 0.f;
    for (int t = 0; t < SEQ; ++t) {
        const u32x4* up = (const u32x4*)(a2g + (size_t)(b * 128 + (t >> 4)) * A2LD + (t & 15) * 16); const u32x4 u0 = up[0], u1 = up[1];
        float uv[16];
        uv[0] = bf2f(u0.x & 0xffffu); uv[1] = bf2f(u0.x >> 16); uv[2] = bf2f(u0.y & 0xffffu); uv[3] = bf2f(u0.y >> 16); uv[4] = bf2f(u0.z & 0xffffu); uv[5] = bf2f(u0.z >> 16); uv[6] = bf2f(u0.w & 0xffffu); uv[7] = bf2f(u0.w >> 16);
        uv[8] = bf2f(u1.x & 0xffffu); uv[9] = bf2f(u1.x >> 16); uv[10] = bf2f(u1.y & 0xffffu); uv[11] = bf2f(u1.y >> 16); uv[12] = bf2f(u1.z & 0xffffu); uv[13] = bf2f(u1.z >> 16); uv[14] = bf2f(u1.w & 0xffffu); uv[15] = bf2f(u1.w >> 16);
        float bur = 0.f, bui = 0.f;
#pragma unroll
        for (int h = 0; h < 16; ++h) { bur += bbr[h] * uv[h]; bui += bbi[h] * uv[h]; }
        const float nsr = ar * sr - ai * si + bur, nsi = ar * si + ai * sr + bui; sr = nsr; si = nsi;
        float y = 0.f, um = 0.f;
#pragma unroll
        for (int h = 0; h < 16; ++h) { const float p = wave_sum(cr[h] * sr - ci[h] * si); if (n == h) { y = p; um = uv[h]; } }
        if (n < 16) yg[(size_t)(b * SEQ + t) * DS + g * 16 + n] = (bf16_t)f2bf(gelu_tanh_f(y + dsk * um));
    }
}

constexpr int NR_KLD = 264;
__global__ void __launch_bounds__(256) naive_ret(Args args, int l) {
    extern __shared__ __attribute__((aligned(16))) unsigned char sm[];
    bf16_t* Qs = (bf16_t*)sm;
    bf16_t* Ks = Qs + 32 * 256;
    float* Ss = (float*)(Ks + 64 * NR_KLD);
    float* red = Ss + 32 * 64;
    const int qt = blockIdx.x & 63, h = (blockIdx.x >> 6) & 7, b = blockIdx.x >> 9, tid = threadIdx.x, lane = tid & 63, wv = tid >> 6;
    const bf16_t* q = (const bf16_t*)(args.ws + WS_Q); const bf16_t* k = (const bf16_t*)(args.ws + WS_K); const bf16_t* vt = (const bf16_t*)(args.ws + WS_VT); const bf16_t* gr = (const bf16_t*)(args.ws + WS_GR);
    const int tok0 = b * SEQ + qt * 32;
    for (int e = tid; e < 32 * 32; e += 256) { const int r = e >> 5, c = (e & 31) * 8; *(u32x4*)(Qs + r * 256 + c) = *(const u32x4*)(q + (size_t)(tok0 + r) * DR + h * 256 + c); }
    const float lg2 = log2f(1.f - exp2f(-5.f - (float)h));
    float o[32];
#pragma unroll
    for (int r = 0; r < 32; ++r) o[r] = 0.f;
    const int ntile = qt / 2 + 1;
    for (int kt = 0; kt < ntile; ++kt) {
        __syncthreads();
        for (int e = tid; e < 64 * 32; e += 256) { const int r = e >> 5, c = (e & 31) * 8; *(u32x4*)(Ks + r * NR_KLD + c) = *(const u32x4*)(k + (size_t)(b * SEQ + kt * 64 + r) * DR + h * 256 + c); }
        __syncthreads();
        { const int key = lane, rg = wv; float acc[8];
#pragma unroll
          for (int r = 0; r < 8; ++r) acc[r] = 0.f;
          for (int d = 0; d < 256; d += 8) { const u32x4 kv = *(const u32x4*)(Ks + key * NR_KLD + d);
              const float k0 = bf2f(kv.x & 0xffffu), k1 = bf2f(kv.x >> 16), k2 = bf2f(kv.y & 0xffffu), k3 = bf2f(kv.y >> 16), k4 = bf2f(kv.z & 0xffffu), k5 = bf2f(kv.z >> 16), k6 = bf2f(kv.w & 0xffffu), k7 = bf2f(kv.w >> 16);
#pragma unroll
              for (int r = 0; r < 8; ++r) { const u32x4 qv = *(const u32x4*)(Qs + (rg * 8 + r) * 256 + d);
                  acc[r] += bf2f(qv.x & 0xffffu) * k0 + bf2f(qv.x >> 16) * k1 + bf2f(qv.y & 0xffffu) * k2 + bf2f(qv.y >> 16) * k3 + bf2f(qv.z & 0xffffu) * k4 + bf2f(qv.z >> 16) * k5 + bf2f(qv.w & 0xffffu) * k6 + bf2f(qv.w >> 16) * k7; } }
#pragma unroll
          for (int r = 0; r < 8; ++r) { const int i = qt * 32 + rg * 8 + r, j = kt * 64 + key; Ss[(rg * 8 + r) * 64 + key] = (i >= j) ? acc[r] * exp2f((float)(i - j) * lg2) : 0.f; } }
        __syncthreads();
        { const bf16_t* vr = vt + (size_t)(h * 256 + tid) * MTOK + b * SEQ + kt * 64;
          for (int kk = 0; kk < 64; kk += 8) { const u32x4 vv = *(const u32x4*)(vr + kk);
              const float v0 = bf2f(vv.x & 0xffffu), v1 = bf2f(vv.x >> 16), v2 = bf2f(vv.y & 0xffffu), v3 = bf2f(vv.y >> 16), v4 = bf2f(vv.z & 0xffffu), v5 = bf2f(vv.z >> 16), v6 = bf2f(vv.w & 0xffffu), v7 = bf2f(vv.w >> 16);
#pragma unroll
              for (int r = 0; r < 32; ++r) { const f32x4 s0 = *(const f32x4*)(Ss + r * 64 + kk), s1 = *(const f32x4*)(Ss + r * 64 + kk + 4);
                  o[r] += s0[0] * v0 + s0[1] * v1 + s0[2] * v2 + s0[3] * v3 + s1[0] * v4 + s1[1] * v5 + s1[2] * v6 + s1[3] * v7; } } }
    }
    __syncthreads();
#pragma unroll
    for (int r = 0; r < 32; ++r) { const float p = wave_sum(o[r] * o[r]); if (lane == 0) red[r * 4 + wv] = p; }
    __syncthreads();
    bf16_t* ycat = (bf16_t*)(args.ws + WS_YCAT);
#pragma unroll
    for (int r = 0; r < 32; ++r) { const float ss = (red[r * 4] + red[r * 4 + 1]) + (red[r * 4 + 2] + red[r * 4 + 3]); const float rstd = __builtin_amdgcn_rsqf(ss * (1.f / 256.f) + EPS);
        const size_t tok = (size_t)(tok0 + r); ycat[tok * DM + DS + h * 256 + tid] = (bf16_t)f2bf(o[r] * rstd * bf2f(gr[tok * DR + h * 256 + tid])); }
}

extern "C" void kernel_launch(void* const* d_in, const int* in_sizes, int n_in, void* d_out, int out_size, void* d_ws, size_t ws_size, hipStream_t stream) {
    static int grid = 0;
    if (grid == 0) {
        if (n_in != 17 || in_sizes[0] != MTOK * DM || out_size != MTOK * DM || ws_size < WS_END) { fprintf(stderr, "kernel_launch: unexpected problem (n_in %d, x %d, out %d, ws %zu)\n", n_in, n_in > 0 ? in_sizes[0] : -1, out_size, ws_size); grid = -1; return; }
        int dev = 0, cus = 0, per_cu = 0;
        hipGetDevice(&dev); hipDeviceGetAttribute(&cus, hipDeviceAttributeMultiprocessorCount, dev);
        if (hipFuncSetAttribute((const void*)mk_fwd, hipFuncAttributeMaxDynamicSharedMemorySize, LDS_BYTES) != hipSuccess) { fprintf(stderr, "kernel_launch: hipFuncSetAttribute failed\n"); grid = -1; return; }
        hipFuncSetAttribute((const void*)naive_ret, hipFuncAttributeMaxDynamicSharedMemorySize, 65536);
        hipOccupancyMaxActiveBlocksPerMultiprocessor(&per_cu, (const void*)mk_fwd, 512, LDS_BYTES);
        (void)hipGetLastError();
        if (per_cu < 1) fprintf(stderr, "kernel_launch: occupancy query says %d blocks per CU\n", per_cu);
        grid = cus;
        if (grid != 256) fprintf(stderr, "kernel_launch: %d CUs (phase balance assumes 256)\n", grid);
        for (int c = 0; c < grid; ++c) { pg8::StaticOrder S; Unit u0, u;
            S.init(MTOK, 10240, grid, c); S.next(0, u0); for (int i = 1; S.next(i, u); ++i) if (u.pm != u0.pm) { fprintf(stderr, "kernel_launch: in-proj unit order breaks the one-panel-per-workgroup assumption\n"); grid = -1; return; }
            S.init(DR, MTOK, grid, c); S.next(0, u0); for (int i = 1; S.next(i, u); ++i) if (u.pn != u0.pn) { fprintf(stderr, "kernel_launch: V^T unit order breaks the assumption\n"); grid = -1; return; }
            S.init(MTOK, DM, grid, c); S.next(0, u0); for (int i = 1; S.next(i, u); ++i) if (u.pm != u0.pm) { fprintf(stderr, "kernel_launch: out-proj unit order breaks the assumption\n"); grid = -1; return; } }
    }
    if (grid < 0) return;
    Args a{};
    for (int i = 0; i < 17; ++i) a.in[i] = (const float*)d_in[i];
    a.out = (float*)d_out; a.ws = (unsigned char*)d_ws;
    auto launch = [&](int lo, int hi) { a.ph_lo = lo; a.ph_hi = hi; void* kargs[] = {&a};
        hipError_t e = hipLaunchCooperativeKernel((const void*)mk_fwd, dim3(grid), dim3(512), kargs, LDS_BYTES, stream);
        if (e != hipSuccess) fprintf(stderr, "kernel_launch: cooperative launch [%d,%d) failed: %s\n", lo, hi, hipGetErrorString(e)); };
#if FAST_SSM && FAST_RET
    launch(0, NPH);
#else
    launch(0, 1);
    for (int l = 0; l < DEPTH; ++l) {
        launch(1 + 4 * l, 2 + 4 * l);
        launch(2 + 4 * l, 3 + 4 * l);
#if !FAST_SSM
        hipLaunchKernelGGL(naive_ssm, dim3(BATCH * NG), dim3(64), 0, stream, a, l);
#endif
#if !FAST_RET
        hipLaunchKernelGGL(naive_ret, dim3(BATCH * RH * 64), dim3(256), 32 * 256 * 2 + 64 * NR_KLD * 2 + 32 * 64 * 4 + 32 * 4 * 4, stream, a, l);
#endif
        launch(3 + 4 * l, 4 + 4 * l);
        launch(4 + 4 * l, 5 + 4 * l);
    }
    launch(NPH - 1, NPH);
#endif
}
```

```cpp
#include <hip/hip_runtime.h>
#include <hip/hip_cooperative_groups.h>
#include <cstdio>
#include <cstdint>
namespace cg = cooperative_groups;

#ifndef FAST_SSM
#define FAST_SSM 1
#endif
#ifndef FAST_RET
#define FAST_RET 1
#endif

#ifndef ONE_LAUNCH
#define ONE_LAUNCH 1
#endif

#define LAS __attribute__((address_space(3)))
typedef unsigned short bf16_t;
typedef short bf16x8 __attribute__((ext_vector_type(8)));
typedef float f32x4 __attribute__((ext_vector_type(4)));
typedef float f32x2 __attribute__((ext_vector_type(2)));
typedef unsigned u32x4 __attribute__((ext_vector_type(4)));
typedef unsigned u32x2 __attribute__((ext_vector_type(2)));

constexpr int BATCH = 4, SEQ = 2048, DM = 4096, DEPTH = 2, DS = 2048, DR = 2048, NG = 128, SG = 16, NST = 64, RH = 8, RD = 256;
constexpr int NPROJ = 12288, MTOK = BATCH * SEQ;
constexpr float EPS = 1e-6f;
constexpr int TCH = 16;
constexpr int A2LD = 384;

constexpr size_t MiB = 1u << 20;
constexpr size_t WS_CTL = 0;
constexpr size_t WS_WTIN = 16 * MiB;
constexpr size_t WS_WTGLU = 208 * MiB;
constexpr size_t WS_WTOUT = 224 * MiB;
constexpr size_t WS_BT2 = 288 * MiB;
constexpr size_t WS_PM = 336 * MiB;
constexpr size_t WS_A16 = 368 * MiB;
constexpr size_t WS_ROPE = 369 * MiB;
constexpr size_t WS_SSQX = 371 * MiB;
constexpr size_t WS_SSQ2 = 373 * MiB;
constexpr size_t WS_XB = 384 * MiB;
constexpr size_t WS_X1 = 448 * MiB;
constexpr size_t WS_A2U = 576 * MiB;
constexpr size_t WS_GS = 624 * MiB, WS_Q = 656 * MiB, WS_K = 688 * MiB, WS_VT = 720 * MiB, WS_GR = 752 * MiB, WS_YG = 784 * MiB;
constexpr size_t WS_YCAT = 816 * MiB;
constexpr size_t WS_END = 880 * MiB;

constexpr int RING_BYTES = 131072;
constexpr int STASH_OFF = 155648;
constexpr int LDS_BYTES = 163840 - 4096;

__device__ __forceinline__ unsigned f2bf(float f) { unsigned u = __builtin_bit_cast(unsigned, f); return (u + 0x7fffu + ((u >> 16) & 1u)) >> 16; }
__device__ __forceinline__ unsigned pk2(float lo, float hi) { return f2bf(lo) | (f2bf(hi) << 16); }
__device__ __forceinline__ float bf2f(unsigned v) { return __builtin_bit_cast(float, v << 16); }
__device__ __forceinline__ unsigned cvt_pk_bf16(float lo, float hi) { unsigned r; asm volatile("v_cvt_pk_bf16_f32 %0, %1, %2" : "=v"(r) : "v"(lo), "v"(hi)); return r; }
__device__ __forceinline__ float silu_f(float x) { return x * __builtin_amdgcn_rcpf(1.f + __expf(-x)); }
__device__ __forceinline__ float sigmoid_f(float x) { return __builtin_amdgcn_rcpf(1.f + __expf(-x)); }
__device__ __forceinline__ float gelu_tanh_f(float x) {
    const float z = 0.7978845608028654f * (x + 0.044715f * x * x * x);
    const float th = 1.f - 2.f * __builtin_amdgcn_rcpf(1.f + __expf(2.f * z));
    return 0.5f * x * (1.f + th);
}
template <int X> __device__ __forceinline__ float xor_add(float v) {
    if constexpr (X == 32) { const unsigned u = __builtin_bit_cast(unsigned, v); auto r = __builtin_amdgcn_permlane32_swap(u, u, false, false);
        return __builtin_bit_cast(float, (unsigned)r[0]) + __builtin_bit_cast(float, (unsigned)r[1]); }
    else return v + __builtin_bit_cast(float, __builtin_amdgcn_ds_swizzle(__builtin_bit_cast(int, v), (X << 10) | 0x1f));
}
__device__ __forceinline__ float wave_sum(float v) {
    v = xor_add<1>(v); v = xor_add<2>(v); v = xor_add<4>(v); v = xor_add<8>(v); v = xor_add<16>(v); v = xor_add<32>(v);
    return v;
}
__device__ __forceinline__ void cis_d(double ph, float& c, float& s) {
    const double rv = ph * 0.15915494309189535;
    const float r = (float)(rv - __builtin_rint(rv));
    c = __builtin_amdgcn_cosf(r); s = __builtin_amdgcn_sinf(r);
}
#define LDS_WAIT() asm volatile("s_waitcnt lgkmcnt(0)" ::: "memory")
#define VM_WAIT() asm volatile("s_waitcnt vmcnt(0)" ::: "memory")

namespace pg8 {
constexpr int BM = 256, BK = 64, HALF = 128, HTB = HALF * BK * 2, STAGE_BYTES = 8 * HTB, NXCD = 8, WGM = 8;
__host__ __device__ __forceinline__ int lds_byte(int r, int c) { const int st = (r >> 4) * 2 + (c >> 5), rr = r & 15, cc = c & 31, ob = rr * 64 + cc * 2; return st * 1024 + (ob ^ (((ob >> 9) & 1) << 5)); }
__host__ __device__ __forceinline__ void stage_rc(int b, int& R, int& C) { const int st = b / 1024, sb = b % 1024, swz = sb ^ (((sb >> 9) & 1) << 5); R = (st >> 1) * 16 + swz / 64; C = (st & 1) * 32 + (swz % 64) / 2; }
__host__ __device__ __forceinline__ int perm32(int rho) { const int n = rho >> 4, i = rho & 15; return 8 * (i >> 2) + 4 * n + (i & 3); }

struct Unit { int pm, pn; };
struct Gemm { const bf16_t* A; const bf16_t* Bt; int K, lda, ldb, kmid; };

struct StaticOrder {
    int nM, nN, nwg, G, c;
    __host__ __device__ void init(int M, int N, int G_, int c_) { nM = M / BM; nN = N / BM; nwg = nM * nN; G = G_; c = c_; }
    __host__ __device__ bool next(int i, Unit& u) const {
        const long L = (long)i * G + c; if (L >= nwg) return false;
        int wgid = (int)L; { const int q = nwg / NXCD, r = nwg % NXCD, xcd = wgid % NXCD, off = wgid / NXCD; wgid = (xcd < r ? xcd * (q + 1) : r * (q + 1) + (xcd - r) * q) + off; }
        const int nig = WGM * nN, gid = wgid / nig, fm = gid * WGM, gsz = (nM - fm) < WGM ? (nM - fm) : WGM;
        u.pm = fm + ((wgid % nig) % gsz); u.pn = (wgid % nig) / gsz; return true;
    }
};
struct OneUnit {
    int pm, pn;
    __device__ __forceinline__ bool next(int i, Unit& u) const { if (i) return false; u.pm = pm; u.pn = pn; return true; }
};

template <class Epi, class Sched, bool ALIGN_EPI, bool SP2>
__device__ __forceinline__ void gemm_phase(LAS unsigned char* lds, const Gemm g, const Sched& S, const Epi& E, int tid_in) {
    int tid_ = tid_in; asm volatile("" : "+v"(tid_));
    const int tid = tid_, wid = __builtin_amdgcn_readfirstlane(tid >> 6), lane = tid & 63, wr = wid >> 2, wc = wid & 3, fr = lane & 15, fq = lane >> 4;
    const int K = g.K, nt = K / BK;
    unsigned voffA[2], voffB[2];
#pragma unroll
    for (int i = 0; i < 2; ++i) { int R, C; stage_rc(tid * 16 + i * 8192, R, C); const int Rb = Epi::PERM ? ((R & ~31) + perm32(R & 31)) : R;
        voffA[i] = (unsigned)(R * g.lda + C) * 2u; voffB[i] = (unsigned)(Rb * g.ldb + C) * 2u; }
    const size_t kstep = (size_t)(BK * 2);
    const size_t hstepA = (size_t)HALF * g.lda * 2, hstepB = (size_t)HALF * g.ldb * 2;
    const size_t tstepA = 2 * hstepA, tstepB = 2 * hstepB;
    const unsigned ldsw = (unsigned)wid * 1024u;
    const int aoff = lds_byte(wr * 64 + fr, fq * 8), boff = lds_byte(wc * 32 + fr, fq * 8);
#define PG8_SA(b, h) (((b) * 2 + (h)) * HTB)
#define PG8_SB(b, h) ((4 + (b) * 2 + (h)) * HTB)
#define PG8_STAGE(bufoff, gbase, voff) do { _Pragma("unroll") for (int _i = 0; _i < 2; ++_i) \
        __builtin_amdgcn_global_load_lds((const unsigned*)((const char*)(gbase) + (voff)[_i]), (LAS unsigned*)(lds + (bufoff) + ldsw + _i * 8192), 16, 0, 0); } while (0)
#define PG8_LDA(dst, b, h) do { _Pragma("unroll") for (int m = 0; m < 4; ++m) _Pragma("unroll") for (int k = 0; k < 2; ++k) dst[m][k] = *(const LAS bf16x8*)(lds + PG8_SA(b, h) + aoff + m * 2048 + k * 1024); } while (0)
#define PG8_LDB(dst, b, h) do { _Pragma("unroll") for (int n = 0; n < 2; ++n) _Pragma("unroll") for (int k = 0; k < 2; ++k) dst[n][k] = *(const LAS bf16x8*)(lds + PG8_SB(b, h) + boff + n * 2048 + k * 1024); } while (0)
#define PG8_MMA(ai, bj, At, Bt) do { __builtin_amdgcn_s_setprio(1); _Pragma("unroll") for (int m = 0; m < 4; ++m) _Pragma("unroll") for (int n = 0; n < 2; ++n) _Pragma("unroll") for (int k = 0; k < 2; ++k) \
        acc[ai][bj][m][n] = __builtin_amdgcn_mfma_f32_16x16x32_bf16(Bt[n][k], At[m][k], acc[ai][bj][m][n], 0, 0, 0); __builtin_amdgcn_s_setprio(0); } while (0)
#define PG8_WAIT_V(n) asm volatile("s_waitcnt vmcnt(" #n ")" ::: "memory")
#define PG8_WAIT_L(n) asm volatile("s_waitcnt lgkmcnt(" #n ")" ::: "memory")
#define PG8_BAR __builtin_amdgcn_s_barrier()
#define PG8_SCHED __builtin_amdgcn_sched_barrier(0)
    Unit cur, nxt; int ui = 0;
    if (!S.next(0, cur)) return;
    f32x4 acc[2][2][4][2];
#pragma unroll
    for (int a = 0; a < 2; ++a)
#pragma unroll
        for (int b = 0; b < 2; ++b)
#pragma unroll
            for (int m = 0; m < 4; ++m)
#pragma unroll
                for (int n = 0; n < 2; ++n) acc[a][b][m][n] = (f32x4){0.f, 0.f, 0.f, 0.f};
    bf16x8 At[4][2], B0[2][2], B1[2][2];
    const char* cA = (const char*)g.A + (size_t)cur.pm * tstepA; const char* cB = (const char*)g.Bt + (size_t)cur.pn * tstepB;
    if constexpr (SP2) {
        PG8_STAGE(PG8_SB(0, 0), cB, voffB); PG8_STAGE(PG8_SB(0, 1), cB + hstepB, voffB); PG8_STAGE(PG8_SA(0, 0), cA, voffA); PG8_STAGE(PG8_SA(0, 1), cA + hstepA, voffA);
        if (wr == 1) PG8_BAR;
        PG8_WAIT_V(2); PG8_BAR;
        PG8_STAGE(PG8_SB(1, 0), cB + kstep, voffB); PG8_STAGE(PG8_SA(1, 0), cA + kstep, voffA); PG8_STAGE(PG8_SB(1, 1), cB + hstepB + kstep, voffB);
        PG8_WAIT_V(6); PG8_BAR;
    } else {
        PG8_STAGE(PG8_SB(0, 0), cB, voffB); PG8_STAGE(PG8_SA(0, 0), cA, voffA); PG8_STAGE(PG8_SB(0, 1), cB + hstepB, voffB); PG8_STAGE(PG8_SA(0, 1), cA + hstepA, voffA);
        if (wr == 1) PG8_BAR;
        PG8_WAIT_V(4); PG8_BAR;
        PG8_STAGE(PG8_SB(1, 0), cB + kstep, voffB); PG8_STAGE(PG8_SA(1, 0), cA + kstep, voffA); PG8_STAGE(PG8_SB(1, 1), cB + hstepB + kstep, voffB);
        PG8_WAIT_V(6); PG8_BAR;
    }
    for (;;) {
        const bool has_next = S.next(ui + 1, nxt);
        const char* nA = has_next ? (const char*)g.A + (size_t)nxt.pm * tstepA : cA; const char* nB = has_next ? (const char*)g.Bt + (size_t)nxt.pn * tstepB : cB;
        for (int t = 0; t < nt; t += 2) {
            const bool last = (t == nt - 2);
            const char* a1 = cA + (size_t)(t + 1) * kstep;
            const char* a2 = last ? nA : cA + (size_t)(t + 2) * kstep; const char* b2 = last ? nB : cB + (size_t)(t + 2) * kstep;
            const char* a3 = a2 + kstep; const char* b3 = b2 + kstep;
            if constexpr (Epi::MIDK) { if (t == g.kmid) E.midk(acc, wr, fr); }
            if constexpr (SP2) {
            PG8_LDB(B0, 0, 0); PG8_LDB(B1, 0, 1); PG8_SCHED; PG8_LDA(At, 0, 0); PG8_STAGE(PG8_SA(1, 1), a1 + hstepA, voffA);
            PG8_WAIT_V(8); PG8_WAIT_L(0); PG8_BAR; PG8_MMA(0, 0, At, B0); PG8_MMA(0, 1, At, B1); PG8_BAR; PG8_SCHED;
            PG8_LDA(At, 0, 1); PG8_STAGE(PG8_SB(0, 0), b2, voffB); PG8_STAGE(PG8_SB(0, 1), b2 + hstepB, voffB); PG8_STAGE(PG8_SA(0, 0), a2, voffA);
            PG8_WAIT_V(8); PG8_WAIT_L(0); PG8_BAR; PG8_MMA(1, 0, At, B0); PG8_MMA(1, 1, At, B1); PG8_BAR; PG8_SCHED;
            PG8_LDB(B0, 1, 0); PG8_LDB(B1, 1, 1); PG8_SCHED; PG8_LDA(At, 1, 0); PG8_STAGE(PG8_SA(0, 1), a2 + hstepA, voffA);
            PG8_WAIT_V(8); PG8_WAIT_L(0); PG8_BAR; PG8_MMA(0, 0, At, B0); PG8_MMA(0, 1, At, B1); PG8_BAR; PG8_SCHED;
            PG8_LDA(At, 1, 1); PG8_STAGE(PG8_SB(1, 0), b3, voffB); PG8_STAGE(PG8_SB(1, 1), b3 + hstepB, voffB); PG8_STAGE(PG8_SA(1, 0), a3, voffA);
            PG8_WAIT_V(8); PG8_WAIT_L(0); PG8_BAR; PG8_MMA(1, 0, At, B0); PG8_MMA(1, 1, At, B1); PG8_BAR; PG8_SCHED;
            } else {
            PG8_LDB(B0, 0, 0); PG8_SCHED; PG8_LDA(At, 0, 0); PG8_STAGE(PG8_SA(1, 1), a1 + hstepA, voffA);
            PG8_WAIT_L(8); PG8_BAR; PG8_WAIT_L(0); PG8_MMA(0, 0, At, B0); PG8_BAR; PG8_SCHED;
            PG8_LDB(B1, 0, 1); PG8_STAGE(PG8_SB(0, 0), b2, voffB);
            PG8_BAR; PG8_WAIT_L(0); PG8_MMA(0, 1, At, B1); PG8_BAR;
            PG8_LDA(At, 0, 1); PG8_STAGE(PG8_SA(0, 0), a2, voffA);
            PG8_BAR; PG8_WAIT_L(0); PG8_MMA(1, 0, At, B0); PG8_BAR; PG8_SCHED;
            PG8_STAGE(PG8_SB(0, 1), b2 + hstepB, voffB);
            PG8_WAIT_V(6); PG8_BAR; PG8_MMA(1, 1, At, B1); PG8_BAR;
            PG8_LDB(B0, 1, 0); PG8_SCHED; PG8_LDA(At, 1, 0); PG8_STAGE(PG8_SA(0, 1), a2 + hstepA, voffA);
            PG8_WAIT_L(8); PG8_BAR; PG8_WAIT_L(0); PG8_MMA(0, 0, At, B0); PG8_BAR; PG8_SCHED;
            PG8_LDB(B1, 1, 1); PG8_STAGE(PG8_SB(1, 0), b3, voffB);
            PG8_BAR; PG8_WAIT_L(0); PG8_MMA(0, 1, At, B1); PG8_BAR;
            PG8_LDA(At, 1, 1); PG8_STAGE(PG8_SA(1, 0), a3, voffA);
            PG8_BAR; PG8_WAIT_L(0); PG8_MMA(1, 0, At, B0); PG8_BAR; PG8_SCHED;
            PG8_STAGE(PG8_SB(1, 1), b3 + hstepB, voffB);
            PG8_WAIT_V(6); PG8_BAR; PG8_MMA(1, 1, At, B1); PG8_BAR;
            }
        }
        if constexpr (ALIGN_EPI) { if (wr == 0) PG8_BAR; }
        if constexpr (!Epi::AFTER_DRAIN) { E(acc, cur, wr, wc, fr, fq); }
        if (!has_next) break;
#pragma unroll
        for (int a = 0; a < 2; ++a)
#pragma unroll
            for (int b = 0; b < 2; ++b)
#pragma unroll
                for (int m = 0; m < 4; ++m)
#pragma unroll
                    for (int n = 0; n < 2; ++n) acc[a][b][m][n] = (f32x4){0.f, 0.f, 0.f, 0.f};
        cur = nxt; cA = nA; cB = nB; ++ui;
        if constexpr (ALIGN_EPI) { if (wr == 1) PG8_BAR; }
    }
    PG8_WAIT_V(0);
    if constexpr (!ALIGN_EPI) { if (wr == 0) PG8_BAR; }
    PG8_BAR;
    if constexpr (Epi::AFTER_DRAIN) { E.fused(acc, cur, wr, wc, fr, fq, lds); }
#undef PG8_SA
#undef PG8_SB
#undef PG8_STAGE
#undef PG8_LDA
#undef PG8_LDB
#undef PG8_MMA
#undef PG8_WAIT_V
#undef PG8_WAIT_L
#undef PG8_BAR
#undef PG8_SCHED
}
}
using pg8::Unit;
typedef f32x4 Acc[2][2][4][2];

struct EpiInProj {
    static constexpr bool PERM = true, AFTER_DRAIN = false, MIDK = false;
    const LAS float* rs; bf16_t *a2u, *gs, *q, *k, *gr; const float* rope;
    __device__ __forceinline__ void operator()(const Acc& acc, const Unit& u, int wr, int wc, int fr, int fq) const {
        asm volatile("" : "+v"(fr), "+v"(fq));
        const int type = u.pn >> 3, colt = (u.pn & 7) << 8, c8 = wc * 32 + 8 * fq;
#pragma unroll
        for (int ai = 0; ai < 2; ++ai)
#pragma unroll
            for (int m = 0; m < 4; ++m) {
                const int lr = wr * 64 + fr + ai * 128 + m * 16, r = u.pm * 256 + lr; const float s = rs[lr];
                f32x4 v[2][2];
#pragma unroll
                for (int bj = 0; bj < 2; ++bj)
#pragma unroll
                    for (int n = 0; n < 2; ++n) v[bj][n] = acc[ai][bj][m][n] * s;
                if (type == 0) {
#pragma unroll
                    for (int bj = 0; bj < 2; ++bj) { const int col = colt + bj * 128 + c8;
                        u32x4 w; w.x = cvt_pk_bf16(v[bj][0][0], v[bj][0][1]); w.y = cvt_pk_bf16(v[bj][0][2], v[bj][0][3]); w.z = cvt_pk_bf16(v[bj][1][0], v[bj][1][1]); w.w = cvt_pk_bf16(v[bj][1][2], v[bj][1][3]);
                        *(u32x4*)(a2u + ((size_t)((col >> 4) * 512 + (r >> 4)) * A2LD + (r & 15) * 16 + (col & 15))) = w; }
                } else if (type == 1 || type == 4) {
                    bf16_t* dst = (type == 1 ? gs : gr) + (size_t)r * 2048 + colt + c8;
#pragma unroll
                    for (int bj = 0; bj < 2; ++bj) {
                        u32x4 w; w.x = cvt_pk_bf16(silu_f(v[bj][0][0]), silu_f(v[bj][0][1])); w.y = cvt_pk_bf16(silu_f(v[bj][0][2]), silu_f(v[bj][0][3]));
                        w.z = cvt_pk_bf16(silu_f(v[bj][1][0]), silu_f(v[bj][1][1])); w.w = cvt_pk_bf16(silu_f(v[bj][1][2]), silu_f(v[bj][1][3]));
                        *(u32x4*)(dst + bj * 128) = w; }
                } else {
                    const float sc = (type == 3) ? 0.0625f : 1.f;
                    const f32x4* cs = (const f32x4*)(rope + ((size_t)(r & 2047) * 128 + c8) * 2);
                    float o1[8], o2[8];
#pragma unroll
                    for (int jj = 0; jj < 4; ++jj) { const f32x4 t = cs[jj];
                        const float a0 = v[0][jj >> 1][(jj & 1) * 2], b0 = v[1][jj >> 1][(jj & 1) * 2], a1 = v[0][jj >> 1][(jj & 1) * 2 + 1], b1 = v[1][jj >> 1][(jj & 1) * 2 + 1];
                        o1[2 * jj] = (a0 * t[0] - b0 * t[1]) * sc; o2[2 * jj] = (b0 * t[0] + a0 * t[1]) * sc;
                        o1[2 * jj + 1] = (a1 * t[2] - b1 * t[3]) * sc; o2[2 * jj + 1] = (b1 * t[2] + a1 * t[3]) * sc; }
                    bf16_t* dst = (type == 2 ? q : k) + (size_t)r * 2048 + colt + c8;
                    u32x4 w; w.x = cvt_pk_bf16(o1[0], o1[1]); w.y = cvt_pk_bf16(o1[2], o1[3]); w.z = cvt_pk_bf16(o1[4], o1[5]); w.w = cvt_pk_bf16(o1[6], o1[7]);
                    *(u32x4*)dst = w;
                    w.x = cvt_pk_bf16(o2[0], o2[1]); w.y = cvt_pk_bf16(o2[2], o2[3]); w.z = cvt_pk_bf16(o2[4], o2[5]); w.w = cvt_pk_bf16(o2[6], o2[7]);
                    *(u32x4*)(dst + 128) = w;
                }
                asm volatile("" ::: "memory");
            }
    }
};
struct EpiVT {
    static constexpr bool PERM = true, AFTER_DRAIN = false, MIDK = false;
    const LAS float* rs; bf16_t* vt;
    __device__ __forceinline__ void operator()(const Acc& acc, const Unit& u, int wr, int wc, int fr, int fq) const {
        asm volatile("" : "+v"(fr), "+v"(fq));
        f32x4 sv[2][2];
#pragma unroll
        for (int bj = 0; bj < 2; ++bj)
#pragma unroll
            for (int n = 0; n < 2; ++n) sv[bj][n] = *(const LAS f32x4*)(rs + bj * 128 + wc * 32 + 8 * fq + 4 * n);
#pragma unroll
        for (int ai = 0; ai < 2; ++ai)
#pragma unroll
            for (int m = 0; m < 4; ++m) { bf16_t* dst = vt + (size_t)(u.pm * 256 + wr * 64 + fr + ai * 128 + m * 16) * MTOK + u.pn * 256 + wc * 32 + 8 * fq;
#pragma unroll
                for (int bj = 0; bj < 2; ++bj) { const f32x4 a = acc[ai][bj][m][0] * sv[bj][0], b = acc[ai][bj][m][1] * sv[bj][1];
                    u32x4 w; w.x = cvt_pk_bf16(a[0], a[1]); w.y = cvt_pk_bf16(a[2], a[3]); w.z = cvt_pk_bf16(b[0], b[1]); w.w = cvt_pk_bf16(b[2], b[3]);
                    *(u32x4*)(dst + bj * 128) = w; } }
    }
};
constexpr int SLD = 132;
struct EpiSloc {
    static constexpr bool PERM = false, AFTER_DRAIN = true, MIDK = false;
    __device__ __forceinline__ void fused(const Acc& acc, const Unit&, int wr, int wc, int fr, int fq, LAS unsigned char* lds) const {
        asm volatile("" : "+v"(fr), "+v"(fq));
        LAS float* S = (LAS float*)lds;
#pragma unroll
        for (int ai = 0; ai < 2; ++ai)
#pragma unroll
            for (int m = 0; m < 4; ++m)
#pragma unroll
                for (int n = 0; n < 2; ++n) *(LAS f32x4*)(S + (ai * 128 + wr * 64 + m * 16 + fr) * SLD + wc * 32 + n * 16 + 4 * fq) = acc[ai][0][m][n];
    }
};
struct EpiSsmOut {
    static constexpr bool PERM = true, AFTER_DRAIN = false, MIDK = false;
    const bf16_t* a2g; const float* dsk; bf16_t* yg; int g;
    __device__ __forceinline__ void operator()(const Acc& acc, const Unit& u, int wr, int wc, int fr, int fq) const {
        asm volatile("" : "+v"(fr), "+v"(fq));
        const int h0 = 8 * (fq & 1);
        const f32x4 d0 = *(const f32x4*)(dsk + h0), d1 = *(const f32x4*)(dsk + h0 + 4);
#pragma unroll
        for (int ai = 0; ai < 2; ++ai)
#pragma unroll
            for (int m = 0; m < 4; ++m) { const int row = u.pm * 256 + ai * 128 + wr * 64 + m * 16 + fr;
#pragma unroll
                for (int bj = 0; bj < 2; ++bj) { const int col = bj * 128 + wc * 32 + 8 * fq, tl = col >> 4;
                    const u32x4 uu = *(const u32x4*)(a2g + (size_t)row * A2LD + col);
                    const f32x4 a = acc[ai][bj][m][0], b = acc[ai][bj][m][1];
                    float y[8];
                    y[0] = a[0] + d0[0] * bf2f(uu.x & 0xffffu); y[1] = a[1] + d0[1] * bf2f(uu.x >> 16); y[2] = a[2] + d0[2] * bf2f(uu.y & 0xffffu); y[3] = a[3] + d0[3] * bf2f(uu.y >> 16);
                    y[4] = b[0] + d1[0] * bf2f(uu.z & 0xffffu); y[5] = b[1] + d1[1] * bf2f(uu.z >> 16); y[6] = b[2] + d1[2] * bf2f(uu.w & 0xffffu); y[7] = b[3] + d1[3] * bf2f(uu.w >> 16);
#pragma unroll
                    for (int j = 0; j < 8; ++j) y[j] = gelu_tanh_f(y[j]);
                    u32x4 w; w.x = cvt_pk_bf16(y[0], y[1]); w.y = cvt_pk_bf16(y[2], y[3]); w.z = cvt_pk_bf16(y[4], y[5]); w.w = cvt_pk_bf16(y[6], y[7]);
                    *(u32x4*)(yg + (size_t)(row * 16 + tl) * DS + g * 16 + h0) = w; }
                asm volatile("" ::: "memory"); }
    }
};
struct EpiGlu {
    static constexpr bool PERM = true, AFTER_DRAIN = false, MIDK = false;
    const bf16_t* yg; const bf16_t* gs; const float* bias; bf16_t* ycat; float* ssq2;
    __device__ __forceinline__ void operator()(const Acc& acc, const Unit& u, int wr, int wc, int fr, int fq) const {
        asm volatile("" : "+v"(fr), "+v"(fq));
        const int col0 = u.pn * 256 + wc * 32 + 8 * fq;
        f32x4 bv[2][2];
#pragma unroll
        for (int bj = 0; bj < 2; ++bj)
#pragma unroll
            for (int n = 0; n < 2; ++n) bv[bj][n] = *(const f32x4*)(bias + col0 + bj * 128 + 4 * n);
#pragma unroll
        for (int ai = 0; ai < 2; ++ai)
#pragma unroll
            for (int m = 0; m < 4; ++m) { const int r = u.pm * 256 + ai * 128 + wr * 64 + m * 16 + fr; float ss = 0.f;
#pragma unroll
                for (int bj = 0; bj < 2; ++bj) { const size_t off = (size_t)r * DS + col0 + bj * 128;
                    const u32x4 yy = *(const u32x4*)(yg + off), gg = *(const u32x4*)(gs + off);
                    const f32x4 a = acc[ai][bj][m][0] + bv[bj][0], b = acc[ai][bj][m][1] + bv[bj][1];
                    float z[8];
                    z[0] = bf2f(yy.x & 0xffffu) * sigmoid_f(a[0]); z[1] = bf2f(yy.x >> 16) * sigmoid_f(a[1]); z[2] = bf2f(yy.y & 0xffffu) * sigmoid_f(a[2]); z[3] = bf2f(yy.y >> 16) * sigmoid_f(a[3]);
                    z[4] = bf2f(yy.z & 0xffffu) * sigmoid_f(b[0]); z[5] = bf2f(yy.z >> 16) * sigmoid_f(b[1]); z[6] = bf2f(yy.w & 0xffffu) * sigmoid_f(b[2]); z[7] = bf2f(yy.w >> 16) * sigmoid_f(b[3]);
#pragma unroll
                    for (int j = 0; j < 8; ++j) ss += z[j] * z[j];
                    z[0] *= bf2f(gg.x & 0xffffu); z[1] *= bf2f(gg.x >> 16); z[2] *= bf2f(gg.y & 0xffffu); z[3] *= bf2f(gg.y >> 16);
                    z[4] *= bf2f(gg.z & 0xffffu); z[5] *= bf2f(gg.z >> 16); z[6] *= bf2f(gg.w & 0xffffu); z[7] *= bf2f(gg.w >> 16);
                    u32x4 w; w.x = cvt_pk_bf16(z[0], z[1]); w.y = cvt_pk_bf16(z[2], z[3]); w.z = cvt_pk_bf16(z[4], z[5]); w.w = cvt_pk_bf16(z[6], z[7]);
                    *(u32x4*)(ycat + (size_t)r * DM + col0 + bj * 128) = w; }
                ss = xor_add<16>(ss); ss = xor_add<32>(ss);
                if (fq == 0) ssq2[(size_t)r * 32 + u.pn * 4 + wc] = ss;
                asm volatile("" ::: "memory"); }
    }
};
struct EpiOut {
    static constexpr bool PERM = false, AFTER_DRAIN = false, MIDK = true;
    const LAS float* rs2; const float* res; float* out; bf16_t* xb; float* ssq;
    __device__ __forceinline__ void midk(Acc& acc, int wr, int fr) const {
        asm volatile("" : "+v"(fr));
#pragma unroll
        for (int ai = 0; ai < 2; ++ai)
#pragma unroll
            for (int m = 0; m < 4; ++m) { const float s = rs2[ai * 128 + wr * 64 + m * 16 + fr];
#pragma unroll
                for (int bj = 0; bj < 2; ++bj)
#pragma unroll
                    for (int n = 0; n < 2; ++n) acc[ai][bj][m][n] *= s; }
    }
    __device__ __forceinline__ void operator()(const Acc& acc, const Unit& u, int wr, int wc, int fr, int fq) const {
        asm volatile("" : "+v"(fr), "+v"(fq));
        const int col0 = u.pn * 256 + wc * 32 + 4 * fq;
#pragma unroll
        for (int ai = 0; ai < 2; ++ai)
#pragma unroll
            for (int m = 0; m < 4; ++m) { const int r = u.pm * 256 + ai * 128 + wr * 64 + m * 16 + fr; float ss = 0.f;
#pragma unroll
                for (int bj = 0; bj < 2; ++bj)
#pragma unroll
                    for (int n = 0; n < 2; ++n) { const size_t off = (size_t)r * DM + col0 + bj * 128 + n * 16;
                        const f32x4 x = *(const f32x4*)(res + off) + acc[ai][bj][m][n];
                        *(f32x4*)(out + off) = x; ss += (x[0] * x[0] + x[1] * x[1]) + (x[2] * x[2] + x[3] * x[3]);
                        if (xb) { u32x2 w; w.x = cvt_pk_bf16(x[0], x[1]); w.y = cvt_pk_bf16(x[2], x[3]); *(u32x2*)(xb + off) = w; } }
                ss = xor_add<16>(ss); ss = xor_add<32>(ss);
                if (fq == 0) ssq[(size_t)r * 64 + u.pn * 4 + wc] = ss;
                asm volatile("" ::: "memory"); }
    }
};

struct Args { const float* in[17]; float* out; unsigned char* ws; int ph_lo, ph_hi; };
enum { I_X = 0, I_NORMW, I_WIN, I_LRE, I_LIM, I_BRE, I_BIM, I_CRE, I_CIM, I_D, I_LOGDT, I_WGLU, I_BGLU, I_SNW, I_RNW, I_WOUT, I_FNW };

typedef const __attribute__((address_space(4))) Args* ArgsP;
struct Frame {
    LAS unsigned char* lds; int tid, lane, wave, vcu, G, bid; unsigned char* ws;
};

__device__ __forceinline__ void transpose_item(const float* W, int K, int N, bf16_t* WT, const float* ks0, const float* ks1, int ksplit, int remap, LAS float* scr, int item, int lane) {
    const int nblk = N / 32, kb = item / nblk, nb = item % nblk, k0 = 64 * kb; int n0 = 32 * nb;
    const float* ks = (k0 < ksplit) ? ks0 + k0 : ks1 + (k0 - ksplit);
#pragma unroll 8
    for (int i = 0; i < 32; ++i) { const int kk = 2 * i + (lane >> 5); scr[kk * 33 + (lane & 31)] = W[(size_t)(k0 + kk) * N + n0 + (lane & 31)] * (ks0 ? ks[kk] : 1.f); }
    LDS_WAIT(); asm volatile("" ::: "memory");
    if (remap) { if (n0 >= 10240) n0 -= 2048; else if (n0 >= 8192) n0 += 2048; }
    const int c = lane & 7;
#pragma unroll
    for (int j = 0; j < 4; ++j) { const int n = (lane >> 3) + 8 * j; const LAS float* s = scr + (8 * c) * 33 + n;
        u32x4 o; o.x = pk2(s[0 * 33], s[1 * 33]); o.y = pk2(s[2 * 33], s[3 * 33]); o.z = pk2(s[4 * 33], s[5 * 33]); o.w = pk2(s[6 * 33], s[7 * 33]);
        *(u32x4*)(WT + (size_t)(n0 + n) * K + k0 + 8 * c) = o; }
    LDS_WAIT(); asm volatile("" ::: "memory");
}

__device__ __forceinline__ void ssm_mats_item(const Frame& F, ArgsP a, int l, int g) {
    const int lg = l * NG + g, tid = F.tid;
    LAS float* apr = (LAS float*)F.lds;
    LAS float* api = apr + 17 * 64;
    LAS float* bbr = api + 17 * 64;
    LAS float* bbi = bbr + 1024;
    LAS float* Kt = bbi + 1024;
    if (tid < 64) {
        const int n = tid; const double dt = (double)expf(a->in[I_LOGDT][lg]);
        const float lr = a->in[I_LRE][lg * 64 + n], li = a->in[I_LIM][lg * 64 + n];
        for (int tau = 0; tau <= 16; ++tau) { float c, s; cis_d((double)li * dt * tau, c, s); const float mag = expf(lr * (float)dt * (float)tau); apr[tau * 64 + n] = mag * c; api[tau * 64 + n] = mag * s; }
        const float abr = apr[64 + n], abi = api[64 + n], nr = abr - 1.f, ni = abi, den = lr * lr + li * li;
        const float cor = (nr * lr + ni * li) / den, coi = (ni * lr - nr * li) / den;
        for (int h = 0; h < 16; ++h) { const float br = a->in[I_BRE][(size_t)(lg * 64 + n) * 16 + h], bi = a->in[I_BIM][(size_t)(lg * 64 + n) * 16 + h];
            bbr[n * 16 + h] = cor * br - coi * bi; bbi[n * 16 + h] = cor * bi + coi * br; }
        ((float2*)(F.ws + WS_A16))[lg * 64 + n] = make_float2(apr[16 * 64 + n], api[16 * 64 + n]);
    }
    __syncthreads();
    const float* cre = a->in[I_CRE] + (size_t)lg * 1024; const float* cim = a->in[I_CIM] + (size_t)lg * 1024;
    for (int o = tid; o < 4096; o += 512) { const int tau = o >> 8, hp = (o >> 4) & 15, h = o & 15; float sum = 0.f;
        for (int n = 0; n < 64; ++n) { const float cr = cre[hp * 64 + n], ci = cim[hp * 64 + n], ar = apr[tau * 64 + n], ai = api[tau * 64 + n];
            sum += (cr * ar - ci * ai) * bbr[n * 16 + h] - (cr * ai + ci * ar) * bbi[n * 16 + h]; }
        Kt[o] = sum; }
    __syncthreads();
    bf16_t* bt2 = (bf16_t*)(F.ws + WS_BT2) + (size_t)lg * 256 * A2LD;
    for (int e = tid; e < 256 * A2LD / 8; e += 512) { const int row = e / 48, c0 = (e % 48) * 8, t = row >> 4, hp = row & 15; float v[8];
        if (c0 < 256) { const int j = c0 >> 4, h0 = c0 & 15;
#pragma unroll
            for (int i = 0; i < 8; ++i) v[i] = (t >= j) ? Kt[((t - j) << 8) + (hp << 4) + h0 + i] : 0.f;
        } else { const int nn = c0 - 256;
#pragma unroll
            for (int i = 0; i < 8; ++i) { const int n = (nn + i) & 63; const float cr = cre[hp * 64 + n], ci = cim[hp * 64 + n], ar = apr[(t + 1) * 64 + n], ai = api[(t + 1) * 64 + n];
                v[i] = (nn < 64) ? (cr * ar - ci * ai) : -(cr * ai + ci * ar); } }
        u32x4 w; w.x = pk2(v[0], v[1]); w.y = pk2(v[2], v[3]); w.z = pk2(v[4], v[5]); w.w = pk2(v[6], v[7]);
        *(u32x4*)(bt2 + (size_t)row * A2LD + c0) = w; }
    bf16_t* pm = (bf16_t*)(F.ws + WS_PM) + (size_t)lg * 256 * 256;
    for (int e = tid; e < 256 * 256 / 8; e += 512) { const int row = e >> 5, c0 = (e & 31) * 8; float v[8];
        if (row < 128) { const int n = row & 63, im = row >> 6, j = c0 >> 4, h0 = c0 & 15; const float ar = apr[(15 - j) * 64 + n], ai = api[(15 - j) * 64 + n];
#pragma unroll
            for (int i = 0; i < 8; ++i) { const float br = bbr[n * 16 + h0 + i], bi = bbi[n * 16 + h0 + i]; v[i] = im ? (ar * bi + ai * br) : (ar * br - ai * bi); }
        } else {
#pragma unroll
            for (int i = 0; i < 8; ++i) v[i] = 0.f; }
        u32x4 w; w.x = pk2(v[0], v[1]); w.y = pk2(v[2], v[3]); w.z = pk2(v[4], v[5]); w.w = pk2(v[6], v[7]);
        *(u32x4*)(pm + (size_t)row * 256 + c0) = w; }
    __syncthreads();
}

__device__ __forceinline__ void p0_prologue(const Frame& F, ArgsP a) {
    for (int it = F.vcu; it < DEPTH * NG; it += F.G) ssm_mats_item(F, a, it / NG, it % NG);
    { float2* rope = (float2*)(F.ws + WS_ROPE);
      for (int e = F.vcu * 512 + F.tid; e < SEQ * 128; e += F.G * 512) { const int pos = e >> 7, i = e & 127;
          const double inv = (double)expf(-(float)(2 * i) * (9.210340371976184f / 256.0f)); float c, s; cis_d((double)pos * inv, c, s); rope[e] = make_float2(c, s); } }
    const int gw = F.vcu * 8 + F.wave, NGW = F.G * 8;
    for (int m = gw; m < MTOK; m += NGW) {
        const f32x4* xr = (const f32x4*)(a->in[I_X] + (size_t)m * DM) + F.lane; float ss = 0.f; f32x4 v[16];
#pragma unroll
        for (int j = 0; j < 16; ++j) { v[j] = xr[64 * j]; ss += (v[j][0] * v[j][0] + v[j][1] * v[j][1]) + (v[j][2] * v[j][2] + v[j][3] * v[j][3]); }
        ss = wave_sum(ss);
        u32x2* o = (u32x2*)((bf16_t*)(F.ws + WS_XB) + (size_t)m * DM) + F.lane;
#pragma unroll
        for (int j = 0; j < 16; ++j) { u32x2 w; w.x = pk2(v[j][0], v[j][1]); w.y = pk2(v[j][2], v[j][3]); o[64 * j] = w; }
        ((float*)(F.ws + WS_SSQX))[(size_t)m * 64 + F.lane] = (F.lane == 0) ? ss : 0.f;
    }
    LAS float* scr = (LAS float*)(F.lds + F.wave * 16384);
    constexpr int I_IN = (DM / 64) * (NPROJ / 32), I_GLU = (DS / 64) * (DS / 32), I_OUT = (DM / 64) * (DM / 32), I_L = I_IN + I_GLU + I_OUT;
    for (int it = gw; it < DEPTH * I_L; it += NGW) {
        const int l = it / I_L; int r = it % I_L;
        if (r < I_IN) { transpose_item(a->in[I_WIN] + (size_t)l * DM * NPROJ, DM, NPROJ, (bf16_t*)(F.ws + WS_WTIN) + (size_t)l * NPROJ * DM, a->in[I_NORMW] + l * DM, a->in[I_NORMW] + l * DM, 1 << 30, 1, scr, r, F.lane); continue; } r -= I_IN;
        if (r < I_GLU) { transpose_item(a->in[I_WGLU] + (size_t)l * DS * DS, DS, DS, (bf16_t*)(F.ws + WS_WTGLU) + (size_t)l * DS * DS, nullptr, nullptr, 1 << 30, 0, scr, r, F.lane); continue; } r -= I_GLU;
        transpose_item(a->in[I_WOUT] + (size_t)l * DM * DM, DM, DM, (bf16_t*)(F.ws + WS_WTOUT) + (size_t)l * DM * DM, a->in[I_SNW] + l * DS, a->in[I_RNW] + l * DR, DS, 0, scr, r, F.lane);
    }
}

__device__ __forceinline__ void stash_rstd(const Frame& F, const float* slots, int nslot, int panel, float inv_dim) {
    __syncthreads();
    if (F.tid < 256) { const f32x4* p = (const f32x4*)(slots + (size_t)(panel * 256 + F.tid) * nslot); float s = 0.f;
        for (int j = 0; j < nslot / 4; ++j) { const f32x4 t = p[j]; s += (t[0] + t[1]) + (t[2] + t[3]); }
        ((LAS float*)(F.lds + STASH_OFF))[F.tid] = __builtin_amdgcn_rsqf(s * inv_dim + EPS); }
    __syncthreads();
}

__device__ __forceinline__ void p1_inproj(const Frame& F, int l) {
    const bf16_t* xb = (const bf16_t*)(F.ws + WS_XB); const bf16_t* wt = (const bf16_t*)(F.ws + WS_WTIN) + (size_t)l * NPROJ * DM;
    const LAS float* rs = (const LAS float*)(F.lds + STASH_OFF);
    { pg8::StaticOrder S; S.init(MTOK, 10240, F.G, F.bid); Unit u0; S.next(0, u0);
      stash_rstd(F, (const float*)(F.ws + WS_SSQX), 64, u0.pm, 1.f / DM);
      pg8::Gemm g{xb, wt, DM, DM, DM, -1};
      EpiInProj E{rs, (bf16_t*)(F.ws + WS_A2U), (bf16_t*)(F.ws + WS_GS), (bf16_t*)(F.ws + WS_Q), (bf16_t*)(F.ws + WS_K), (bf16_t*)(F.ws + WS_GR), (const float*)(F.ws + WS_ROPE)};
      pg8::gemm_phase<EpiInProj, pg8::StaticOrder, true, true>(F.lds, g, S, E, F.tid); }
    { pg8::StaticOrder S; S.init(DR, MTOK, F.G, F.bid); Unit u0; S.next(0, u0);
      stash_rstd(F, (const float*)(F.ws + WS_SSQX), 64, u0.pn, 1.f / DM);
      pg8::Gemm g{wt + (size_t)10240 * DM, xb, DM, DM, DM, -1};
      EpiVT E{rs, (bf16_t*)(F.ws + WS_VT)};
      pg8::gemm_phase<EpiVT, pg8::StaticOrder, true, true>(F.lds, g, S, E, F.tid); }
}

__device__ __forceinline__ void p2_ssm(const Frame& F, ArgsP a, int l) {
    for (int it = F.vcu; it < NG * 2; it += F.G) {
        const int g = it >> 1, bp = it & 1, lg = l * NG + g;
        bf16_t* a2g = (bf16_t*)(F.ws + WS_A2U) + (size_t)g * 512 * A2LD;
        { pg8::Gemm g1{a2g, (const bf16_t*)(F.ws + WS_PM) + (size_t)lg * 256 * 256, 256, A2LD, 256, -1}; pg8::OneUnit S{bp, 0}; EpiSloc E{};
          pg8::gemm_phase<EpiSloc, pg8::OneUnit, false, true>(F.lds, g1, S, E, F.tid); }
        LDS_WAIT(); __syncthreads();
        int t2 = F.tid; asm volatile("" : "+v"(t2));
        if (t2 < 128) {
            const int bb = t2 >> 6, n = t2 & 63; const float2 a16 = ((const float2*)(F.ws + WS_A16))[lg * 64 + n];
            const LAS float* S = (const LAS float*)F.lds + (bb * 128) * SLD; bf16_t* dst = a2g + (size_t)(bp * 256 + bb * 128) * A2LD + 256 + n;
            float sr = 0.f, si = 0.f;
#pragma unroll 8
            for (int c = 0; c < 128; ++c) { dst[(size_t)c * A2LD] = (bf16_t)f2bf(sr); dst[(size_t)c * A2LD + 64] = (bf16_t)f2bf(si);
                const float lr = S[c * SLD + n], li = S[c * SLD + 64 + n]; const float nr = a16.x * sr - a16.y * si + lr, ni = a16.x * si + a16.y * sr + li; sr = nr; si = ni; }
        }
        VM_WAIT(); __syncthreads();
        if (F.tid == 0) { __builtin_amdgcn_fence(__ATOMIC_ACQUIRE, "agent"); VM_WAIT(); }
        __syncthreads();
        { pg8::Gemm g2{a2g, (const bf16_t*)(F.ws + WS_BT2) + (size_t)lg * 256 * A2LD, A2LD, A2LD, A2LD, -1}; pg8::OneUnit S{bp, 0};
          EpiSsmOut E{a2g, a->in[I_D] + (size_t)l * DS + g * 16, (bf16_t*)(F.ws + WS_YG), g};
          pg8::gemm_phase<EpiSsmOut, pg8::OneUnit, false, true>(F.lds, g2, S, E, F.tid); }
        __syncthreads();
    }
}


typedef float f32x16 __attribute__((ext_vector_type(16)));
constexpr int RT_K0 = 0, RT_V0 = 65536, RT_P = 131072, RT_RED = 147456, RT_OLD = 528;
#define RT_BAR() do { asm volatile("s_waitcnt lgkmcnt(0)" ::: "memory"); __builtin_amdgcn_s_barrier(); asm volatile("" ::: "memory"); } while (0)
__device__ __forceinline__ void p2_ret(const Frame& F) {
    int t_ = F.tid; asm volatile("" : "+v"(t_));
    const int tid = t_, lane = tid & 63, w = __builtin_amdgcn_readfirstlane(tid >> 6), wr = w & 3, wc = w >> 2, l31 = lane & 31, hh = lane >> 5;
    LAS unsigned char* lds = F.lds;
    const bf16_t* qg = (const bf16_t*)(F.ws + WS_Q); const bf16_t* kg = (const bf16_t*)(F.ws + WS_K); const bf16_t* vtg = (const bf16_t*)(F.ws + WS_VT);
    const bf16_t* grg = (const bf16_t*)(F.ws + WS_GR); bf16_t* ycat = (bf16_t*)(F.ws + WS_YCAT);
    const unsigned koff = (unsigned)((2 * w + hh) * 4096 + ((l31 ^ ((2 * w + hh) & 15)) << 4));
    const unsigned voff = (unsigned)((8 * w + (lane >> 3)) * 16384 + (((lane & 7) ^ (((lane >> 4) + 4 * w) & 7)) << 4));
    for (int it = F.vcu; it < BATCH * RH * 8; it += F.G) {
        const int bh = it >> 3, p = it & 7, b = bh >> 3, h = bh & 7;
        const float e = __builtin_amdgcn_exp2f((float)(-5 - h));
        const float lg2 = -(e * (1.f + e * (0.5f + e * (0.33333334f + e * (0.25f + e * (0.2f + e * 0.16666667f)))))) * 1.4426950408889634f;
        for (int uu = 0; uu < 2; ++uu) {
            const int qi = uu ? p : 15 - p, ntile = 2 * (qi + 1);
            const size_t tokq = (size_t)b * SEQ + qi * 128;
            bf16x8 qf[16];
            { const bf16_t* qp = qg + (tokq + wr * 32 + l31) * DR + h * 256 + 8 * hh;
#pragma unroll
              for (int s = 0; s < 16; ++s) qf[s] = *(const bf16x8*)(qp + 16 * s); }
            f32x16 oacc[4];
#pragma unroll
            for (int db = 0; db < 4; ++db)
#pragma unroll
                for (int r = 0; r < 16; ++r) oacc[db][r] = 0.f;
#define RT_DMA(kt_, bf_) do { const char* kb_ = (const char*)(kg + ((size_t)(b * SEQ + (kt_) * 64) * DR + h * 256)) + koff; const char* vb_ = (const char*)(vtg + ((size_t)(h * 256) * MTOK + b * SEQ + (kt_) * 64)) + voff; \
            _Pragma("unroll") for (int i_ = 0; i_ < 4; ++i_) __builtin_amdgcn_global_load_lds((const unsigned*)(kb_ + i_ * 65536), (LAS unsigned*)(lds + RT_K0 + (bf_) * 32768 + (w + 8 * i_) * 1024), 16, 0, 0); \
            _Pragma("unroll") for (int i_ = 0; i_ < 4; ++i_) __builtin_amdgcn_global_load_lds((const unsigned*)(vb_ + i_ * 1048576), (LAS unsigned*)(lds + RT_V0 + (bf_) * 32768 + (w + 8 * i_) * 1024), 16, 0, 0); } while (0)
            RT_DMA(0, 0);
            asm volatile("s_waitcnt vmcnt(0)" ::: "memory"); RT_BAR();
            for (int kt = 0; kt < ntile; ++kt) {
                const int bf = kt & 1;
                if (kt + 1 < ntile) RT_DMA(kt + 1, bf ^ 1);
                int lo_ = lane; asm volatile("" : "+v"(lo_));
                const int l31 = lo_ & 31, hh = lo_ >> 5, x15 = l31 & 15, m4 = ((l31 >> 1) & 7) << 4, lane = lo_;
                f32x16 st;
#pragma unroll
                for (int r = 0; r < 16; ++r) st[r] = 0.f;
                { const LAS unsigned char* kb = lds + RT_K0 + bf * 32768 + (32 * wc + l31) * 512;
#define RT_KRD(dst, s0) do { _Pragma("unroll") for (int j_ = 0; j_ < 4; ++j_) dst[j_] = *(const LAS bf16x8*)(kb + ((((2 * ((s0) + j_)) | hh) ^ x15) << 4)); } while (0)
#define RT_KMM(src, s0) do { _Pragma("unroll") for (int j_ = 0; j_ < 4; ++j_) st = __builtin_amdgcn_mfma_f32_32x32x16_bf16(src[j_], qf[(s0) + j_], st, 0, 0, 0); } while (0)
                  bf16x8 ka[4], kc[4];
                  RT_KRD(ka, 0); __builtin_amdgcn_sched_barrier(0);
                  RT_KRD(kc, 4); RT_KMM(ka, 0); __builtin_amdgcn_sched_barrier(0);
                  RT_KRD(ka, 8); RT_KMM(kc, 4); __builtin_amdgcn_sched_barrier(0);
                  RT_KRD(kc, 12); RT_KMM(ka, 8); __builtin_amdgcn_sched_barrier(0);
                  RT_KMM(kc, 12); __builtin_amdgcn_sched_barrier(0);
#undef RT_KRD
#undef RT_KMM
                }
                { const int nb = (2 * qi - kt) * 64 - 32 * wc - 4 * hh;
                  const bool diag = kt >= 2 * qi; const int lim = wr * 32 + l31 + nb;
                  unsigned pk[8];
#pragma unroll
                  for (int i = 0; i < 8; ++i) { const int r0 = 2 * i, r1 = 2 * i + 1, o0 = (r0 & 3) + 8 * (r0 >> 2), o1 = (r1 & 3) + 8 * (r1 >> 2);
                      float v0 = st[r0] * __builtin_amdgcn_exp2f((float)(nb - o0) * lg2), v1 = st[r1] * __builtin_amdgcn_exp2f((float)(nb - o1) * lg2);
                      if (diag) { v0 = (o0 <= lim) ? v0 : 0.f; v1 = (o1 <= lim) ? v1 : 0.f; }
                      pk[i] = cvt_pk_bf16(v0, v1); }
                  LAS unsigned char* pw = lds + RT_P + ((wr * 2 + wc) * 2) * 1024 + lane * 16;
                  *(LAS u32x4*)pw = (u32x4){pk[0], pk[1], pk[2], pk[3]}; *(LAS u32x4*)(pw + 1024) = (u32x4){pk[4], pk[5], pk[6], pk[7]}; }
                RT_BAR();
                { bf16x8 pf[2][2];
#pragma unroll
                  for (int kb2 = 0; kb2 < 2; ++kb2)
#pragma unroll
                      for (int s = 0; s < 2; ++s) pf[kb2][s] = *(const LAS bf16x8*)(lds + RT_P + ((wr * 2 + kb2) * 2 + s) * 1024 + lane * 16);
                  const LAS unsigned char* vb = lds + RT_V0 + bf * 32768 + (128 * wc + l31) * 128 + 8 * hh;
#define RT_VRD(dst, db) do { _Pragma("unroll") for (int j_ = 0; j_ < 4; ++j_) { const int v_ = 4 * (j_ >> 1) + 2 * (j_ & 1); \
                      const u32x2 lo_ = *(const LAS u32x2*)(vb + (db) * 4096 + ((v_ << 4) ^ m4)), hi_ = *(const LAS u32x2*)(vb + (db) * 4096 + (((v_ + 1) << 4) ^ m4)); \
                      dst[j_] = (u32x4){lo_.x, lo_.y, hi_.x, hi_.y}; } } while (0)
#define RT_VMM(src, db) do { _Pragma("unroll") for (int j_ = 0; j_ < 4; ++j_) oacc[db] = __builtin_amdgcn_mfma_f32_32x32x16_bf16(pf[j_ >> 1][j_ & 1], __builtin_bit_cast(bf16x8, src[j_]), oacc[db], 0, 0, 0); } while (0)
                  u32x4 va[4], vc[4];
                  RT_VRD(va, 0); __builtin_amdgcn_sched_barrier(0);
                  RT_VRD(vc, 1); RT_VMM(va, 0); __builtin_amdgcn_sched_barrier(0);
                  RT_VRD(va, 2); RT_VMM(vc, 1); __builtin_amdgcn_sched_barrier(0);
                  RT_VRD(vc, 3); RT_VMM(va, 2); __builtin_amdgcn_sched_barrier(0);
                  RT_VMM(vc, 3); __builtin_amdgcn_sched_barrier(0);
#undef RT_VRD
#undef RT_VMM
                }
                asm volatile("s_waitcnt vmcnt(0)" ::: "memory"); RT_BAR();
            }
            int le_ = tid; asm volatile("" : "+v"(le_));
            const int tide = le_, l31e = le_ & 31, hhe = (le_ >> 5) & 1;
            float ssr[16];
#pragma unroll
            for (int r = 0; r < 16; ++r) { const float rf = __builtin_amdgcn_exp2f((float)(wr * 32 + 4 * hhe + (r & 3) + 8 * (r >> 2)) * lg2); float s2 = 0.f;
#pragma unroll
                for (int db = 0; db < 4; ++db) { const float o = oacc[db][r] * rf; oacc[db][r] = o; s2 += o * o; }
                s2 = xor_add<1>(s2); s2 = xor_add<2>(s2); s2 = xor_add<4>(s2); s2 = xor_add<8>(s2); s2 = xor_add<16>(s2); ssr[r] = s2; }
            if (l31e == 0) {
#pragma unroll
                for (int i = 0; i < 4; ++i) *(LAS f32x4*)(lds + RT_RED + w * 128 + hhe * 64 + i * 16) = (f32x4){ssr[4 * i], ssr[4 * i + 1], ssr[4 * i + 2], ssr[4 * i + 3]}; }
            RT_BAR();
#pragma unroll
            for (int i = 0; i < 4; ++i) { const f32x4 t = *(const LAS f32x4*)(lds + RT_RED + (w ^ 4) * 128 + hhe * 64 + i * 16);
#pragma unroll
                for (int j = 0; j < 4; ++j) ssr[4 * i + j] = __builtin_amdgcn_rsqf((ssr[4 * i + j] + t[j]) * (1.f / 256.f) + EPS); }
#pragma unroll
            for (int r = 0; r < 16; ++r) { LAS unsigned char* ow = lds + (wr * 32 + 4 * hhe + (r & 3) + 8 * (r >> 2)) * RT_OLD + (128 * wc + l31e) * 2;
#pragma unroll
                for (int db = 0; db < 4; ++db) *(LAS unsigned short*)(ow + db * 64) = (unsigned short)f2bf(oacc[db][r] * ssr[r]); }
            RT_BAR();
#pragma unroll
            for (int i = 0; i < 8; ++i) { const int idx = i * 512 + tide, row = idx >> 5, ch = idx & 31; const size_t tok = tokq + row;
                const u32x4 o = *(const LAS u32x4*)(lds + row * RT_OLD + ch * 16), gv = *(const u32x4*)(grg + tok * DR + h * 256 + ch * 8);
                u32x4 y;
                y.x = cvt_pk_bf16(bf2f(o.x & 0xffffu) * bf2f(gv.x & 0xffffu), bf2f(o.x >> 16) * bf2f(gv.x >> 16)); y.y = cvt_pk_bf16(bf2f(o.y & 0xffffu) * bf2f(gv.y & 0xffffu), bf2f(o.y >> 16) * bf2f(gv.y >> 16));
                y.z = cvt_pk_bf16(bf2f(o.z & 0xffffu) * bf2f(gv.z & 0xffffu), bf2f(o.z >> 16) * bf2f(gv.z >> 16)); y.w = cvt_pk_bf16(bf2f(o.w & 0xffffu) * bf2f(gv.w & 0xffffu), bf2f(o.w >> 16) * bf2f(gv.w >> 16));
                *(u32x4*)(ycat + tok * DM + DS + h * 256 + ch * 8) = y; }
            asm volatile("s_waitcnt vmcnt(0)" ::: "memory"); RT_BAR();
#undef RT_DMA
        }
    }
}

__device__ __forceinline__ void p3_glu(const Frame& F, ArgsP a, int l) {
    pg8::StaticOrder S; S.init(MTOK, DS, F.G, F.bid);
    pg8::Gemm g{(const bf16_t*)(F.ws + WS_YG), (const bf16_t*)(F.ws + WS_WTGLU) + (size_t)l * DS * DS, DS, DS, DS, -1};
    EpiGlu E{(const bf16_t*)(F.ws + WS_YG), (const bf16_t*)(F.ws + WS_GS), a->in[I_BGLU] + (size_t)l * DS, (bf16_t*)(F.ws + WS_YCAT), (float*)(F.ws + WS_SSQ2)};
    pg8::gemm_phase<EpiGlu, pg8::StaticOrder, true, true>(F.lds, g, S, E, F.tid);
}

__device__ __forceinline__ void p4_out(const Frame& F, ArgsP a, int l) {
    pg8::StaticOrder S; S.init(MTOK, DM, F.G, F.bid); Unit u0; S.next(0, u0);
    stash_rstd(F, (const float*)(F.ws + WS_SSQ2), 32, u0.pm, 1.f / DS);
    pg8::Gemm g{(const bf16_t*)(F.ws + WS_YCAT), (const bf16_t*)(F.ws + WS_WTOUT) + (size_t)l * DM * DM, DM, DM, DM, DS / 64};
    const bool lastl = (l == DEPTH - 1);
    EpiOut E{(const LAS float*)(F.lds + STASH_OFF), l == 0 ? a->in[I_X] : (const float*)(F.ws + WS_X1), lastl ? a->out : (float*)(F.ws + WS_X1), lastl ? nullptr : (bf16_t*)(F.ws + WS_XB), (float*)(F.ws + WS_SSQX)};
    pg8::gemm_phase<EpiOut, pg8::StaticOrder, true, true>(F.lds, g, S, E, F.tid);
}

__device__ __forceinline__ void p5_final(const Frame& F, ArgsP a) {
    const int gw = F.vcu * 8 + F.wave, NGW = F.G * 8; const f32x4* fw = (const f32x4*)a->in[I_FNW] + F.lane;
    for (int m = gw; m < MTOK; m += NGW) {
        const float s = wave_sum(((const float*)(F.ws + WS_SSQX))[(size_t)m * 64 + F.lane]); const float rstd = __builtin_amdgcn_rsqf(s * (1.f / DM) + EPS);
        f32x4* xr = (f32x4*)(a->out + (size_t)m * DM) + F.lane;
#pragma unroll
        for (int j = 0; j < 16; ++j) xr[64 * j] = xr[64 * j] * rstd * fw[64 * j];
    }
}

constexpr int NPH = 2 + 4 * DEPTH;
__global__ void __launch_bounds__(512, 2) mk_fwd(Args args) {
    extern __shared__ __attribute__((aligned(16))) unsigned char lds_raw[];
    cg::grid_group grid = cg::this_grid();
    Frame F; F.lds = (LAS unsigned char*)lds_raw; F.G = gridDim.x;
    const int wave0 = __builtin_amdgcn_readfirstlane((int)threadIdx.x >> 6);
    for (int ph = args.ph_lo; ph < args.ph_hi; ++ph) {
        ArgsP ap = (ArgsP)__builtin_amdgcn_kernarg_segment_ptr(); asm volatile("" : "+s"(ap));
        { unsigned m_ = ~0u; asm volatile("" : "+s"(m_)); int t_ = wave0 * 64 + (int)__builtin_amdgcn_mbcnt_hi(m_, __builtin_amdgcn_mbcnt_lo(m_, 0u)); asm volatile("" : "+v"(t_)); F.tid = t_; F.lane = t_ & 63; F.wave = wave0;
          int b_ = blockIdx.x; asm volatile("" : "+s"(b_)); F.bid = b_; F.vcu = (F.G % 8 == 0) ? (b_ % 8) * (F.G / 8) + b_ / 8 : b_;
          size_t z_ = 0; asm volatile("" : "+s"(z_)); F.ws = ap->ws + z_; }
#ifndef PHMASK
#define PHMASK 127
#endif
        if (ph == 0) { if (PHMASK & 1) p0_prologue(F, ap); }
        else if (ph == NPH - 1) { if (PHMASK & 32) p5_final(F, ap); }
        else { const int l = (ph - 1) >> 2, s = (ph - 1) & 3;
            if (s == 0) { if (PHMASK & 2) p1_inproj(F, l); }
            else if (s == 1) {
#if FAST_SSM
                if (PHMASK & 4) p2_ssm(F, ap, l);
#endif
#if FAST_RET
                if (PHMASK & 64) p2_ret(F);
#endif
            }
            else if (s == 2) { if (PHMASK & 8) p3_glu(F, ap, l); }
            else { if (PHMASK & 16) p4_out(F, ap, l); } }
        if (ph + 1 < args.ph_hi) grid.sync();
    }
}

__global__ void __launch_bounds__(64) naive_ssm(Args args, int l) {
    const int b = blockIdx.x >> 7, g = blockIdx.x & 127, lg = l * NG + g, n = threadIdx.x;
    const double dt = (double)expf(args.in[I_LOGDT][lg]);
    const float lr = args.in[I_LRE][lg * 64 + n], li = args.in[I_LIM][lg * 64 + n];
    float ac, as; cis_d((double)li * dt, ac, as); const float mag = expf(lr * (float)dt); const float ar = mag * ac, ai = mag * as;
    const float nr = ar - 1.f, ni = ai, den = lr * lr + li * li, cor = (nr * lr + ni * li) / den, coi = (ni * lr - nr * li) / den;
    float bbr[16], bbi[16], cr[16], ci[16];
#pragma unroll
    for (int h = 0; h < 16; ++h) { const float br = args.in[I_BRE][(size_t)(lg * 64 + n) * 16 + h], bi = args.in[I_BIM][(size_t)(lg * 64 + n) * 16 + h];
        bbr[h] = cor * br - coi * bi; bbi[h] = cor * bi + coi * br; cr[h] = args.in[I_CRE][(size_t)(lg * 16 + h) * 64 + n]; ci[h] = args.in[I_CIM][(size_t)(lg * 16 + h) * 64 + n]; }
    const float dsk = args.in[I_D][(size_t)l * DS + g * 16 + (n & 15)];
    const bf16_t* a2g = (const bf16_t*)(args.ws + WS_A2U) + (size_t)g * 512 * A2LD; bf16_t* yg = (bf16_t*)(args.ws + WS_YG);
    float sr = 0.f, si = 0.f;
    for (int t = 0; t < SEQ; ++t) {
        const u32x4* up = (const u32x4*)(a2g + (size_t)(b * 128 + (t >> 4)) * A2LD + (t & 15) * 16); const u32x4 u0 = up[0], u1 = up[1];
        float uv[16];
        uv[0] = bf2f(u0.x & 0xffffu); uv[1] = bf2f(u0.x >> 16); uv[2] = bf2f(u0.y & 0xffffu); uv[3] = bf2f(u0.y >> 16); uv[4] = bf2f(u0.z & 0xffffu); uv[5] = bf2f(u0.z >> 16); uv[6] = bf2f(u0.w & 0xffffu); uv[7] = bf2f(u0.w >> 16);
        uv[8] = bf2f(u1.x & 0xffffu); uv[9] = bf2f(u1.x >> 16); uv[10] = bf2f(u1.y & 0xffffu); uv[11] = bf2f(u1.y >> 16); uv[12] = bf2f(u1.z & 0xffffu); uv[13] = bf2f(u1.z >> 16); uv[14] = bf2f(u1.w & 0xffffu); uv[15] = bf2f(u1.w >> 16);
        float bur = 0.f, bui = 0.f;
#pragma unroll
        for (int h = 0; h < 16; ++h) { bur += bbr[h] * uv[h]; bui += bbi[h] * uv[h]; }
        const float nsr = ar * sr - ai * si + bur, nsi = ar * si + ai * sr + bui; sr = nsr; si = nsi;
        float y = 0.f, um = 0.f;
#pragma unroll
        for (int h = 0; h < 16; ++h) { const float p = wave_sum(cr[h] * sr - ci[h] * si); if (n == h) { y = p; um = uv[h]; } }
        if (n < 16) yg[(size_t)(b * SEQ + t) * DS + g * 16 + n] = (bf16_t)f2bf(gelu_tanh_f(y + dsk * um));
    }
}

constexpr int NR_KLD = 264;
__global__ void __launch_bounds__(256) naive_ret(Args args, int l) {
    extern __shared__ __attribute__((aligned(16))) unsigned char sm[];
    bf16_t* Qs = (bf16_t*)sm;
    bf16_t* Ks = Qs + 32 * 256;
    float* Ss = (float*)(Ks + 64 * NR_KLD);
    float* red = Ss + 32 * 64;
    const int qt = blockIdx.x & 63, h = (blockIdx.x >> 6) & 7, b = blockIdx.x >> 9, tid = threadIdx.x, lane = tid & 63, wv = tid >> 6;
    const bf16_t* q = (const bf16_t*)(args.ws + WS_Q); const bf16_t* k = (const bf16_t*)(args.ws + WS_K); const bf16_t* vt = (const bf16_t*)(args.ws + WS_VT); const bf16_t* gr = (const bf16_t*)(args.ws + WS_GR);
    const int tok0 = b * SEQ + qt * 32;
    for (int e = tid; e < 32 * 32; e += 256) { const int r = e >> 5, c = (e & 31) * 8; *(u32x4*)(Qs + r * 256 + c) = *(const u32x4*)(q + (size_t)(tok0 + r) * DR + h * 256 + c); }
    const float lg2 = log2f(1.f - exp2f(-5.f - (float)h));
    float o[32];
#pragma unroll
    for (int r = 0; r < 32; ++r) o[r] = 0.f;
    const int ntile = qt / 2 + 1;
    for (int kt = 0; kt < ntile; ++kt) {
        __syncthreads();
        for (int e = tid; e < 64 * 32; e += 256) { const int r = e >> 5, c = (e & 31) * 8; *(u32x4*)(Ks + r * NR_KLD + c) = *(const u32x4*)(k + (size_t)(b * SEQ + kt * 64 + r) * DR + h * 256 + c); }
        __syncthreads();
        { const int key = lane, rg = wv; float acc[8];
#pragma unroll
          for (int r = 0; r < 8; ++r) acc[r] = 0.f;
          for (int d = 0; d < 256; d += 8) { const u32x4 kv = *(const u32x4*)(Ks + key * NR_KLD + d);
              const float k0 = bf2f(kv.x & 0xffffu), k1 = bf2f(kv.x >> 16), k2 = bf2f(kv.y & 0xffffu), k3 = bf2f(kv.y >> 16), k4 = bf2f(kv.z & 0xffffu), k5 = bf2f(kv.z >> 16), k6 = bf2f(kv.w & 0xffffu), k7 = bf2f(kv.w >> 16);
#pragma unroll
              for (int r = 0; r < 8; ++r) { const u32x4 qv = *(const u32x4*)(Qs + (rg * 8 + r) * 256 + d);
                  acc[r] += bf2f(qv.x & 0xffffu) * k0 + bf2f(qv.x >> 16) * k1 + bf2f(qv.y & 0xffffu) * k2 + bf2f(qv.y >> 16) * k3 + bf2f(qv.z & 0xffffu) * k4 + bf2f(qv.z >> 16) * k5 + bf2f(qv.w & 0xffffu) * k6 + bf2f(qv.w >> 16) * k7; } }
#pragma unroll
          for (int r = 0; r < 8; ++r) { const int i = qt * 32 + rg * 8 + r, j = kt * 64 + key; Ss[(rg * 8 + r) * 64 + key] = (i >= j) ? acc[r] * exp2f((float)(i - j) * lg2) : 0.f; } }
        __syncthreads();
        { const bf16_t* vr = vt + (size_t)(h * 256 + tid) * MTOK + b * SEQ + kt * 64;
          for (int kk = 0; kk < 64; kk += 8) { const u32x4 vv = *(const u32x4*)(vr + kk);
              const float v0 = bf2f(vv.x & 0xffffu), v1 = bf2f(vv.x >> 16), v2 = bf2f(vv.y & 0xffffu), v3 = bf2f(vv.y >> 16), v4 = bf2f(vv.z & 0xffffu), v5 = bf2f(vv.z >> 16), v6 = bf2f(vv.w & 0xffffu), v7 = bf2f(vv.w >> 16);
#pragma unroll
              for (int r = 0; r < 32; ++r) { const f32x4 s0 = *(const f32x4*)(Ss + r * 64 + kk), s1 = *(const f32x4*)(Ss + r * 64 + kk + 4);
                  o[r] += s0[0] * v0 + s0[1] * v1 + s0[2] * v2 + s0[3] * v3 + s1[0] * v4 + s1[1] * v5 + s1[2] * v6 + s1[3] * v7; } } }
    }
    __syncthreads();
#pragma unroll
    for (int r = 0; r < 32; ++r) { const float p = wave_sum(o[r] * o[r]); if (lane == 0) red[r * 4 + wv] = p; }
    __syncthreads();
    bf16_t* ycat = (bf16_t*)(args.ws + WS_YCAT);
#pragma unroll
    for (int r = 0; r < 32; ++r) { const float ss = (red[r * 4] + red[r * 4 + 1]) + (red[r * 4 + 2] + red[r * 4 + 3]); const float rstd = __builtin_amdgcn_rsqf(ss * (1.f / 256.f) + EPS);
        const size_t tok = (size_t)(tok0 + r); ycat[tok * DM + DS + h * 256 + tid] = (bf16_t)f2bf(o[r] * rstd * bf2f(gr[tok * DR + h * 256 + tid])); }
}

extern "C" void kernel_launch(void* const* d_in, const int* in_sizes, int n_in, void* d_out, int out_size, void* d_ws, size_t ws_size, hipStream_t stream) {
    static int grid = 0;
    if (grid == 0) {
        if (n_in != 17 || in_sizes[0] != MTOK * DM || out_size != MTOK * DM || ws_size < WS_END) { fprintf(stderr, "kernel_launch: unexpected problem (n_in %d, x %d, out %d, ws %zu)\n", n_in, n_in > 0 ? in_sizes[0] : -1, out_size, ws_size); grid = -1; return; }
        int dev = 0, cus = 0, per_cu = 0;
        hipGetDevice(&dev); hipDeviceGetAttribute(&cus, hipDeviceAttributeMultiprocessorCount, dev);
        if (hipFuncSetAttribute((const void*)mk_fwd, hipFuncAttributeMaxDynamicSharedMemorySize, LDS_BYTES) != hipSuccess) { fprintf(stderr, "kernel_launch: hipFuncSetAttribute failed\n"); grid = -1; return; }
        hipFuncSetAttribute((const void*)naive_ret, hipFuncAttributeMaxDynamicSharedMemorySize, 65536);
        hipOccupancyMaxActiveBlocksPerMultiprocessor(&per_cu, (const void*)mk_fwd, 512, LDS_BYTES);
        (void)hipGetLastError();
        if (per_cu < 1) fprintf(stderr, "kernel_launch: occupancy query says %d blocks per CU\n", per_cu);
        grid = cus;
        if (grid != 256) fprintf(stderr, "kernel_launch: %d CUs (phase balance assumes 256)\n", grid);
        for (int c = 0; c < grid; ++c) { pg8::StaticOrder S; Unit u0, u;
            S.init(MTOK, 10240, grid, c); S.next(0, u0); for (int i = 1; S.next(i, u); ++i) if (u.pm != u0.pm) { fprintf(stderr, "kernel_launch: in-proj unit order breaks the one-panel-per-workgroup assumption\n"); grid = -1; return; }
            S.init(DR, MTOK, grid, c); S.next(0, u0); for (int i = 1; S.next(i, u); ++i) if (u.pn != u0.pn) { fprintf(stderr, "kernel_launch: V^T unit order breaks the assumption\n"); grid = -1; return; }
            S.init(MTOK, DM, grid, c); S.next(0, u0); for (int i = 1; S.next(i, u); ++i) if (u.pm != u0.pm) { fprintf(stderr, "kernel_launch: out-proj unit order breaks the assumption\n"); grid = -1; return; } }
    }
    if (grid < 0) return;
    Args a{};
    for (int i = 0; i < 17; ++i) a.in[i] = (const float*)d_in[i];
    a.out = (float*)d_out; a.ws = (unsigned char*)d_ws;
    auto launch = [&](int lo, int hi) { a.ph_lo = lo; a.ph_hi = hi; void* kargs[] = {&a};
        hipError_t e = hipLaunchCooperativeKernel((const void*)mk_fwd, dim3(grid), dim3(512), kargs, LDS_BYTES, stream);
        if (e != hipSuccess) fprintf(stderr, "kernel_launch: cooperative launch [%d,%d) failed: %s\n", lo, hi, hipGetErrorString(e)); };
#if FAST_SSM && FAST_RET && ONE_LAUNCH
    launch(0, NPH);
#else
    launch(0, 1);
    for (int l = 0; l < DEPTH; ++l) {
        launch(1 + 4 * l, 2 + 4 * l);
        launch(2 + 4 * l, 3 + 4 * l);
#if !FAST_SSM
        hipLaunchKernelGGL(naive_ssm, dim3(BATCH * NG), dim3(64), 0, stream, a, l);
#endif
#if !FAST_RET
        hipLaunchKernelGGL(naive_ret, dim3(BATCH * RH * 64), dim3(256), 32 * 256 * 2 + 64 * NR_KLD * 2 + 32 * 64 * 4 + 32 * 4 * 4, stream, a, l);
#endif
        launch(3 + 4 * l, 4 + 4 * l);
        launch(4 + 4 * l, 5 + 4 * l);
    }
    launch(NPH - 1, NPH);
#endif
}
```

```cpp
#include <hip/hip_runtime.h>
#include <hip/hip_cooperative_groups.h>
#include <cstdio>
#include <cstdint>
namespace cg = cooperative_groups;

#ifndef FAST_SSM
#define FAST_SSM 1
#endif
#ifndef FAST_RET
#define FAST_RET 1
#endif

#ifndef ONE_LAUNCH
#define ONE_LAUNCH 1
#endif

#define LAS __attribute__((address_space(3)))
typedef unsigned short bf16_t;
typedef short bf16x8 __attribute__((ext_vector_type(8)));
typedef float f32x4 __attribute__((ext_vector_type(4)));
typedef float f32x2 __attribute__((ext_vector_type(2)));
typedef unsigned u32x4 __attribute__((ext_vector_type(4)));
typedef unsigned u32x2 __attribute__((ext_vector_type(2)));

constexpr int BATCH = 4, SEQ = 2048, DM = 4096, DEPTH = 2, DS = 2048, DR = 2048, NG = 128, SG = 16, NST = 64, RH = 8, RD = 256;
constexpr int NPROJ = 12288, MTOK = BATCH * SEQ;
constexpr float EPS = 1e-6f;
constexpr int TCH = 16;
constexpr int A2LD = 384;

constexpr size_t MiB = 1u << 20;
constexpr size_t WS_CTL = 0;
constexpr size_t WS_WTIN = 16 * MiB;
constexpr size_t WS_WTGLU = 208 * MiB;
constexpr size_t WS_WTOUT = 224 * MiB;
constexpr size_t WS_BT2 = 288 * MiB;
constexpr size_t WS_PM = 336 * MiB;
constexpr size_t WS_A16 = 368 * MiB;
constexpr size_t WS_ROPE = 369 * MiB;
constexpr size_t WS_SSQX = 371 * MiB;
constexpr size_t WS_SSQ2 = 373 * MiB;
constexpr size_t WS_XB = 384 * MiB;
constexpr size_t WS_X1 = 448 * MiB;
constexpr size_t WS_A2U = 576 * MiB;
constexpr size_t WS_GS = 624 * MiB, WS_Q = 656 * MiB, WS_K = 688 * MiB, WS_VT = 720 * MiB, WS_GR = 752 * MiB, WS_YG = 784 * MiB;
constexpr size_t WS_YCAT = 816 * MiB;
constexpr size_t WS_END = 880 * MiB;

constexpr int RING_BYTES = 131072;
constexpr int STASH_OFF = 155648;
constexpr int LDS_BYTES = 163840 - 4096;

__device__ __forceinline__ unsigned f2bf(float f) { unsigned u = __builtin_bit_cast(unsigned, f); return (u + 0x7fffu + ((u >> 16) & 1u)) >> 16; }
__device__ __forceinline__ unsigned pk2(float lo, float hi) { return f2bf(lo) | (f2bf(hi) << 16); }
__device__ __forceinline__ float bf2f(unsigned v) { return __builtin_bit_cast(float, v << 16); }
__device__ __forceinline__ unsigned cvt_pk_bf16(float lo, float hi) { unsigned r; asm volatile("v_cvt_pk_bf16_f32 %0, %1, %2" : "=v"(r) : "v"(lo), "v"(hi)); return r; }
__device__ __forceinline__ float silu_f(float x) { return x * __builtin_amdgcn_rcpf(1.f + __expf(-x)); }
__device__ __forceinline__ float sigmoid_f(float x) { return __builtin_amdgcn_rcpf(1.f + __expf(-x)); }
__device__ __forceinline__ float gelu_tanh_f(float x) {
    const float z = 0.7978845608028654f * (x + 0.044715f * x * x * x);
    const float th = 1.f - 2.f * __builtin_amdgcn_rcpf(1.f + __expf(2.f * z));
    return 0.5f * x * (1.f + th);
}
template <int X> __device__ __forceinline__ float xor_add(float v) {
    if constexpr (X == 32) { const unsigned u = __builtin_bit_cast(unsigned, v); auto r = __builtin_amdgcn_permlane32_swap(u, u, false, false);
        return __builtin_bit_cast(float, (unsigned)r[0]) + __builtin_bit_cast(float, (unsigned)r[1]); }
    else return v + __builtin_bit_cast(float, __builtin_amdgcn_ds_swizzle(__builtin_bit_cast(int, v), (X << 10) | 0x1f));
}
__device__ __forceinline__ float wave_sum(float v) {
    v = xor_add<1>(v); v = xor_add<2>(v); v = xor_add<4>(v); v = xor_add<8>(v); v = xor_add<16>(v); v = xor_add<32>(v);
    return v;
}
__device__ __forceinline__ void cis_d(double ph, float& c, float& s) {
    const double rv = ph * 0.15915494309189535;
    const float r = (float)(rv - __builtin_rint(rv));
    c = __builtin_amdgcn_cosf(r); s = __builtin_amdgcn_sinf(r);
}
#define LDS_WAIT() asm volatile("s_waitcnt lgkmcnt(0)" ::: "memory")
#define VM_WAIT() asm volatile("s_waitcnt vmcnt(0)" ::: "memory")

namespace pg8 {
constexpr int BM = 256, BK = 64, HALF = 128, HTB = HALF * BK * 2, STAGE_BYTES = 8 * HTB, NXCD = 8, WGM = 8;
__host__ __device__ __forceinline__ int lds_byte(int r, int c) { const int st = (r >> 4) * 2 + (c >> 5), rr = r & 15, cc = c & 31, ob = rr * 64 + cc * 2; return st * 1024 + (ob ^ (((ob >> 9) & 1) << 5)); }
__host__ __device__ __forceinline__ void stage_rc(int b, int& R, int& C) { const int st = b / 1024, sb = b % 1024, swz = sb ^ (((sb >> 9) & 1) << 5); R = (st >> 1) * 16 + swz / 64; C = (st & 1) * 32 + (swz % 64) / 2; }
__host__ __device__ __forceinline__ int perm32(int rho) { const int n = rho >> 4, i = rho & 15; return 8 * (i >> 2) + 4 * n + (i & 3); }

struct Unit { int pm, pn; };
struct Gemm { const bf16_t* A; const bf16_t* Bt; int K, lda, ldb, kmid; };

struct StaticOrder {
    int nM, nN, nwg, G, c;
    __host__ __device__ void init(int M, int N, int G_, int c_) { nM = M / BM; nN = N / BM; nwg = nM * nN; G = G_; c = c_; }
    __host__ __device__ bool next(int i, Unit& u) const {
        const long L = (long)i * G + c; if (L >= nwg) return false;
        int wgid = (int)L; { const int q = nwg / NXCD, r = nwg % NXCD, xcd = wgid % NXCD, off = wgid / NXCD; wgid = (xcd < r ? xcd * (q + 1) : r * (q + 1) + (xcd - r) * q) + off; }
        const int nig = WGM * nN, gid = wgid / nig, fm = gid * WGM, gsz = (nM - fm) < WGM ? (nM - fm) : WGM;
        u.pm = fm + ((wgid % nig) % gsz); u.pn = (wgid % nig) / gsz; return true;
    }
};
struct OneUnit {
    int pm, pn;
    __device__ __forceinline__ bool next(int i, Unit& u) const { if (i) return false; u.pm = pm; u.pn = pn; return true; }
};

template <class Epi, class Sched, bool ALIGN_EPI, bool SP2>
__device__ __forceinline__ void gemm_phase(LAS unsigned char* lds, const Gemm g, const Sched& S, const Epi& E, int tid_in) {
    int tid_ = tid_in; asm volatile("" : "+v"(tid_));
    const int tid = tid_, wid = __builtin_amdgcn_readfirstlane(tid >> 6), lane = tid & 63, wr = wid >> 2, wc = wid & 3, fr = lane & 15, fq = lane >> 4;
    const int K = g.K, nt = K / BK;
    unsigned voffA[2], voffB[2];
#pragma unroll
    for (int i = 0; i < 2; ++i) { int R, C; stage_rc(tid * 16 + i * 8192, R, C); const int Rb = Epi::PERM ? ((R & ~31) + perm32(R & 31)) : R;
        voffA[i] = (unsigned)(R * g.lda + C) * 2u; voffB[i] = (unsigned)(Rb * g.ldb + C) * 2u; }
    const size_t kstep = (size_t)(BK * 2);
    const size_t hstepA = (size_t)HALF * g.lda * 2, hstepB = (size_t)HALF * g.ldb * 2;
    const size_t tstepA = 2 * hstepA, tstepB = 2 * hstepB;
    const unsigned ldsw = (unsigned)wid * 1024u;
    const int aoff = lds_byte(wr * 64 + fr, fq * 8), boff = lds_byte(wc * 32 + fr, fq * 8);
#define PG8_SA(b, h) (((b) * 2 + (h)) * HTB)
#define PG8_SB(b, h) ((4 + (b) * 2 + (h)) * HTB)
#define PG8_STAGE(bufoff, gbase, voff) do { _Pragma("unroll") for (int _i = 0; _i < 2; ++_i) \
        __builtin_amdgcn_global_load_lds((const unsigned*)((const char*)(gbase) + (voff)[_i]), (LAS unsigned*)(lds + (bufoff) + ldsw + _i * 8192), 16, 0, 0); } while (0)
#define PG8_LDA(dst, b, h) do { _Pragma("unroll") for (int m = 0; m < 4; ++m) _Pragma("unroll") for (int k = 0; k < 2; ++k) dst[m][k] = *(const LAS bf16x8*)(lds + PG8_SA(b, h) + aoff + m * 2048 + k * 1024); } while (0)
#define PG8_LDB(dst, b, h) do { _Pragma("unroll") for (int n = 0; n < 2; ++n) _Pragma("unroll") for (int k = 0; k < 2; ++k) dst[n][k] = *(const LAS bf16x8*)(lds + PG8_SB(b, h) + boff + n * 2048 + k * 1024); } while (0)
#define PG8_MMA(ai, bj, At, Bt) do { __builtin_amdgcn_s_setprio(1); _Pragma("unroll") for (int m = 0; m < 4; ++m) _Pragma("unroll") for (int n = 0; n < 2; ++n) _Pragma("unroll") for (int k = 0; k < 2; ++k) \
        acc[ai][bj][m][n] = __builtin_amdgcn_mfma_f32_16x16x32_bf16(Bt[n][k], At[m][k], acc[ai][bj][m][n], 0, 0, 0); __builtin_amdgcn_s_setprio(0); } while (0)
#define PG8_WAIT_V(n) asm volatile("s_waitcnt vmcnt(" #n ")" ::: "memory")
#define PG8_WAIT_L(n) asm volatile("s_waitcnt lgkmcnt(" #n ")" ::: "memory")
#define PG8_BAR __builtin_amdgcn_s_barrier()
#define PG8_SCHED __builtin_amdgcn_sched_barrier(0)
    Unit cur, nxt; int ui = 0;
    if (!S.next(0, cur)) return;
    f32x4 acc[2][2][4][2];
#pragma unroll
    for (int a = 0; a < 2; ++a)
#pragma unroll
        for (int b = 0; b < 2; ++b)
#pragma unroll
            for (int m = 0; m < 4; ++m)
#pragma unroll
                for (int n = 0; n < 2; ++n) acc[a][b][m][n] = (f32x4){0.f, 0.f, 0.f, 0.f};
    bf16x8 At[4][2], B0[2][2], B1[2][2];
    const char* cA = (const char*)g.A + (size_t)cur.pm * tstepA; const char* cB = (const char*)g.Bt + (size_t)cur.pn * tstepB;
    if constexpr (SP2) {
        PG8_STAGE(PG8_SB(0, 0), cB, voffB); PG8_STAGE(PG8_SB(0, 1), cB + hstepB, voffB); PG8_STAGE(PG8_SA(0, 0), cA, voffA); PG8_STAGE(PG8_SA(0, 1), cA + hstepA, voffA);
        if (wr == 1) PG8_BAR;
        PG8_WAIT_V(2); PG8_BAR;
        PG8_STAGE(PG8_SB(1, 0), cB + kstep, voffB); PG8_STAGE(PG8_SA(1, 0), cA + kstep, voffA); PG8_STAGE(PG8_SB(1, 1), cB + hstepB + kstep, voffB);
        PG8_WAIT_V(6); PG8_BAR;
    } else {
        PG8_STAGE(PG8_SB(0, 0), cB, voffB); PG8_STAGE(PG8_SA(0, 0), cA, voffA); PG8_STAGE(PG8_SB(0, 1), cB + hstepB, voffB); PG8_STAGE(PG8_SA(0, 1), cA + hstepA, voffA);
        if (wr == 1) PG8_BAR;
        PG8_WAIT_V(4); PG8_BAR;
        PG8_STAGE(PG8_SB(1, 0), cB + kstep, voffB); PG8_STAGE(PG8_SA(1, 0), cA + kstep, voffA); PG8_STAGE(PG8_SB(1, 1), cB + hstepB + kstep, voffB);
        PG8_WAIT_V(6); PG8_BAR;
    }
    for (;;) {
        const bool has_next = S.next(ui + 1, nxt);
        const char* nA = has_next ? (const char*)g.A + (size_t)nxt.pm * tstepA : cA; const char* nB = has_next ? (const char*)g.Bt + (size_t)nxt.pn * tstepB : cB;
        for (int t = 0; t < nt; t += 2) {
            const bool last = (t == nt - 2);
            const char* a1 = cA + (size_t)(t + 1) * kstep;
            const char* a2 = last ? nA : cA + (size_t)(t + 2) * kstep; const char* b2 = last ? nB : cB + (size_t)(t + 2) * kstep;
            const char* a3 = a2 + kstep; const char* b3 = b2 + kstep;
            if constexpr (Epi::MIDK) { if (t == g.kmid) E.midk(acc, wr, fr); }
            if constexpr (SP2) {
            PG8_LDB(B0, 0, 0); PG8_LDB(B1, 0, 1); PG8_SCHED; PG8_LDA(At, 0, 0); PG8_STAGE(PG8_SA(1, 1), a1 + hstepA, voffA);
            PG8_WAIT_V(8); PG8_WAIT_L(0); PG8_BAR; PG8_MMA(0, 0, At, B0); PG8_MMA(0, 1, At, B1); PG8_BAR; PG8_SCHED;
            PG8_LDA(At, 0, 1); PG8_STAGE(PG8_SB(0, 0), b2, voffB); PG8_STAGE(PG8_SB(0, 1), b2 + hstepB, voffB); PG8_STAGE(PG8_SA(0, 0), a2, voffA);
            PG8_WAIT_V(8); PG8_WAIT_L(0); PG8_BAR; PG8_MMA(1, 0, At, B0); PG8_MMA(1, 1, At, B1); PG8_BAR; PG8_SCHED;
            PG8_LDB(B0, 1, 0); PG8_LDB(B1, 1, 1); PG8_SCHED; PG8_LDA(At, 1, 0); PG8_STAGE(PG8_SA(0, 1), a2 + hstepA, voffA);
            PG8_WAIT_V(8); PG8_WAIT_L(0); PG8_BAR; PG8_MMA(0, 0, At, B0); PG8_MMA(0, 1, At, B1); PG8_BAR; PG8_SCHED;
            PG8_LDA(At, 1, 1); PG8_STAGE(PG8_SB(1, 0), b3, voffB); PG8_STAGE(PG8_SB(1, 1), b3 + hstepB, voffB); PG8_STAGE(PG8_SA(1, 0), a3, voffA);
            PG8_WAIT_V(8); PG8_WAIT_L(0); PG8_BAR; PG8_MMA(1, 0, At, B0); PG8_MMA(1, 1, At, B1); PG8_BAR; PG8_SCHED;
            } else {
            PG8_LDB(B0, 0, 0); PG8_SCHED; PG8_LDA(At, 0, 0); PG8_STAGE(PG8_SA(1, 1), a1 + hstepA, voffA);
            PG8_WAIT_L(8); PG8_BAR; PG8_WAIT_L(0); PG8_MMA(0, 0, At, B0); PG8_BAR; PG8_SCHED;
            PG8_LDB(B1, 0, 1); PG8_STAGE(PG8_SB(0, 0), b2, voffB);
            PG8_BAR; PG8_WAIT_L(0); PG8_MMA(0, 1, At, B1); PG8_BAR;
            PG8_LDA(At, 0, 1); PG8_STAGE(PG8_SA(0, 0), a2, voffA);
            PG8_BAR; PG8_WAIT_L(0); PG8_MMA(1, 0, At, B0); PG8_BAR; PG8_SCHED;
            PG8_STAGE(PG8_SB(0, 1), b2 + hstepB, voffB);
            PG8_WAIT_V(6); PG8_BAR; PG8_MMA(1, 1, At, B1); PG8_BAR;
            PG8_LDB(B0, 1, 0); PG8_SCHED; PG8_LDA(At, 1, 0); PG8_STAGE(PG8_SA(0, 1), a2 + hstepA, voffA);
            PG8_WAIT_L(8); PG8_BAR; PG8_WAIT_L(0); PG8_MMA(0, 0, At, B0); PG8_BAR; PG8_SCHED;
            PG8_LDB(B1, 1, 1); PG8_STAGE(PG8_SB(1, 0), b3, voffB);
            PG8_BAR; PG8_WAIT_L(0); PG8_MMA(0, 1, At, B1); PG8_BAR;
            PG8_LDA(At, 1, 1); PG8_STAGE(PG8_SA(1, 0), a3, voffA);
            PG8_BAR; PG8_WAIT_L(0); PG8_MMA(1, 0, At, B0); PG8_BAR; PG8_SCHED;
            PG8_STAGE(PG8_SB(1, 1), b3 + hstepB, voffB);
            PG8_WAIT_V(6); PG8_BAR; PG8_MMA(1, 1, At, B1); PG8_BAR;
            }
        }
        if constexpr (ALIGN_EPI) { if (wr == 0) PG8_BAR; }
        if constexpr (!Epi::AFTER_DRAIN) { E(acc, cur, wr, wc, fr, fq); }
        if (!has_next) break;
#pragma unroll
        for (int a = 0; a < 2; ++a)
#pragma unroll
            for (int b = 0; b < 2; ++b)
#pragma unroll
                for (int m = 0; m < 4; ++m)
#pragma unroll
                    for (int n = 0; n < 2; ++n) acc[a][b][m][n] = (f32x4){0.f, 0.f, 0.f, 0.f};
        cur = nxt; cA = nA; cB = nB; ++ui;
        if constexpr (ALIGN_EPI) { if (wr == 1) PG8_BAR; }
    }
    PG8_WAIT_V(0);
    if constexpr (!ALIGN_EPI) { if (wr == 0) PG8_BAR; }
    PG8_BAR;
    if constexpr (Epi::AFTER_DRAIN) { E.fused(acc, cur, wr, wc, fr, fq, lds); }
#undef PG8_SA
#undef PG8_SB
#undef PG8_STAGE
#undef PG8_LDA
#undef PG8_LDB
#undef PG8_MMA
#undef PG8_WAIT_V
#undef PG8_WAIT_L
#undef PG8_BAR
#undef PG8_SCHED
}
}
using pg8::Unit;
typedef f32x4 Acc[2][2][4][2];

struct EpiInProj {
    static constexpr bool PERM = true, AFTER_DRAIN = false, MIDK = false;
    const LAS float* rs; bf16_t *a2u, *gs, *q, *k, *gr; const float* rope;
    __device__ __forceinline__ void operator()(const Acc& acc, const Unit& u, int wr, int wc, int fr, int fq) const {
        asm volatile("" : "+v"(fr), "+v"(fq));
        const int type = u.pn >> 3, colt = (u.pn & 7) << 8, c8 = wc * 32 + 8 * fq;
#pragma unroll
        for (int ai = 0; ai < 2; ++ai)
#pragma unroll
            for (int m = 0; m < 4; ++m) {
                const int lr = wr * 64 + fr + ai * 128 + m * 16, r = u.pm * 256 + lr; const float s = rs[lr];
                f32x4 v[2][2];
#pragma unroll
                for (int bj = 0; bj < 2; ++bj)
#pragma unroll
                    for (int n = 0; n < 2; ++n) v[bj][n] = acc[ai][bj][m][n] * s;
                if (type == 0) {
#pragma unroll
                    for (int bj = 0; bj < 2; ++bj) { const int col = colt + bj * 128 + c8;
                        u32x4 w; w.x = cvt_pk_bf16(v[bj][0][0], v[bj][0][1]); w.y = cvt_pk_bf16(v[bj][0][2], v[bj][0][3]); w.z = cvt_pk_bf16(v[bj][1][0], v[bj][1][1]); w.w = cvt_pk_bf16(v[bj][1][2], v[bj][1][3]);
                        *(u32x4*)(a2u + ((size_t)((col >> 4) * 512 + (r >> 4)) * A2LD + (r & 15) * 16 + (col & 15))) = w; }
                } else if (type == 1 || type == 4) {
                    bf16_t* dst = (type == 1 ? gs : gr) + (size_t)r * 2048 + colt + c8;
#pragma unroll
                    for (int bj = 0; bj < 2; ++bj) {
                        u32x4 w; w.x = cvt_pk_bf16(silu_f(v[bj][0][0]), silu_f(v[bj][0][1])); w.y = cvt_pk_bf16(silu_f(v[bj][0][2]), silu_f(v[bj][0][3]));
                        w.z = cvt_pk_bf16(silu_f(v[bj][1][0]), silu_f(v[bj][1][1])); w.w = cvt_pk_bf16(silu_f(v[bj][1][2]), silu_f(v[bj][1][3]));
                        *(u32x4*)(dst + bj * 128) = w; }
                } else {
                    const float sc = (type == 3) ? 0.0625f : 1.f;
                    const f32x4* cs = (const f32x4*)(rope + ((size_t)(r & 2047) * 128 + c8) * 2);
                    float o1[8], o2[8];
#pragma unroll
                    for (int jj = 0; jj < 4; ++jj) { const f32x4 t = cs[jj];
                        const float a0 = v[0][jj >> 1][(jj & 1) * 2], b0 = v[1][jj >> 1][(jj & 1) * 2], a1 = v[0][jj >> 1][(jj & 1) * 2 + 1], b1 = v[1][jj >> 1][(jj & 1) * 2 + 1];
                        o1[2 * jj] = (a0 * t[0] - b0 * t[1]) * sc; o2[2 * jj] = (b0 * t[0] + a0 * t[1]) * sc;
                        o1[2 * jj + 1] = (a1 * t[2] - b1 * t[3]) * sc; o2[2 * jj + 1] = (b1 * t[2] + a1 * t[3]) * sc; }
                    bf16_t* dst = (type == 2 ? q : k) + (size_t)r * 2048 + colt + c8;
                    u32x4 w; w.x = cvt_pk_bf16(o1[0], o1[1]); w.y = cvt_pk_bf16(o1[2], o1[3]); w.z = cvt_pk_bf16(o1[4], o1[5]); w.w = cvt_pk_bf16(o1[6], o1[7]);
                    *(u32x4*)dst = w;
                    w.x = cvt_pk_bf16(o2[0], o2[1]); w.y = cvt_pk_bf16(o2[2], o2[3]); w.z = cvt_pk_bf16(o2[4], o2[5]); w.w = cvt_pk_bf16(o2[6], o2[7]);
                    *(u32x4*)(dst + 128) = w;
                }
                asm volatile("" ::: "memory");
            }
    }
};
struct EpiVT {
    static constexpr bool PERM = true, AFTER_DRAIN = false, MIDK = false;
    const LAS float* rs; bf16_t* vt;
    __device__ __forceinline__ void operator()(const Acc& acc, const Unit& u, int wr, int wc, int fr, int fq) const {
        asm volatile("" : "+v"(fr), "+v"(fq));
        f32x4 sv[2][2];
#pragma unroll
        for (int bj = 0; bj < 2; ++bj)
#pragma unroll
            for (int n = 0; n < 2; ++n) sv[bj][n] = *(const LAS f32x4*)(rs + bj * 128 + wc * 32 + 8 * fq + 4 * n);
#pragma unroll
        for (int ai = 0; ai < 2; ++ai)
#pragma unroll
            for (int m = 0; m < 4; ++m) { bf16_t* dst = vt + (size_t)(u.pm * 256 + wr * 64 + fr + ai * 128 + m * 16) * MTOK + u.pn * 256 + wc * 32 + 8 * fq;
#pragma unroll
                for (int bj = 0; bj < 2; ++bj) { const f32x4 a = acc[ai][bj][m][0] * sv[bj][0], b = acc[ai][bj][m][1] * sv[bj][1];
                    u32x4 w; w.x = cvt_pk_bf16(a[0], a[1]); w.y = cvt_pk_bf16(a[2], a[3]); w.z = cvt_pk_bf16(b[0], b[1]); w.w = cvt_pk_bf16(b[2], b[3]);
                    *(u32x4*)(dst + bj * 128) = w; } }
    }
};
constexpr int SLD = 132;
struct EpiSloc {
    static constexpr bool PERM = false, AFTER_DRAIN = true, MIDK = false;
    __device__ __forceinline__ void fused(const Acc& acc, const Unit&, int wr, int wc, int fr, int fq, LAS unsigned char* lds) const {
        asm volatile("" : "+v"(fr), "+v"(fq));
        LAS float* S = (LAS float*)lds;
#pragma unroll
        for (int ai = 0; ai < 2; ++ai)
#pragma unroll
            for (int m = 0; m < 4; ++m)
#pragma unroll
                for (int n = 0; n < 2; ++n) *(LAS f32x4*)(S + (ai * 128 + wr * 64 + m * 16 + fr) * SLD + wc * 32 + n * 16 + 4 * fq) = acc[ai][0][m][n];
    }
};
struct EpiSsmOut {
    static constexpr bool PERM = true, AFTER_DRAIN = false, MIDK = false;
    const bf16_t* a2g; const float* dsk; bf16_t* yg; int g;
    __device__ __forceinline__ void operator()(const Acc& acc, const Unit& u, int wr, int wc, int fr, int fq) const {
        asm volatile("" : "+v"(fr), "+v"(fq));
        const int h0 = 8 * (fq & 1);
        const f32x4 d0 = *(const f32x4*)(dsk + h0), d1 = *(const f32x4*)(dsk + h0 + 4);
#pragma unroll
        for (int ai = 0; ai < 2; ++ai)
#pragma unroll
            for (int m = 0; m < 4; ++m) { const int row = u.pm * 256 + ai * 128 + wr * 64 + m * 16 + fr;
#pragma unroll
                for (int bj = 0; bj < 2; ++bj) { const int col = bj * 128 + wc * 32 + 8 * fq, tl = col >> 4;
                    const u32x4 uu = *(const u32x4*)(a2g + (size_t)row * A2LD + col);
                    const f32x4 a = acc[ai][bj][m][0], b = acc[ai][bj][m][1];
                    float y[8];
                    y[0] = a[0] + d0[0] * bf2f(uu.x & 0xffffu); y[1] = a[1] + d0[1] * bf2f(uu.x >> 16); y[2] = a[2] + d0[2] * bf2f(uu.y & 0xffffu); y[3] = a[3] + d0[3] * bf2f(uu.y >> 16);
                    y[4] = b[0] + d1[0] * bf2f(uu.z & 0xffffu); y[5] = b[1] + d1[1] * bf2f(uu.z >> 16); y[6] = b[2] + d1[2] * bf2f(uu.w & 0xffffu); y[7] = b[3] + d1[3] * bf2f(uu.w >> 16);
#pragma unroll
                    for (int j = 0; j < 8; ++j) y[j] = gelu_tanh_f(y[j]);
                    u32x4 w; w.x = cvt_pk_bf16(y[0], y[1]); w.y = cvt_pk_bf16(y[2], y[3]); w.z = cvt_pk_bf16(y[4], y[5]); w.w = cvt_pk_bf16(y[6], y[7]);
                    *(u32x4*)(yg + (size_t)(row * 16 + tl) * DS + g * 16 + h0) = w; }
                asm volatile("" ::: "memory"); }
    }
};
struct EpiGlu {
    static constexpr bool PERM = true, AFTER_DRAIN = false, MIDK = false;
    const bf16_t* yg; const bf16_t* gs; const float* bias; bf16_t* ycat; float* ssq2;
    __device__ __forceinline__ void operator()(const Acc& acc, const Unit& u, int wr, int wc, int fr, int fq) const {
        asm volatile("" : "+v"(fr), "+v"(fq));
        const int col0 = u.pn * 256 + wc * 32 + 8 * fq;
        f32x4 bv[2][2];
#pragma unroll
        for (int bj = 0; bj < 2; ++bj)
#pragma unroll
            for (int n = 0; n < 2; ++n) bv[bj][n] = *(const f32x4*)(bias + col0 + bj * 128 + 4 * n);
#pragma unroll
        for (int ai = 0; ai < 2; ++ai)
#pragma unroll
            for (int m = 0; m < 4; ++m) { const int r = u.pm * 256 + ai * 128 + wr * 64 + m * 16 + fr; float ss = 0.f;
#pragma unroll
                for (int bj = 0; bj < 2; ++bj) { const size_t off = (size_t)r * DS + col0 + bj * 128;
                    const u32x4 yy = *(const u32x4*)(yg + off), gg = *(const u32x4*)(gs + off);
                    const f32x4 a = acc[ai][bj][m][0] + bv[bj][0], b = acc[ai][bj][m][1] + bv[bj][1];
                    float z[8];
                    z[0] = bf2f(yy.x & 0xffffu) * sigmoid_f(a[0]); z[1] = bf2f(yy.x >> 16) * sigmoid_f(a[1]); z[2] = bf2f(yy.y & 0xffffu) * sigmoid_f(a[2]); z[3] = bf2f(yy.y >> 16) * sigmoid_f(a[3]);
                    z[4] = bf2f(yy.z & 0xffffu) * sigmoid_f(b[0]); z[5] = bf2f(yy.z >> 16) * sigmoid_f(b[1]); z[6] = bf2f(yy.w & 0xffffu) * sigmoid_f(b[2]); z[7] = bf2f(yy.w >> 16) * sigmoid_f(b[3]);
#pragma unroll
                    for (int j = 0; j < 8; ++j) ss += z[j] * z[j];
                    z[0] *= bf2f(gg.x & 0xffffu); z[1] *= bf2f(gg.x >> 16); z[2] *= bf2f(gg.y & 0xffffu); z[3] *= bf2f(gg.y >> 16);
                    z[4] *= bf2f(gg.z & 0xffffu); z[5] *= bf2f(gg.z >> 16); z[6] *= bf2f(gg.w & 0xffffu); z[7] *= bf2f(gg.w >> 16);
                    u32x4 w; w.x = cvt_pk_bf16(z[0], z[1]); w.y = cvt_pk_bf16(z[2], z[3]); w.z = cvt_pk_bf16(z[4], z[5]); w.w = cvt_pk_bf16(z[6], z[7]);
                    *(u32x4*)(ycat + (size_t)r * DM + col0 + bj * 128) = w; }
                ss = xor_add<16>(ss); ss = xor_add<32>(ss);
                if (fq == 0) ssq2[(size_t)r * 32 + u.pn * 4 + wc] = ss;
                asm volatile("" ::: "memory"); }
    }
};
struct EpiOut {
    static constexpr bool PERM = false, AFTER_DRAIN = false, MIDK = true;
    const LAS float* rs2; const float* res; float* out; bf16_t* xb; float* ssq;
    __device__ __forceinline__ void midk(Acc& acc, int wr, int fr) const {
        asm volatile("" : "+v"(fr));
#pragma unroll
        for (int ai = 0; ai < 2; ++ai)
#pragma unroll
            for (int m = 0; m < 4; ++m) { const float s = rs2[ai * 128 + wr * 64 + m * 16 + fr];
#pragma unroll
                for (int bj = 0; bj < 2; ++bj)
#pragma unroll
                    for (int n = 0; n < 2; ++n) acc[ai][bj][m][n] *= s; }
    }
    __device__ __forceinline__ void operator()(const Acc& acc, const Unit& u, int wr, int wc, int fr, int fq) const {
        asm volatile("" : "+v"(fr), "+v"(fq));
        const int col0 = u.pn * 256 + wc * 32 + 4 * fq;
#pragma unroll
        for (int ai = 0; ai < 2; ++ai)
#pragma unroll
            for (int m = 0; m < 4; ++m) { const int r = u.pm * 256 + ai * 128 + wr * 64 + m * 16 + fr; float ss = 0.f;
#pragma unroll
                for (int bj = 0; bj < 2; ++bj)
#pragma unroll
                    for (int n = 0; n < 2; ++n) { const size_t off = (size_t)r * DM + col0 + bj * 128 + n * 16;
                        const f32x4 x = *(const f32x4*)(res + off) + acc[ai][bj][m][n];
                        *(f32x4*)(out + off) = x; ss += (x[0] * x[0] + x[1] * x[1]) + (x[2] * x[2] + x[3] * x[3]);
                        if (xb) { u32x2 w; w.x = cvt_pk_bf16(x[0], x[1]); w.y = cvt_pk_bf16(x[2], x[3]); *(u32x2*)(xb + off) = w; } }
                ss = xor_add<16>(ss); ss = xor_add<32>(ss);
                if (fq == 0) ssq[(size_t)r * 64 + u.pn * 4 + wc] = ss;
                asm volatile("" ::: "memory"); }
    }
};

struct Args { const float* in[17]; float* out; unsigned char* ws; int ph_lo, ph_hi; };
enum { I_X = 0, I_NORMW, I_WIN, I_LRE, I_LIM, I_BRE, I_BIM, I_CRE, I_CIM, I_D, I_LOGDT, I_WGLU, I_BGLU, I_SNW, I_RNW, I_WOUT, I_FNW };

typedef const __attribute__((address_space(4))) Args* ArgsP;
struct Frame {
    LAS unsigned char* lds; int tid, lane, wave, vcu, G, bid; unsigned char* ws;
};

__device__ __forceinline__ void transpose_item(const float* W, int K, int N, bf16_t* WT, const float* ks0, const float* ks1, int ksplit, int remap, int item, int lane) {
    const int nblk = N / 64, kb = item / nblk, nb = item % nblk, k0 = 64 * kb, nq = lane & 15, kq = lane >> 4; int n0 = 64 * nb;
    const float* wp = W + (size_t)(k0 + 16 * kq) * N + n0 + 4 * nq;
    f32x4 v[16];
#pragma unroll
    for (int i = 0; i < 16; ++i) v[i] = *(const f32x4*)(wp + (size_t)i * N);
    if (ks0) { const float* ks = ((k0 < ksplit) ? ks0 + k0 : ks1 + (k0 - ksplit)) + 16 * kq;
#pragma unroll
        for (int i = 0; i < 4; ++i) { const f32x4 sc = *(const f32x4*)(ks + 4 * i);
#pragma unroll
            for (int j = 0; j < 4; ++j) v[4 * i + j] = v[4 * i + j] * sc[j]; } }
    if (remap) { if (n0 >= 10240) n0 -= 2048; else if (n0 >= 8192) n0 += 2048; }
#pragma unroll
    for (int c = 0; c < 4; ++c) { bf16_t* dst = WT + (size_t)(n0 + 4 * nq + c) * K + k0 + 16 * kq;
        u32x4 o0, o1;
        o0.x = pk2(v[0][c], v[1][c]); o0.y = pk2(v[2][c], v[3][c]); o0.z = pk2(v[4][c], v[5][c]); o0.w = pk2(v[6][c], v[7][c]);
        o1.x = pk2(v[8][c], v[9][c]); o1.y = pk2(v[10][c], v[11][c]); o1.z = pk2(v[12][c], v[13][c]); o1.w = pk2(v[14][c], v[15][c]);
        *(u32x4*)dst = o0; *(u32x4*)(dst + 8) = o1; }
}

__device__ __forceinline__ void ssm_mats_item(const Frame& F, ArgsP a, int l, int g) {
    const int lg = l * NG + g, tid = F.tid;
    LAS float* apr = (LAS float*)F.lds;
    LAS float* api = apr + 17 * 64;
    LAS float* bbr = api + 17 * 64;
    LAS float* bbi = bbr + 1024;
    LAS float* crs = bbi + 1024;
    LAS float* cis = crs + 1024;
    LAS float* Kt = cis + 1024;
    const float dtf = expf(a->in[I_LOGDT][lg]);
    for (int e = tid; e < 17 * 64; e += 512) { const int tau = e >> 6, n = e & 63; const float lr = a->in[I_LRE][lg * 64 + n], li = a->in[I_LIM][lg * 64 + n];
        float c, s; cis_d((double)li * (double)dtf * tau, c, s); const float mag = expf(lr * dtf * (float)tau); apr[e] = mag * c; api[e] = mag * s; }
    for (int e = tid; e < 1024; e += 512) { crs[e] = a->in[I_CRE][(size_t)lg * 1024 + e]; cis[e] = a->in[I_CIM][(size_t)lg * 1024 + e]; }
    __syncthreads();
    for (int e = tid; e < 1024; e += 512) { const int n = e >> 4; const float lr = a->in[I_LRE][lg * 64 + n], li = a->in[I_LIM][lg * 64 + n];
        const float nr = apr[64 + n] - 1.f, ni = api[64 + n], den = lr * lr + li * li, cor = (nr * lr + ni * li) / den, coi = (ni * lr - nr * li) / den;
        const float br = a->in[I_BRE][(size_t)lg * 1024 + e], bi = a->in[I_BIM][(size_t)lg * 1024 + e];
        bbr[e] = cor * br - coi * bi; bbi[e] = cor * bi + coi * br; }
    if (tid < 64) ((float2*)(F.ws + WS_A16))[lg * 64 + tid] = make_float2(apr[16 * 64 + tid], api[16 * 64 + tid]);
    __syncthreads();
    { const int tau = tid >> 5, hp = (tid >> 1) & 15, h0 = (tid & 1) * 8; float sum[8];
#pragma unroll
      for (int j = 0; j < 8; ++j) sum[j] = 0.f;
      for (int n = 0; n < 64; ++n) { const float cr = crs[hp * 64 + n], ci = cis[hp * 64 + n], ar = apr[tau * 64 + n], ai = api[tau * 64 + n], pr = cr * ar - ci * ai, pi = cr * ai + ci * ar;
          const f32x4 b0 = *(const LAS f32x4*)(bbr + n * 16 + h0), b1 = *(const LAS f32x4*)(bbr + n * 16 + h0 + 4), d0 = *(const LAS f32x4*)(bbi + n * 16 + h0), d1 = *(const LAS f32x4*)(bbi + n * 16 + h0 + 4);
#pragma unroll
          for (int j = 0; j < 4; ++j) { sum[j] += pr * b0[j] - pi * d0[j]; sum[4 + j] += pr * b1[j] - pi * d1[j]; } }
#pragma unroll
      for (int j = 0; j < 8; ++j) Kt[(tau << 8) + (hp << 4) + h0 + j] = sum[j]; }
    __syncthreads();
    bf16_t* bt2 = (bf16_t*)(F.ws + WS_BT2) + (size_t)lg * 256 * A2LD;
    for (int e = tid; e < 256 * A2LD / 8; e += 512) { const int row = e / 48, c0 = (e % 48) * 8, t = row >> 4, hp = row & 15; float v[8];
        if (c0 < 256) { const int j = c0 >> 4, h0 = c0 & 15;
#pragma unroll
            for (int i = 0; i < 8; ++i) v[i] = (t >= j) ? Kt[((t - j) << 8) + (hp << 4) + h0 + i] : 0.f;
        } else { const int nn = c0 - 256;
#pragma unroll
            for (int i = 0; i < 8; ++i) { const int n = (nn + i) & 63; const float cr = crs[hp * 64 + n], ci = cis[hp * 64 + n], ar = apr[(t + 1) * 64 + n], ai = api[(t + 1) * 64 + n];
                v[i] = (nn < 64) ? (cr * ar - ci * ai) : -(cr * ai + ci * ar); } }
        u32x4 w; w.x = pk2(v[0], v[1]); w.y = pk2(v[2], v[3]); w.z = pk2(v[4], v[5]); w.w = pk2(v[6], v[7]);
        *(u32x4*)(bt2 + (size_t)row * A2LD + c0) = w; }
    bf16_t* pm = (bf16_t*)(F.ws + WS_PM) + (size_t)lg * 256 * 256;
    for (int e = tid; e < 256 * 256 / 8; e += 512) { const int row = e >> 5, c0 = (e & 31) * 8; float v[8];
        if (row < 128) { const int n = row & 63, im = row >> 6, j = c0 >> 4, h0 = c0 & 15; const float ar = apr[(15 - j) * 64 + n], ai = api[(15 - j) * 64 + n];
#pragma unroll
            for (int i = 0; i < 8; ++i) { const float br = bbr[n * 16 + h0 + i], bi = bbi[n * 16 + h0 + i]; v[i] = im ? (ar * bi + ai * br) : (ar * br - ai * bi); }
        } else {
#pragma unroll
            for (int i = 0; i < 8; ++i) v[i] = 0.f; }
        u32x4 w; w.x = pk2(v[0], v[1]); w.y = pk2(v[2], v[3]); w.z = pk2(v[4], v[5]); w.w = pk2(v[6], v[7]);
        *(u32x4*)(pm + (size_t)row * 256 + c0) = w; }
    __syncthreads();
}

__device__ __forceinline__ void p0_prologue(const Frame& F, ArgsP a) {
    for (int it = F.vcu; it < DEPTH * NG; it += F.G) ssm_mats_item(F, a, it / NG, it % NG);
    { float2* rope = (float2*)(F.ws + WS_ROPE);
      for (int e = F.vcu * 512 + F.tid; e < SEQ * 128; e += F.G * 512) { const int pos = e >> 7, i = e & 127;
          const double inv = (double)expf(-(float)(2 * i) * (9.210340371976184f / 256.0f)); float c, s; cis_d((double)pos * inv, c, s); rope[e] = make_float2(c, s); } }
    const int gw = F.vcu * 8 + F.wave, NGW = F.G * 8;
    for (int m = gw; m < MTOK; m += NGW) {
        const f32x4* xr = (const f32x4*)(a->in[I_X] + (size_t)m * DM) + F.lane; float ss = 0.f; f32x4 v[16];
#pragma unroll
        for (int j = 0; j < 16; ++j) { v[j] = xr[64 * j]; ss += (v[j][0] * v[j][0] + v[j][1] * v[j][1]) + (v[j][2] * v[j][2] + v[j][3] * v[j][3]); }
        ss = wave_sum(ss);
        u32x2* o = (u32x2*)((bf16_t*)(F.ws + WS_XB) + (size_t)m * DM) + F.lane;
#pragma unroll
        for (int j = 0; j < 16; ++j) { u32x2 w; w.x = pk2(v[j][0], v[j][1]); w.y = pk2(v[j][2], v[j][3]); o[64 * j] = w; }
        ((float*)(F.ws + WS_SSQX))[(size_t)m * 64 + F.lane] = (F.lane == 0) ? ss : 0.f;
    }
    constexpr int I_IN = (DM / 64) * (NPROJ / 64), I_GLU = (DS / 64) * (DS / 64), I_OUT = (DM / 64) * (DM / 64), I_L = I_IN + I_GLU + I_OUT;
    for (int it = gw; it < DEPTH * I_L; it += NGW) {
        const int l = it / I_L; int r = it % I_L;
        if (r < I_IN) { transpose_item(a->in[I_WIN] + (size_t)l * DM * NPROJ, DM, NPROJ, (bf16_t*)(F.ws + WS_WTIN) + (size_t)l * NPROJ * DM, a->in[I_NORMW] + l * DM, a->in[I_NORMW] + l * DM, 1 << 30, 1, r, F.lane); continue; } r -= I_IN;
        if (r < I_GLU) { transpose_item(a->in[I_WGLU] + (size_t)l * DS * DS, DS, DS, (bf16_t*)(F.ws + WS_WTGLU) + (size_t)l * DS * DS, nullptr, nullptr, 1 << 30, 0, r, F.lane); continue; } r -= I_GLU;
        transpose_item(a->in[I_WOUT] + (size_t)l * DM * DM, DM, DM, (bf16_t*)(F.ws + WS_WTOUT) + (size_t)l * DM * DM, a->in[I_SNW] + l * DS, a->in[I_RNW] + l * DR, DS, 0, r, F.lane);
    }
}

__device__ __forceinline__ void stash_rstd(const Frame& F, const float* slots, int nslot, int panel, float inv_dim) {
    __syncthreads();
    if (F.tid < 256) { const f32x4* p = (const f32x4*)(slots + (size_t)(panel * 256 + F.tid) * nslot); float s = 0.f;
        for (int j = 0; j < nslot / 4; ++j) { const f32x4 t = p[j]; s += (t[0] + t[1]) + (t[2] + t[3]); }
        ((LAS float*)(F.lds + STASH_OFF))[F.tid] = __builtin_amdgcn_rsqf(s * inv_dim + EPS); }
    __syncthreads();
}

__device__ __forceinline__ void p1_inproj(const Frame& F, int l) {
    const bf16_t* xb = (const bf16_t*)(F.ws + WS_XB); const bf16_t* wt = (const bf16_t*)(F.ws + WS_WTIN) + (size_t)l * NPROJ * DM;
    const LAS float* rs = (const LAS float*)(F.lds + STASH_OFF);
    { pg8::StaticOrder S; S.init(MTOK, 10240, F.G, F.bid); Unit u0; S.next(0, u0);
      stash_rstd(F, (const float*)(F.ws + WS_SSQX), 64, u0.pm, 1.f / DM);
      pg8::Gemm g{xb, wt, DM, DM, DM, -1};
      EpiInProj E{rs, (bf16_t*)(F.ws + WS_A2U), (bf16_t*)(F.ws + WS_GS), (bf16_t*)(F.ws + WS_Q), (bf16_t*)(F.ws + WS_K), (bf16_t*)(F.ws + WS_GR), (const float*)(F.ws + WS_ROPE)};
      pg8::gemm_phase<EpiInProj, pg8::StaticOrder, true, true>(F.lds, g, S, E, F.tid); }
    { pg8::StaticOrder S; S.init(DR, MTOK, F.G, F.bid); Unit u0; S.next(0, u0);
      stash_rstd(F, (const float*)(F.ws + WS_SSQX), 64, u0.pn, 1.f / DM);
      pg8::Gemm g{wt + (size_t)10240 * DM, xb, DM, DM, DM, -1};
      EpiVT E{rs, (bf16_t*)(F.ws + WS_VT)};
      pg8::gemm_phase<EpiVT, pg8::StaticOrder, true, true>(F.lds, g, S, E, F.tid); }
}

__device__ __forceinline__ void p2_ssm(const Frame& F, ArgsP a, int l) {
    for (int it = F.vcu; it < NG * 2; it += F.G) {
        const int g = it >> 1, bp = it & 1, lg = l * NG + g;
        bf16_t* a2g = (bf16_t*)(F.ws + WS_A2U) + (size_t)g * 512 * A2LD;
        { pg8::Gemm g1{a2g, (const bf16_t*)(F.ws + WS_PM) + (size_t)lg * 256 * 256, 256, A2LD, 256, -1}; pg8::OneUnit S{bp, 0}; EpiSloc E{};
          pg8::gemm_phase<EpiSloc, pg8::OneUnit, false, true>(F.lds, g1, S, E, F.tid); }
        LDS_WAIT(); __syncthreads();
        int t2 = F.tid; asm volatile("" : "+v"(t2));
        if (t2 < 128) {
            const int bb = t2 >> 6, n = t2 & 63; const float2 a16 = ((const float2*)(F.ws + WS_A16))[lg * 64 + n];
            const LAS float* S = (const LAS float*)F.lds + (bb * 128) * SLD; bf16_t* dst = a2g + (size_t)(bp * 256 + bb * 128) * A2LD + 256 + n;
            float sr = 0.f, si = 0.f;
#pragma unroll 8
            for (int c = 0; c < 128; ++c) { dst[(size_t)c * A2LD] = (bf16_t)f2bf(sr); dst[(size_t)c * A2LD + 64] = (bf16_t)f2bf(si);
                const float lr = S[c * SLD + n], li = S[c * SLD + 64 + n]; const float nr = a16.x * sr - a16.y * si + lr, ni = a16.x * si + a16.y * sr + li; sr = nr; si = ni; }
        }
        VM_WAIT(); __syncthreads();
        if (F.tid == 0) { __builtin_amdgcn_fence(__ATOMIC_ACQUIRE, "agent"); VM_WAIT(); }
        __syncthreads();
        { pg8::Gemm g2{a2g, (const bf16_t*)(F.ws + WS_BT2) + (size_t)lg * 256 * A2LD, A2LD, A2LD, A2LD, -1}; pg8::OneUnit S{bp, 0};
          EpiSsmOut E{a2g, a->in[I_D] + (size_t)l * DS + g * 16, (bf16_t*)(F.ws + WS_YG), g};
          pg8::gemm_phase<EpiSsmOut, pg8::OneUnit, false, true>(F.lds, g2, S, E, F.tid); }
        __syncthreads();
    }
}


typedef float f32x16 __attribute__((ext_vector_type(16)));
constexpr int RT_K0 = 0, RT_V0 = 65536, RT_P = 131072, RT_RED = 147456, RT_OLD = 528;
#define RT_BAR() do { asm volatile("s_waitcnt lgkmcnt(0)" ::: "memory"); __builtin_amdgcn_s_barrier(); asm volatile("" ::: "memory"); } while (0)
__device__ __forceinline__ void p2_ret(const Frame& F) {
    int t_ = F.tid; asm volatile("" : "+v"(t_));
    const int tid = t_, lane = tid & 63, w = __builtin_amdgcn_readfirstlane(tid >> 6), wr = w & 3, wc = w >> 2, l31 = lane & 31, hh = lane >> 5;
    LAS unsigned char* lds = F.lds;
    const bf16_t* qg = (const bf16_t*)(F.ws + WS_Q); const bf16_t* kg = (const bf16_t*)(F.ws + WS_K); const bf16_t* vtg = (const bf16_t*)(F.ws + WS_VT);
    const bf16_t* grg = (const bf16_t*)(F.ws + WS_GR); bf16_t* ycat = (bf16_t*)(F.ws + WS_YCAT);
    const unsigned koff = (unsigned)((2 * w + hh) * 4096 + ((l31 ^ ((2 * w + hh) & 15)) << 4));
    const unsigned voff = (unsigned)((8 * w + (lane >> 3)) * 16384 + (((lane & 7) ^ (((lane >> 4) + 4 * w) & 7)) << 4));
    for (int it = F.vcu; it < BATCH * RH * 8; it += F.G) {
        const int bh = it >> 3, p = it & 7, b = bh >> 3, h = bh & 7;
        const float e = __builtin_amdgcn_exp2f((float)(-5 - h));
        const float lg2 = -(e * (1.f + e * (0.5f + e * (0.33333334f + e * (0.25f + e * (0.2f + e * 0.16666667f)))))) * 1.4426950408889634f;
        for (int uu = 0; uu < 2; ++uu) {
            const int qi = uu ? p : 15 - p, ntile = 2 * (qi + 1);
            const size_t tokq = (size_t)b * SEQ + qi * 128;
            bf16x8 qf[16];
            { const bf16_t* qp = qg + (tokq + wr * 32 + l31) * DR + h * 256 + 8 * hh;
#pragma unroll
              for (int s = 0; s < 16; ++s) qf[s] = *(const bf16x8*)(qp + 16 * s); }
            f32x16 oacc[4];
#pragma unroll
            for (int db = 0; db < 4; ++db)
#pragma unroll
                for (int r = 0; r < 16; ++r) oacc[db][r] = 0.f;
#define RT_DMA(kt_, bf_) do { const char* kb_ = (const char*)(kg + ((size_t)(b * SEQ + (kt_) * 64) * DR + h * 256)) + koff; const char* vb_ = (const char*)(vtg + ((size_t)(h * 256) * MTOK + b * SEQ + (kt_) * 64)) + voff; \
            _Pragma("unroll") for (int i_ = 0; i_ < 4; ++i_) __builtin_amdgcn_global_load_lds((const unsigned*)(kb_ + i_ * 65536), (LAS unsigned*)(lds + RT_K0 + (bf_) * 32768 + (w + 8 * i_) * 1024), 16, 0, 0); \
            _Pragma("unroll") for (int i_ = 0; i_ < 4; ++i_) __builtin_amdgcn_global_load_lds((const unsigned*)(vb_ + i_ * 1048576), (LAS unsigned*)(lds + RT_V0 + (bf_) * 32768 + (w + 8 * i_) * 1024), 16, 0, 0); } while (0)
            RT_DMA(0, 0);
            asm volatile("s_waitcnt vmcnt(0)" ::: "memory"); RT_BAR();
            for (int kt = 0; kt < ntile; ++kt) {
                const int bf = kt & 1;
                if (kt + 1 < ntile) RT_DMA(kt + 1, bf ^ 1);
                int lo_ = lane; asm volatile("" : "+v"(lo_));
                const int l31 = lo_ & 31, hh = lo_ >> 5, x15 = l31 & 15, m4 = ((l31 >> 1) & 7) << 4, lane = lo_;
                f32x16 st;
#pragma unroll
                for (int r = 0; r < 16; ++r) st[r] = 0.f;
                { const LAS unsigned char* kb = lds + RT_K0 + bf * 32768 + (32 * wc + l31) * 512;
#define RT_KRD(dst, s0) do { _Pragma("unroll") for (int j_ = 0; j_ < 4; ++j_) dst[j_] = *(const LAS bf16x8*)(kb + ((((2 * ((s0) + j_)) | hh) ^ x15) << 4)); } while (0)
#define RT_KMM(src, s0) do { _Pragma("unroll") for (int j_ = 0; j_ < 4; ++j_) st = __builtin_amdgcn_mfma_f32_32x32x16_bf16(src[j_], qf[(s0) + j_], st, 0, 0, 0); } while (0)
                  bf16x8 ka[4], kc[4];
                  RT_KRD(ka, 0); __builtin_amdgcn_sched_barrier(0);
                  RT_KRD(kc, 4); RT_KMM(ka, 0); __builtin_amdgcn_sched_barrier(0);
                  RT_KRD(ka, 8); RT_KMM(kc, 4); __builtin_amdgcn_sched_barrier(0);
                  RT_KRD(kc, 12); RT_KMM(ka, 8); __builtin_amdgcn_sched_barrier(0);
                  RT_KMM(kc, 12); __builtin_amdgcn_sched_barrier(0);
#undef RT_KRD
#undef RT_KMM
                }
                { const int nb = (2 * qi - kt) * 64 - 32 * wc - 4 * hh;
                  const bool diag = kt >= 2 * qi; const int lim = wr * 32 + l31 + nb;
                  unsigned pk[8];
#pragma unroll
                  for (int i = 0; i < 8; ++i) { const int r0 = 2 * i, r1 = 2 * i + 1, o0 = (r0 & 3) + 8 * (r0 >> 2), o1 = (r1 & 3) + 8 * (r1 >> 2);
                      float v0 = st[r0] * __builtin_amdgcn_exp2f((float)(nb - o0) * lg2), v1 = st[r1] * __builtin_amdgcn_exp2f((float)(nb - o1) * lg2);
                      if (diag) { v0 = (o0 <= lim) ? v0 : 0.f; v1 = (o1 <= lim) ? v1 : 0.f; }
                      pk[i] = cvt_pk_bf16(v0, v1); }
                  LAS unsigned char* pw = lds + RT_P + ((wr * 2 + wc) * 2) * 1024 + lane * 16;
                  *(LAS u32x4*)pw = (u32x4){pk[0], pk[1], pk[2], pk[3]}; *(LAS u32x4*)(pw + 1024) = (u32x4){pk[4], pk[5], pk[6], pk[7]}; }
                RT_BAR();
                { bf16x8 pf[2][2];
#pragma unroll
                  for (int kb2 = 0; kb2 < 2; ++kb2)
#pragma unroll
                      for (int s = 0; s < 2; ++s) pf[kb2][s] = *(const LAS bf16x8*)(lds + RT_P + ((wr * 2 + kb2) * 2 + s) * 1024 + lane * 16);
                  const LAS unsigned char* vb = lds + RT_V0 + bf * 32768 + (128 * wc + l31) * 128 + 8 * hh;
#define RT_VRD(dst, db) do { _Pragma("unroll") for (int j_ = 0; j_ < 4; ++j_) { const int v_ = 4 * (j_ >> 1) + 2 * (j_ & 1); \
                      const u32x2 lo_ = *(const LAS u32x2*)(vb + (db) * 4096 + ((v_ << 4) ^ m4)), hi_ = *(const LAS u32x2*)(vb + (db) * 4096 + (((v_ + 1) << 4) ^ m4)); \
                      dst[j_] = (u32x4){lo_.x, lo_.y, hi_.x, hi_.y}; } } while (0)
#define RT_VMM(src, db) do { _Pragma("unroll") for (int j_ = 0; j_ < 4; ++j_) oacc[db] = __builtin_amdgcn_mfma_f32_32x32x16_bf16(pf[j_ >> 1][j_ & 1], __builtin_bit_cast(bf16x8, src[j_]), oacc[db], 0, 0, 0); } while (0)
                  u32x4 va[4], vc[4];
                  RT_VRD(va, 0); __builtin_amdgcn_sched_barrier(0);
                  RT_VRD(vc, 1); RT_VMM(va, 0); __builtin_amdgcn_sched_barrier(0);
                  RT_VRD(va, 2); RT_VMM(vc, 1); __builtin_amdgcn_sched_barrier(0);
                  RT_VRD(vc, 3); RT_VMM(va, 2); __builtin_amdgcn_sched_barrier(0);
                  RT_VMM(vc, 3); __builtin_amdgcn_sched_barrier(0);
#undef RT_VRD
#undef RT_VMM
                }
                asm volatile("s_waitcnt vmcnt(0)" ::: "memory"); RT_BAR();
            }
            int le_ = tid; asm volatile("" : "+v"(le_));
            const int tide = le_, l31e = le_ & 31, hhe = (le_ >> 5) & 1;
            float ssr[16];
#pragma unroll
            for (int r = 0; r < 16; ++r) { const float rf = __builtin_amdgcn_exp2f((float)(wr * 32 + 4 * hhe + (r & 3) + 8 * (r >> 2)) * lg2); float s2 = 0.f;
#pragma unroll
                for (int db = 0; db < 4; ++db) { const float o = oacc[db][r] * rf; oacc[db][r] = o; s2 += o * o; }
                s2 = xor_add<1>(s2); s2 = xor_add<2>(s2); s2 = xor_add<4>(s2); s2 = xor_add<8>(s2); s2 = xor_add<16>(s2); ssr[r] = s2; }
            if (l31e == 0) {
#pragma unroll
                for (int i = 0; i < 4; ++i) *(LAS f32x4*)(lds + RT_RED + w * 128 + hhe * 64 + i * 16) = (f32x4){ssr[4 * i], ssr[4 * i + 1], ssr[4 * i + 2], ssr[4 * i + 3]}; }
            RT_BAR();
#pragma unroll
            for (int i = 0; i < 4; ++i) { const f32x4 t = *(const LAS f32x4*)(lds + RT_RED + (w ^ 4) * 128 + hhe * 64 + i * 16);
#pragma unroll
                for (int j = 0; j < 4; ++j) ssr[4 * i + j] = __builtin_amdgcn_rsqf((ssr[4 * i + j] + t[j]) * (1.f / 256.f) + EPS); }
#pragma unroll
            for (int r = 0; r < 16; ++r) { LAS unsigned char* ow = lds + (wr * 32 + 4 * hhe + (r & 3) + 8 * (r >> 2)) * RT_OLD + (128 * wc + l31e) * 2;
#pragma unroll
                for (int db = 0; db < 4; ++db) *(LAS unsigned short*)(ow + db * 64) = (unsigned short)f2bf(oacc[db][r] * ssr[r]); }
            RT_BAR();
#pragma unroll
            for (int i = 0; i < 8; ++i) { const int idx = i * 512 + tide, row = idx >> 5, ch = idx & 31; const size_t tok = tokq + row;
                const u32x4 o = *(const LAS u32x4*)(lds + row * RT_OLD + ch * 16), gv = *(const u32x4*)(grg + tok * DR + h * 256 + ch * 8);
                u32x4 y;
                y.x = cvt_pk_bf16(bf2f(o.x & 0xffffu) * bf2f(gv.x & 0xffffu), bf2f(o.x >> 16) * bf2f(gv.x >> 16)); y.y = cvt_pk_bf16(bf2f(o.y & 0xffffu) * bf2f(gv.y & 0xffffu), bf2f(o.y >> 16) * bf2f(gv.y >> 16));
                y.z = cvt_pk_bf16(bf2f(o.z & 0xffffu) * bf2f(gv.z & 0xffffu), bf2f(o.z >> 16) * bf2f(gv.z >> 16)); y.w = cvt_pk_bf16(bf2f(o.w & 0xffffu) * bf2f(gv.w & 0xffffu), bf2f(o.w >> 16) * bf2f(gv.w >> 16));
                *(u32x4*)(ycat + tok * DM + DS + h * 256 + ch * 8) = y; }
            asm volatile("s_waitcnt vmcnt(0)" ::: "memory"); RT_BAR();
#undef RT_DMA
        }
    }
}

__device__ __forceinline__ void p3_glu(const Frame& F, ArgsP a, int l) {
    pg8::StaticOrder S; S.init(MTOK, DS, F.G, F.bid);
    pg8::Gemm g{(const bf16_t*)(F.ws + WS_YG), (const bf16_t*)(F.ws + WS_WTGLU) + (size_t)l * DS * DS, DS, DS, DS, -1};
    EpiGlu E{(const bf16_t*)(F.ws + WS_YG), (const bf16_t*)(F.ws + WS_GS), a->in[I_BGLU] + (size_t)l * DS, (bf16_t*)(F.ws + WS_YCAT), (float*)(F.ws + WS_SSQ2)};
    pg8::gemm_phase<EpiGlu, pg8::StaticOrder, true, true>(F.lds, g, S, E, F.tid);
}

__device__ __forceinline__ void p4_out(const Frame& F, ArgsP a, int l) {
    pg8::StaticOrder S; S.init(MTOK, DM, F.G, F.bid); Unit u0; S.next(0, u0);
    stash_rstd(F, (const float*)(F.ws + WS_SSQ2), 32, u0.pm, 1.f / DS);
    pg8::Gemm g{(const bf16_t*)(F.ws + WS_YCAT), (const bf16_t*)(F.ws + WS_WTOUT) + (size_t)l * DM * DM, DM, DM, DM, DS / 64};
    const bool lastl = (l == DEPTH - 1);
    EpiOut E{(const LAS float*)(F.lds + STASH_OFF), l == 0 ? a->in[I_X] : (const float*)(F.ws + WS_X1), lastl ? a->out : (float*)(F.ws + WS_X1), lastl ? nullptr : (bf16_t*)(F.ws + WS_XB), (float*)(F.ws + WS_SSQX)};
    pg8::gemm_phase<EpiOut, pg8::StaticOrder, true, true>(F.lds, g, S, E, F.tid);
}

__device__ __forceinline__ void p5_final(const Frame& F, ArgsP a) {
    const int gw = F.vcu * 8 + F.wave, NGW = F.G * 8; const f32x4* fw = (const f32x4*)a->in[I_FNW] + F.lane;
    for (int m = gw; m < MTOK; m += NGW) {
        const float s = wave_sum(((const float*)(F.ws + WS_SSQX))[(size_t)m * 64 + F.lane]); const float rstd = __builtin_amdgcn_rsqf(s * (1.f / DM) + EPS);
        f32x4* xr = (f32x4*)(a->out + (size_t)m * DM) + F.lane;
#pragma unroll
        for (int j = 0; j < 16; ++j) xr[64 * j] = xr[64 * j] * rstd * fw[64 * j];
    }
}

constexpr int NPH = 2 + 4 * DEPTH;
__global__ void __launch_bounds__(512, 2) mk_fwd(Args args) {
    extern __shared__ __attribute__((aligned(16))) unsigned char lds_raw[];
    cg::grid_group grid = cg::this_grid();
    Frame F; F.lds = (LAS unsigned char*)lds_raw; F.G = gridDim.x;
    const int wave0 = __builtin_amdgcn_readfirstlane((int)threadIdx.x >> 6);
    for (int ph = args.ph_lo; ph < args.ph_hi; ++ph) {
        ArgsP ap = (ArgsP)__builtin_amdgcn_kernarg_segment_ptr(); asm volatile("" : "+s"(ap));
        { unsigned m_ = ~0u; asm volatile("" : "+s"(m_)); int t_ = wave0 * 64 + (int)__builtin_amdgcn_mbcnt_hi(m_, __builtin_amdgcn_mbcnt_lo(m_, 0u)); asm volatile("" : "+v"(t_)); F.tid = t_; F.lane = t_ & 63; F.wave = wave0;
          int b_ = blockIdx.x; asm volatile("" : "+s"(b_)); F.bid = b_; F.vcu = (F.G % 8 == 0) ? (b_ % 8) * (F.G / 8) + b_ / 8 : b_;
          size_t z_ = 0; asm volatile("" : "+s"(z_)); F.ws = ap->ws + z_; }
#ifndef PHMASK
#define PHMASK 127
#endif
        if (ph == 0) { if (PHMASK & 1) p0_prologue(F, ap); }
        else if (ph == NPH - 1) { if (PHMASK & 32) p5_final(F, ap); }
        else { const int l = (ph - 1) >> 2, s = (ph - 1) & 3;
            if (s == 0) { if (PHMASK & 2) p1_inproj(F, l); }
            else if (s == 1) {
#if FAST_SSM
                if (PHMASK & 4) p2_ssm(F, ap, l);
#endif
#if FAST_RET
                if (PHMASK & 64) p2_ret(F);
#endif
            }
            else if (s == 2) { if (PHMASK & 8) p3_glu(F, ap, l); }
            else { if (PHMASK & 16) p4_out(F, ap, l); } }
#ifdef REPEAT_MASK
        __syncthreads();
        { const int s2 = (ph - 1) & 3, l2 = (ph - 1) >> 2;
          if (ph == 0) { if (REPEAT_MASK & 1) p0_prologue(F, ap); }
          else if (ph < NPH - 1) {
            if (s2 == 0 && (REPEAT_MASK & 2)) p1_inproj(F, l2);
            if (s2 == 1 && (REPEAT_MASK & 4)) p2_ssm(F, ap, l2);
            if (s2 == 1 && (REPEAT_MASK & 64)) p2_ret(F);
            if (s2 == 2 && (REPEAT_MASK & 8)) p3_glu(F, ap, l2);
            if (s2 == 3 && (REPEAT_MASK & 16)) p4_out(F, ap, l2); } }
#endif
        if (ph + 1 < args.ph_hi) grid.sync();
    }
}

__global__ void __launch_bounds__(64) naive_ssm(Args args, int l) {
    const int b = blockIdx.x >> 7, g = blockIdx.x & 127, lg = l * NG + g, n = threadIdx.x;
    const double dt = (double)expf(args.in[I_LOGDT][lg]);
    const float lr = args.in[I_LRE][lg * 64 + n], li = args.in[I_LIM][lg * 64 + n];
    float ac, as; cis_d((double)li * dt, ac, as); const float mag = expf(lr * (float)dt); const float ar = mag * ac, ai = mag * as;
    const float nr = ar - 1.f, ni = ai, den = lr * lr + li * li, cor = (nr * lr + ni * li) / den, coi = (ni * lr - nr * li) / den;
    float bbr[16], bbi[16], cr[16], ci[16];
#pragma unroll
    for (int h = 0; h < 16; ++h) { const float br = args.in[I_BRE][(size_t)(lg * 64 + n) * 16 + h], bi = args.in[I_BIM][(size_t)(lg * 64 + n) * 16 + h];
        bbr[h] = cor * br - coi * bi; bbi[h] = cor * bi + coi * br; cr[h] = args.in[I_CRE][(size_t)(lg * 16 + h) * 64 + n]; ci[h] = args.in[I_CIM][(size_t)(lg * 16 + h) * 64 + n]; }
    const float dsk = args.in[I_D][(size_t)l * DS + g * 16 + (n & 15)];
    const bf16_t* a2g = (const bf16_t*)(args.ws + WS_A2U) + (size_t)g * 512 * A2LD; bf16_t* yg = (bf16_t*)(args.ws + WS_YG);
    float sr = 0.f, si = 0.f;
    for (int t = 0; t < SEQ; ++t) {
        const u32x4* up = (const u32x4*)(a2g + (size_t)(b * 128 + (t >> 4)) * A2LD + (t & 15) * 16); const u32x4 u0 = up[0], u1 = up[1];
        float uv[16];
        uv[0] = bf2f(u0.x & 0xffffu); uv[1] = bf2f(u0.x >> 16); uv[2] = bf2f(u0.y & 0xffffu); uv[3] = bf2f(u0.y >> 16); uv[4] = bf2f(u0.z & 0xffffu); uv[5] = bf2f(u0.z >> 16); uv[6] = bf2f(u0.w & 0xffffu); uv[7] = bf2f(u0.w >> 16);
        uv[8] = bf2f(u1.x & 0xffffu); uv[9] = bf2f(u1.x >> 16); uv[10] = bf2f(u1.y & 0xffffu); uv[11] = bf2f(u1.y >> 16); uv[12] = bf2f(u1.z & 0xffffu); uv[13] = bf2f(u1.z >> 16); uv[14] = bf2f(u1.w & 0xffffu); uv[15] = bf2f(u1.w >> 16);
        float bur = 0.f, bui = 0.f;
#pragma unroll
        for (int h = 0; h < 16; ++h) { bur += bbr[h] * uv[h]; bui += bbi[h] * uv[h]; }
        const float nsr = ar * sr - ai * si + bur, nsi = ar * si + ai * sr + bui; sr = nsr; si = nsi;
        float y = 0.f, um = 0.f;
#pragma unroll
        for (int h = 0; h < 16; ++h) { const float p = wave_sum(cr[h] * sr - ci[h] * si); if (n == h) { y = p; um = uv[h]; } }
        if (n < 16) yg[(size_t)(b * SEQ + t) * DS + g * 16 + n] = (bf16_t)f2bf(gelu_tanh_f(y + dsk * um));
    }
}

constexpr int NR_KLD = 264;
__global__ void __launch_bounds__(256) naive_ret(Args args, int l) {
    extern __shared__ __attribute__((aligned(16))) unsigned char sm[];
    bf16_t* Qs = (bf16_t*)sm;
    bf16_t* Ks = Qs + 32 * 256;
    float* Ss = (float*)(Ks + 64 * NR_KLD);
    float* red = Ss + 32 * 64;
    const int qt = blockIdx.x & 63, h = (blockIdx.x >> 6) & 7, b = blockIdx.x >> 9, tid = threadIdx.x, lane = tid & 63, wv = tid >> 6;
    const bf16_t* q = (const bf16_t*)(args.ws + WS_Q); const bf16_t* k = (const bf16_t*)(args.ws + WS_K); const bf16_t* vt = (const bf16_t*)(args.ws + WS_VT); const bf16_t* gr = (const bf16_t*)(args.ws + WS_GR);
    const int tok0 = b * SEQ + qt * 32;
    for (int e = tid; e < 32 * 32; e += 256) { const int r = e >> 5, c = (e & 31) * 8; *(u32x4*)(Qs + r * 256 + c) = *(const u32x4*)(q + (size_t)(tok0 + r) * DR + h * 256 + c); }
    const float lg2 = log2f(1.f - exp2f(-5.f - (float)h));
    float o[32];
#pragma unroll
    for (int r = 0; r < 32; ++r) o[r] = 0.f;
    const int ntile = qt / 2 + 1;
    for (int kt = 0; kt < ntile; ++kt) {
        __syncthreads();
        for (int e = tid; e < 64 * 32; e += 256) { const int r = e >> 5, c = (e & 31) * 8; *(u32x4*)(Ks + r * NR_KLD + c) = *(const u32x4*)(k + (size_t)(b * SEQ + kt * 64 + r) * DR + h * 256 + c); }
        __syncthreads();
        { const int key = lane, rg = wv; float acc[8];
#pragma unroll
          for (int r = 0; r < 8; ++r) acc[r] = 0.f;
          for (int d = 0; d < 256; d += 8) { const u32x4 kv = *(const u32x4*)(Ks + key * NR_KLD + d);
              const float k0 = bf2f(kv.x & 0xffffu), k1 = bf2f(kv.x >> 16), k2 = bf2f(kv.y & 0xffffu), k3 = bf2f(kv.y >> 16), k4 = bf2f(kv.z & 0xffffu), k5 = bf2f(kv.z >> 16), k6 = bf2f(kv.w & 0xffffu), k7 = bf2f(kv.w >> 16);
#pragma unroll
              for (int r = 0; r < 8; ++r) { const u32x4 qv = *(const u32x4*)(Qs + (rg * 8 + r) * 256 + d);
                  acc[r] += bf2f(qv.x & 0xffffu) * k0 + bf2f(qv.x >> 16) * k1 + bf2f(qv.y & 0xffffu) * k2 + bf2f(qv.y >> 16) * k3 + bf2f(qv.z & 0xffffu) * k4 + bf2f(qv.z >> 16) * k5 + bf2f(qv.w & 0xffffu) * k6 + bf2f(qv.w >> 16) * k7; } }
#pragma unroll
          for (int r = 0; r < 8; ++r) { const int i = qt * 32 + rg * 8 + r, j = kt * 64 + key; Ss[(rg * 8 + r) * 64 + key] = (i >= j) ? acc[r] * exp2f((float)(i - j) * lg2) : 0.f; } }
        __syncthreads();
        { const bf16_t* vr = vt + (size_t)(h * 256 + tid) * MTOK + b * SEQ + kt * 64;
          for (int kk = 0; kk < 64; kk += 8) { const u32x4 vv = *(const u32x4*)(vr + kk);
              const float v0 = bf2f(vv.x & 0xffffu), v1 = bf2f(vv.x >> 16), v2 = bf2f(vv.y & 0xffffu), v3 = bf2f(vv.y >> 16), v4 = bf2f(vv.z & 0xffffu), v5 = bf2f(vv.z >> 16), v6 = bf2f(vv.w & 0xffffu), v7 = bf2f(vv.w >> 16);
#pragma unroll
              for (int r = 0; r < 32; ++r) { const f32x4 s0 = *(const f32x4*)(Ss + r * 64 + kk), s1 = *(const f32x4*)(Ss + r * 64 + kk + 4);
                  o[r] += s0[0] * v0 + s0[1] * v1 + s0[2] * v2 + s0[3] * v3 + s1[0] * v4 + s1[1] * v5 + s1[2] * v6 + s1[3] * v7; } } }
    }
    __syncthreads();
#pragma unroll
    for (int r = 0; r < 32; ++r) { const float p = wave_sum(o[r] * o[r]); if (lane == 0) red[r * 4 + wv] = p; }
    __syncthreads();
    bf16_t* ycat = (bf16_t*)(args.ws + WS_YCAT);
#pragma unroll
    for (int r = 0; r < 32; ++r) { const float ss = (red[r * 4] + red[r * 4 + 1]) + (red[r * 4 + 2] + red[r * 4 + 3]); const float rstd = __builtin_amdgcn_rsqf(ss * (1.f / 256.f) + EPS);
        const size_t tok = (size_t)(tok0 + r); ycat[tok * DM + DS + h * 256 + tid] = (bf16_t)f2bf(o[r] * rstd * bf2f(gr[tok * DR + h * 256 + tid])); }
}

extern "C" void kernel_launch(void* const* d_in, const int* in_sizes, int n_in, void* d_out, int out_size, void* d_ws, size_t ws_size, hipStream_t stream) {
    static int grid = 0;
    if (grid == 0) {
        if (n_in != 17 || in_sizes[0] != MTOK * DM || out_size != MTOK * DM || ws_size < WS_END) { fprintf(stderr, "kernel_launch: unexpected problem (n_in %d, x %d, out %d, ws %zu)\n", n_in, n_in > 0 ? in_sizes[0] : -1, out_size, ws_size); grid = -1; return; }
        int dev = 0, cus = 0, per_cu = 0;
        hipGetDevice(&dev); hipDeviceGetAttribute(&cus, hipDeviceAttributeMultiprocessorCount, dev);
        if (hipFuncSetAttribute((const void*)mk_fwd, hipFuncAttributeMaxDynamicSharedMemorySize, LDS_BYTES) != hipSuccess) { fprintf(stderr, "kernel_launch: hipFuncSetAttribute failed\n"); grid = -1; return; }
        hipFuncSetAttribute((const void*)naive_ret, hipFuncAttributeMaxDynamicSharedMemorySize, 65536);
        hipOccupancyMaxActiveBlocksPerMultiprocessor(&per_cu, (const void*)mk_fwd, 512, LDS_BYTES);
        (void)hipGetLastError();
        if (per_cu < 1) fprintf(stderr, "kernel_launch: occupancy query says %d blocks per CU\n", per_cu);
        grid = cus;
        if (grid != 256) fprintf(stderr, "kernel_launch: %d CUs (phase balance assumes 256)\n", grid);
        for (int c = 0; c < grid; ++c) { pg8::StaticOrder S; Unit u0, u;
            S.init(MTOK, 10240, grid, c); S.next(0, u0); for (int i = 1; S.next(i, u); ++i) if (u.pm != u0.pm) { fprintf(stderr, "kernel_launch: in-proj unit order breaks the one-panel-per-workgroup assumption\n"); grid = -1; return; }
            S.init(DR, MTOK, grid, c); S.next(0, u0); for (int i = 1; S.next(i, u); ++i) if (u.pn != u0.pn) { fprintf(stderr, "kernel_launch: V^T unit order breaks the assumption\n"); grid = -1; return; }
            S.init(MTOK, DM, grid, c); S.next(0, u0); for (int i = 1; S.next(i, u); ++i) if (u.pm != u0.pm) { fprintf(stderr, "kernel_launch: out-proj unit order breaks the assumption\n"); grid = -1; return; } }
    }
    if (grid < 0) return;
    Args a{};
    for (int i = 0; i < 17; ++i) a.in[i] = (const float*)d_in[i];
    a.out = (float*)d_out; a.ws = (unsigned char*)d_ws;
    auto launch = [&](int lo, int hi) { a.ph_lo = lo; a.ph_hi = hi; void* kargs[] = {&a};
        hipError_t e = hipLaunchCooperativeKernel((const void*)mk_fwd, dim3(grid), dim3(512), kargs, LDS_BYTES, stream);
        if (e != hipSuccess) fprintf(stderr, "kernel_launch: cooperative launch [%d,%d) failed: %s\n", lo, hi, hipGetErrorString(e)); };
#if FAST_SSM && FAST_RET && ONE_LAUNCH
    launch(0, NPH);
#else
    launch(0, 1);
    for (int l = 0; l < DEPTH; ++l) {
        launch(1 + 4 * l, 2 + 4 * l);
        launch(2 + 4 * l, 3 + 4 * l);
#if !FAST_SSM
        hipLaunchKernelGGL(naive_ssm, dim3(BATCH * NG), dim3(64), 0, stream, a, l);
#endif
#if !FAST_RET
        hipLaunchKernelGGL(naive_ret, dim3(BATCH * RH * 64), dim3(256), 32 * 256 * 2 + 64 * NR_KLD * 2 + 32 * 64 * 4 + 32 * 4 * 4, stream, a, l);
#endif
        launch(3 + 4 * l, 4 + 4 * l);
        launch(4 + 4 * l, 5 + 4 * l);
    }
    launch(NPH - 1, NPH);
#endif
}
```

```cpp
#include <hip/hip_runtime.h>
#include <hip/hip_cooperative_groups.h>
#include <cstdio>
#include <cstdint>
namespace cg = cooperative_groups;

#ifndef FAST_SSM
#define FAST_SSM 1
#endif
#ifndef FAST_RET
#define FAST_RET 1
#endif

#ifndef ONE_LAUNCH
#define ONE_LAUNCH 1
#endif

#define LAS __attribute__((address_space(3)))
typedef unsigned short bf16_t;
typedef short bf16x8 __attribute__((ext_vector_type(8)));
typedef float f32x4 __attribute__((ext_vector_type(4)));
typedef float f32x2 __attribute__((ext_vector_type(2)));
typedef unsigned u32x4 __attribute__((ext_vector_type(4)));
typedef unsigned u32x2 __attribute__((ext_vector_type(2)));

constexpr int BATCH = 4, SEQ = 2048, DM = 4096, DEPTH = 2, DS = 2048, DR = 2048, NG = 128, SG = 16, NST = 64, RH = 8, RD = 256;
constexpr int NPROJ = 12288, MTOK = BATCH * SEQ;
constexpr float EPS = 1e-6f;
constexpr int TCH = 16;
constexpr int A2LD = 384;

constexpr size_t MiB = 1u << 20;
constexpr size_t WS_CTL = 0;
constexpr size_t WS_WTIN = 16 * MiB;
constexpr size_t WS_WTGLU = 208 * MiB;
constexpr size_t WS_WTOUT = 224 * MiB;
constexpr size_t WS_BT2 = 288 * MiB;
constexpr size_t WS_PM = 336 * MiB;
constexpr size_t WS_A16 = 368 * MiB;
constexpr size_t WS_ROPE = 369 * MiB;
constexpr size_t WS_SSQX = 371 * MiB;
constexpr size_t WS_SSQ2 = 373 * MiB;
constexpr size_t WS_XB = 384 * MiB;
constexpr size_t WS_X1 = 448 * MiB;
constexpr size_t WS_A2U = 576 * MiB;
constexpr size_t WS_GS = 624 * MiB, WS_Q = 656 * MiB, WS_K = 688 * MiB, WS_VT = 720 * MiB, WS_GR = 752 * MiB, WS_YG = 784 * MiB;
constexpr size_t WS_YCAT = 816 * MiB;
constexpr size_t WS_END = 880 * MiB;

constexpr int RING_BYTES = 131072;
constexpr int STASH_OFF = 155648;
constexpr int LDS_BYTES = 163840 - 4096;

__device__ __forceinline__ unsigned f2bf(float f) { unsigned u = __builtin_bit_cast(unsigned, f); return (u + 0x7fffu + ((u >> 16) & 1u)) >> 16; }
__device__ __forceinline__ unsigned pk2(float lo, float hi) { return f2bf(lo) | (f2bf(hi) << 16); }
__device__ __forceinline__ float bf2f(unsigned v) { return __builtin_bit_cast(float, v << 16); }
__device__ __forceinline__ unsigned cvt_pk_bf16(float lo, float hi) { unsigned r; asm volatile("v_cvt_pk_bf16_f32 %0, %1, %2" : "=v"(r) : "v"(lo), "v"(hi)); return r; }
__device__ __forceinline__ float silu_f(float x) { return x * __builtin_amdgcn_rcpf(1.f + __expf(-x)); }
__device__ __forceinline__ float sigmoid_f(float x) { return __builtin_amdgcn_rcpf(1.f + __expf(-x)); }
__device__ __forceinline__ float gelu_tanh_f(float x) {
    const float z = 0.7978845608028654f * (x + 0.044715f * x * x * x);
    const float th = 1.f - 2.f * __builtin_amdgcn_rcpf(1.f + __expf(2.f * z));
    return 0.5f * x * (1.f + th);
}
template <int X> __device__ __forceinline__ float xor_add(float v) {
    if constexpr (X == 32) { const unsigned u = __builtin_bit_cast(unsigned, v); auto r = __builtin_amdgcn_permlane32_swap(u, u, false, false);
        return __builtin_bit_cast(float, (unsigned)r[0]) + __builtin_bit_cast(float, (unsigned)r[1]); }
    else return v + __builtin_bit_cast(float, __builtin_amdgcn_ds_swizzle(__builtin_bit_cast(int, v), (X << 10) | 0x1f));
}
__device__ __forceinline__ float wave_sum(float v) {
    v = xor_add<1>(v); v = xor_add<2>(v); v = xor_add<4>(v); v = xor_add<8>(v); v = xor_add<16>(v); v = xor_add<32>(v);
    return v;
}
__device__ __forceinline__ void cis_d(double ph, float& c, float& s) {
    const double rv = ph * 0.15915494309189535;
    const float r = (float)(rv - __builtin_rint(rv));
    c = __builtin_amdgcn_cosf(r); s = __builtin_amdgcn_sinf(r);
}
#define LDS_WAIT() asm volatile("s_waitcnt lgkmcnt(0)" ::: "memory")
#define VM_WAIT() asm volatile("s_waitcnt vmcnt(0)" ::: "memory")

namespace pg8 {
constexpr int BM = 256, BK = 64, HALF = 128, HTB = HALF * BK * 2, STAGE_BYTES = 8 * HTB, NXCD = 8, WGM = 8;
__host__ __device__ __forceinline__ int lds_byte(int r, int c) { const int st = (r >> 4) * 2 + (c >> 5), rr = r & 15, cc = c & 31, ob = rr * 64 + cc * 2; return st * 1024 + (ob ^ (((ob >> 9) & 1) << 5)); }
__host__ __device__ __forceinline__ void stage_rc(int b, int& R, int& C) { const int st = b / 1024, sb = b % 1024, swz = sb ^ (((sb >> 9) & 1) << 5); R = (st >> 1) * 16 + swz / 64; C = (st & 1) * 32 + (swz % 64) / 2; }
__host__ __device__ __forceinline__ int perm32(int rho) { const int n = rho >> 4, i = rho & 15; return 8 * (i >> 2) + 4 * n + (i & 3); }

struct Unit { int pm, pn; };
struct Gemm { const bf16_t* A; const bf16_t* Bt; int K, lda, ldb, kmid; };

struct StaticOrder {
    int nM, nN, nwg, G, c;
    __host__ __device__ void init(int M, int N, int G_, int c_) { nM = M / BM; nN = N / BM; nwg = nM * nN; G = G_; c = c_; }
    __host__ __device__ bool next(int i, Unit& u) const {
        const long L = (long)i * G + c; if (L >= nwg) return false;
        int wgid = (int)L; { const int q = nwg / NXCD, r = nwg % NXCD, xcd = wgid % NXCD, off = wgid / NXCD; wgid = (xcd < r ? xcd * (q + 1) : r * (q + 1) + (xcd - r) * q) + off; }
        const int nig = WGM * nN, gid = wgid / nig, fm = gid * WGM, gsz = (nM - fm) < WGM ? (nM - fm) : WGM;
        u.pm = fm + ((wgid % nig) % gsz); u.pn = (wgid % nig) / gsz; return true;
    }
};
struct OneUnit {
    int pm, pn;
    __device__ __forceinline__ bool next(int i, Unit& u) const { if (i) return false; u.pm = pm; u.pn = pn; return true; }
};

template <class Epi, class Sched, bool ALIGN_EPI, bool SP2>
__device__ __forceinline__ void gemm_phase(LAS unsigned char* lds, const Gemm g, const Sched& S, const Epi& E, int tid_in) {
    int tid_ = tid_in; asm volatile("" : "+v"(tid_));
    const int tid = tid_, wid = __builtin_amdgcn_readfirstlane(tid >> 6), lane = tid & 63, wr = wid >> 2, wc = wid & 3, fr = lane & 15, fq = lane >> 4;
    const int K = g.K, nt = K / BK;
    unsigned voffA[2], voffB[2];
#pragma unroll
    for (int i = 0; i < 2; ++i) { int R, C; stage_rc(tid * 16 + i * 8192, R, C); const int Rb = Epi::PERM ? ((R & ~31) + perm32(R & 31)) : R;
        voffA[i] = (unsigned)(R * g.lda + C) * 2u; voffB[i] = (unsigned)(Rb * g.ldb + C) * 2u; }
    const size_t kstep = (size_t)(BK * 2);
    const size_t hstepA = (size_t)HALF * g.lda * 2, hstepB = (size_t)HALF * g.ldb * 2;
    const size_t tstepA = 2 * hstepA, tstepB = 2 * hstepB;
    const unsigned ldsw = (unsigned)wid * 1024u;
    const int aoff = lds_byte(wr * 64 + fr, fq * 8), boff = lds_byte(wc * 32 + fr, fq * 8);
#define PG8_SA(b, h) (((b) * 2 + (h)) * HTB)
#define PG8_SB(b, h) ((4 + (b) * 2 + (h)) * HTB)
#define PG8_STAGE(bufoff, gbase, voff) do { _Pragma("unroll") for (int _i = 0; _i < 2; ++_i) \
        __builtin_amdgcn_global_load_lds((const unsigned*)((const char*)(gbase) + (voff)[_i]), (LAS unsigned*)(lds + (bufoff) + ldsw + _i * 8192), 16, 0, 0); } while (0)
#define PG8_LDA(dst, b, h) do { _Pragma("unroll") for (int m = 0; m < 4; ++m) _Pragma("unroll") for (int k = 0; k < 2; ++k) dst[m][k] = *(const LAS bf16x8*)(lds + PG8_SA(b, h) + aoff + m * 2048 + k * 1024); } while (0)
#define PG8_LDB(dst, b, h) do { _Pragma("unroll") for (int n = 0; n < 2; ++n) _Pragma("unroll") for (int k = 0; k < 2; ++k) dst[n][k] = *(const LAS bf16x8*)(lds + PG8_SB(b, h) + boff + n * 2048 + k * 1024); } while (0)
#define PG8_MMA(ai, bj, At, Bt) do { __builtin_amdgcn_s_setprio(1); _Pragma("unroll") for (int m = 0; m < 4; ++m) _Pragma("unroll") for (int n = 0; n < 2; ++n) _Pragma("unroll") for (int k = 0; k < 2; ++k) \
        acc[ai][bj][m][n] = __builtin_amdgcn_mfma_f32_16x16x32_bf16(Bt[n][k], At[m][k], acc[ai][bj][m][n], 0, 0, 0); __builtin_amdgcn_s_setprio(0); } while (0)
#define PG8_WAIT_V(n) asm volatile("s_waitcnt vmcnt(" #n ")" ::: "memory")
#define PG8_WAIT_L(n) asm volatile("s_waitcnt lgkmcnt(" #n ")" ::: "memory")
#define PG8_BAR __builtin_amdgcn_s_barrier()
#define PG8_SCHED __builtin_amdgcn_sched_barrier(0)
    Unit cur, nxt; int ui = 0;
    if (!S.next(0, cur)) return;
    f32x4 acc[2][2][4][2];
#pragma unroll
    for (int a = 0; a < 2; ++a)
#pragma unroll
        for (int b = 0; b < 2; ++b)
#pragma unroll
            for (int m = 0; m < 4; ++m)
#pragma unroll
                for (int n = 0; n < 2; ++n) acc[a][b][m][n] = (f32x4){0.f, 0.f, 0.f, 0.f};
    bf16x8 At[4][2], B0[2][2], B1[2][2];
    const char* cA = (const char*)g.A + (size_t)cur.pm * tstepA; const char* cB = (const char*)g.Bt + (size_t)cur.pn * tstepB;
    if constexpr (SP2) {
        PG8_STAGE(PG8_SB(0, 0), cB, voffB); PG8_STAGE(PG8_SB(0, 1), cB + hstepB, voffB); PG8_STAGE(PG8_SA(0, 0), cA, voffA); PG8_STAGE(PG8_SA(0, 1), cA + hstepA, voffA);
        if (wr == 1) PG8_BAR;
        PG8_WAIT_V(2); PG8_BAR;
        PG8_STAGE(PG8_SB(1, 0), cB + kstep, voffB); PG8_STAGE(PG8_SA(1, 0), cA + kstep, voffA); PG8_STAGE(PG8_SB(1, 1), cB + hstepB + kstep, voffB);
        PG8_WAIT_V(6); PG8_BAR;
    } else {
        PG8_STAGE(PG8_SB(0, 0), cB, voffB); PG8_STAGE(PG8_SA(0, 0), cA, voffA); PG8_STAGE(PG8_SB(0, 1), cB + hstepB, voffB); PG8_STAGE(PG8_SA(0, 1), cA + hstepA, voffA);
        if (wr == 1) PG8_BAR;
        PG8_WAIT_V(4); PG8_BAR;
        PG8_STAGE(PG8_SB(1, 0), cB + kstep, voffB); PG8_STAGE(PG8_SA(1, 0), cA + kstep, voffA); PG8_STAGE(PG8_SB(1, 1), cB + hstepB + kstep, voffB);
        PG8_WAIT_V(6); PG8_BAR;
    }
    for (;;) {
        const bool has_next = S.next(ui + 1, nxt);
        const char* nA = has_next ? (const char*)g.A + (size_t)nxt.pm * tstepA : cA; const char* nB = has_next ? (const char*)g.Bt + (size_t)nxt.pn * tstepB : cB;
        for (int t = 0; t < nt; t += 2) {
            const bool last = (t == nt - 2);
            const char* a1 = cA + (size_t)(t + 1) * kstep;
            const char* a2 = last ? nA : cA + (size_t)(t + 2) * kstep; const char* b2 = last ? nB : cB + (size_t)(t + 2) * kstep;
            const char* a3 = a2 + kstep; const char* b3 = b2 + kstep;
            if constexpr (Epi::MIDK) { if (t == g.kmid) E.midk(acc, wr, fr); }
            if constexpr (SP2) {
            PG8_LDB(B0, 0, 0); PG8_LDB(B1, 0, 1); PG8_SCHED; PG8_LDA(At, 0, 0); PG8_STAGE(PG8_SA(1, 1), a1 + hstepA, voffA);
            PG8_WAIT_V(8); PG8_WAIT_L(0); PG8_BAR; PG8_MMA(0, 0, At, B0); PG8_MMA(0, 1, At, B1); PG8_BAR; PG8_SCHED;
            PG8_LDA(At, 0, 1); PG8_STAGE(PG8_SB(0, 0), b2, voffB); PG8_STAGE(PG8_SB(0, 1), b2 + hstepB, voffB); PG8_STAGE(PG8_SA(0, 0), a2, voffA);
            PG8_WAIT_V(8); PG8_WAIT_L(0); PG8_BAR; PG8_MMA(1, 0, At, B0); PG8_MMA(1, 1, At, B1); PG8_BAR; PG8_SCHED;
            PG8_LDB(B0, 1, 0); PG8_LDB(B1, 1, 1); PG8_SCHED; PG8_LDA(At, 1, 0); PG8_STAGE(PG8_SA(0, 1), a2 + hstepA, voffA);
            PG8_WAIT_V(8); PG8_WAIT_L(0); PG8_BAR; PG8_MMA(0, 0, At, B0); PG8_MMA(0, 1, At, B1); PG8_BAR; PG8_SCHED;
            PG8_LDA(At, 1, 1); PG8_STAGE(PG8_SB(1, 0), b3, voffB); PG8_STAGE(PG8_SB(1, 1), b3 + hstepB, voffB); PG8_STAGE(PG8_SA(1, 0), a3, voffA);
            PG8_WAIT_V(8); PG8_WAIT_L(0); PG8_BAR; PG8_MMA(1, 0, At, B0); PG8_MMA(1, 1, At, B1); PG8_BAR; PG8_SCHED;
            } else {
            PG8_LDB(B0, 0, 0); PG8_SCHED; PG8_LDA(At, 0, 0); PG8_STAGE(PG8_SA(1, 1), a1 + hstepA, voffA);
            PG8_WAIT_L(8); PG8_BAR; PG8_WAIT_L(0); PG8_MMA(0, 0, At, B0); PG8_BAR; PG8_SCHED;
            PG8_LDB(B1, 0, 1); PG8_STAGE(PG8_SB(0, 0), b2, voffB);
            PG8_BAR; PG8_WAIT_L(0); PG8_MMA(0, 1, At, B1); PG8_BAR;
            PG8_LDA(At, 0, 1); PG8_STAGE(PG8_SA(0, 0), a2, voffA);
            PG8_BAR; PG8_WAIT_L(0); PG8_MMA(1, 0, At, B0); PG8_BAR; PG8_SCHED;
            PG8_STAGE(PG8_SB(0, 1), b2 + hstepB, voffB);
            PG8_WAIT_V(6); PG8_BAR; PG8_MMA(1, 1, At, B1); PG8_BAR;
            PG8_LDB(B0, 1, 0); PG8_SCHED; PG8_LDA(At, 1, 0); PG8_STAGE(PG8_SA(0, 1), a2 + hstepA, voffA);
            PG8_WAIT_L(8); PG8_BAR; PG8_WAIT_L(0); PG8_MMA(0, 0, At, B0); PG8_BAR; PG8_SCHED;
            PG8_LDB(B1, 1, 1); PG8_STAGE(PG8_SB(1, 0), b3, voffB);
            PG8_BAR; PG8_WAIT_L(0); PG8_MMA(0, 1, At, B1); PG8_BAR;
            PG8_LDA(At, 1, 1); PG8_STAGE(PG8_SA(1, 0), a3, voffA);
            PG8_BAR; PG8_WAIT_L(0); PG8_MMA(1, 0, At, B0); PG8_BAR; PG8_SCHED;
            PG8_STAGE(PG8_SB(1, 1), b3 + hstepB, voffB);
            PG8_WAIT_V(6); PG8_BAR; PG8_MMA(1, 1, At, B1); PG8_BAR;
            }
        }
        if constexpr (ALIGN_EPI) { if (wr == 0) PG8_BAR; }
        if constexpr (!Epi::AFTER_DRAIN) { E(acc, cur, wr, wc, fr, fq); }
        if (!has_next) break;
#pragma unroll
        for (int a = 0; a < 2; ++a)
#pragma unroll
            for (int b = 0; b < 2; ++b)
#pragma unroll
                for (int m = 0; m < 4; ++m)
#pragma unroll
                    for (int n = 0; n < 2; ++n) acc[a][b][m][n] = (f32x4){0.f, 0.f, 0.f, 0.f};
        cur = nxt; cA = nA; cB = nB; ++ui;
        if constexpr (ALIGN_EPI) { if (wr == 1) PG8_BAR; }
    }
    PG8_WAIT_V(0);
    if constexpr (!ALIGN_EPI) { if (wr == 0) PG8_BAR; }
    PG8_BAR;
    if constexpr (Epi::AFTER_DRAIN) { E.fused(acc, cur, wr, wc, fr, fq, lds); }
#undef PG8_SA
#undef PG8_SB
#undef PG8_STAGE
#undef PG8_LDA
#undef PG8_LDB
#undef PG8_MMA
#undef PG8_WAIT_V
#undef PG8_WAIT_L
#undef PG8_BAR
#undef PG8_SCHED
}
}
using pg8::Unit;
typedef f32x4 Acc[2][2][4][2];

struct EpiInProj {
    static constexpr bool PERM = true, AFTER_DRAIN = false, MIDK = false;
    const LAS float* rs; bf16_t *a2u, *gs, *q, *k, *gr; const float* rope;
    __device__ __forceinline__ void operator()(const Acc& acc, const Unit& u, int wr, int wc, int fr, int fq) const {
        asm volatile("" : "+v"(fr), "+v"(fq));
        const int type = u.pn >> 3, colt = (u.pn & 7) << 8, c8 = wc * 32 + 8 * fq;
#pragma unroll
        for (int ai = 0; ai < 2; ++ai)
#pragma unroll
            for (int m = 0; m < 4; ++m) {
                const int lr = wr * 64 + fr + ai * 128 + m * 16, r = u.pm * 256 + lr; const float s = rs[lr];
                f32x4 v[2][2];
#pragma unroll
                for (int bj = 0; bj < 2; ++bj)
#pragma unroll
                    for (int n = 0; n < 2; ++n) v[bj][n] = acc[ai][bj][m][n] * s;
                if (type == 0) {
#pragma unroll
                    for (int bj = 0; bj < 2; ++bj) { const int col = colt + bj * 128 + c8;
                        u32x4 w; w.x = cvt_pk_bf16(v[bj][0][0], v[bj][0][1]); w.y = cvt_pk_bf16(v[bj][0][2], v[bj][0][3]); w.z = cvt_pk_bf16(v[bj][1][0], v[bj][1][1]); w.w = cvt_pk_bf16(v[bj][1][2], v[bj][1][3]);
                        *(u32x4*)(a2u + ((size_t)((col >> 4) * 512 + (r >> 4)) * A2LD + (r & 15) * 16 + (col & 15))) = w; }
                } else if (type == 1 || type == 4) {
                    bf16_t* dst = (type == 1 ? gs : gr) + (size_t)r * 2048 + colt + c8;
#pragma unroll
                    for (int bj = 0; bj < 2; ++bj) {
                        u32x4 w; w.x = cvt_pk_bf16(silu_f(v[bj][0][0]), silu_f(v[bj][0][1])); w.y = cvt_pk_bf16(silu_f(v[bj][0][2]), silu_f(v[bj][0][3]));
                        w.z = cvt_pk_bf16(silu_f(v[bj][1][0]), silu_f(v[bj][1][1])); w.w = cvt_pk_bf16(silu_f(v[bj][1][2]), silu_f(v[bj][1][3]));
                        *(u32x4*)(dst + bj * 128) = w; }
                } else {
                    const float eh = __builtin_amdgcn_exp2f((float)(-5 - (u.pn & 7)));
                    const float lg2h = -(eh * (1.f + eh * (0.5f + eh * (0.33333334f + eh * (0.25f + eh * (0.2f + eh * 0.16666667f)))))) * 1.4426950408889634f;
                    const float sc = (type == 3) ? 0.0625f * __builtin_amdgcn_exp2f(-(float)(r & 127) * lg2h) : __builtin_amdgcn_exp2f((float)(r & 127) * lg2h);
                    const f32x4* cs = (const f32x4*)(rope + ((size_t)(r & 2047) * 128 + c8) * 2);
                    float o1[8], o2[8];
#pragma unroll
                    for (int jj = 0; jj < 4; ++jj) { const f32x4 t = cs[jj];
                        const float a0 = v[0][jj >> 1][(jj & 1) * 2], b0 = v[1][jj >> 1][(jj & 1) * 2], a1 = v[0][jj >> 1][(jj & 1) * 2 + 1], b1 = v[1][jj >> 1][(jj & 1) * 2 + 1];
                        o1[2 * jj] = (a0 * t[0] - b0 * t[1]) * sc; o2[2 * jj] = (b0 * t[0] + a0 * t[1]) * sc;
                        o1[2 * jj + 1] = (a1 * t[2] - b1 * t[3]) * sc; o2[2 * jj + 1] = (b1 * t[2] + a1 * t[3]) * sc; }
                    bf16_t* dst = (type == 2 ? q : k) + (size_t)r * 2048 + colt + c8;
                    u32x4 w; w.x = cvt_pk_bf16(o1[0], o1[1]); w.y = cvt_pk_bf16(o1[2], o1[3]); w.z = cvt_pk_bf16(o1[4], o1[5]); w.w = cvt_pk_bf16(o1[6], o1[7]);
                    *(u32x4*)dst = w;
                    w.x = cvt_pk_bf16(o2[0], o2[1]); w.y = cvt_pk_bf16(o2[2], o2[3]); w.z = cvt_pk_bf16(o2[4], o2[5]); w.w = cvt_pk_bf16(o2[6], o2[7]);
                    *(u32x4*)(dst + 128) = w;
                }
                asm volatile("" ::: "memory");
            }
    }
};
struct EpiVT {
    static constexpr bool PERM = true, AFTER_DRAIN = false, MIDK = false;
    const LAS float* rs; bf16_t* vt;
    __device__ __forceinline__ void operator()(const Acc& acc, const Unit& u, int wr, int wc, int fr, int fq) const {
        asm volatile("" : "+v"(fr), "+v"(fq));
        f32x4 sv[2][2];
#pragma unroll
        for (int bj = 0; bj < 2; ++bj)
#pragma unroll
            for (int n = 0; n < 2; ++n) sv[bj][n] = *(const LAS f32x4*)(rs + bj * 128 + wc * 32 + 8 * fq + 4 * n);
#pragma unroll
        for (int ai = 0; ai < 2; ++ai)
#pragma unroll
            for (int m = 0; m < 4; ++m) { bf16_t* dst = vt + (size_t)(u.pm * 256 + wr * 64 + fr + ai * 128 + m * 16) * MTOK + u.pn * 256 + wc * 32 + 8 * fq;
#pragma unroll
                for (int bj = 0; bj < 2; ++bj) { const f32x4 a = acc[ai][bj][m][0] * sv[bj][0], b = acc[ai][bj][m][1] * sv[bj][1];
                    u32x4 w; w.x = cvt_pk_bf16(a[0], a[1]); w.y = cvt_pk_bf16(a[2], a[3]); w.z = cvt_pk_bf16(b[0], b[1]); w.w = cvt_pk_bf16(b[2], b[3]);
                    *(u32x4*)(dst + bj * 128) = w; } }
    }
};
constexpr int SLD = 132;
struct EpiSloc {
    static constexpr bool PERM = false, AFTER_DRAIN = true, MIDK = false;
    __device__ __forceinline__ void fused(const Acc& acc, const Unit&, int wr, int wc, int fr, int fq, LAS unsigned char* lds) const {
        asm volatile("" : "+v"(fr), "+v"(fq));
        LAS float* S = (LAS float*)lds;
#pragma unroll
        for (int ai = 0; ai < 2; ++ai)
#pragma unroll
            for (int m = 0; m < 4; ++m)
#pragma unroll
                for (int n = 0; n < 2; ++n) *(LAS f32x4*)(S + (ai * 128 + wr * 64 + m * 16 + fr) * SLD + wc * 32 + n * 16 + 4 * fq) = acc[ai][0][m][n];
    }
};
struct EpiSsmOut {
    static constexpr bool PERM = true, AFTER_DRAIN = false, MIDK = false;
    const bf16_t* a2g; const float* dsk; bf16_t* yg; int g;
    __device__ __forceinline__ void operator()(const Acc& acc, const Unit& u, int wr, int wc, int fr, int fq) const {
        asm volatile("" : "+v"(fr), "+v"(fq));
        const int h0 = 8 * (fq & 1);
        const f32x4 d0 = *(const f32x4*)(dsk + h0), d1 = *(const f32x4*)(dsk + h0 + 4);
#pragma unroll
        for (int ai = 0; ai < 2; ++ai)
#pragma unroll
            for (int m = 0; m < 4; ++m) { const int row = u.pm * 256 + ai * 128 + wr * 64 + m * 16 + fr;
#pragma unroll
                for (int bj = 0; bj < 2; ++bj) { const int col = bj * 128 + wc * 32 + 8 * fq, tl = col >> 4;
                    const u32x4 uu = *(const u32x4*)(a2g + (size_t)row * A2LD + col);
                    const f32x4 a = acc[ai][bj][m][0], b = acc[ai][bj][m][1];
                    float y[8];
                    y[0] = a[0] + d0[0] * bf2f(uu.x & 0xffffu); y[1] = a[1] + d0[1] * bf2f(uu.x >> 16); y[2] = a[2] + d0[2] * bf2f(uu.y & 0xffffu); y[3] = a[3] + d0[3] * bf2f(uu.y >> 16);
                    y[4] = b[0] + d1[0] * bf2f(uu.z & 0xffffu); y[5] = b[1] + d1[1] * bf2f(uu.z >> 16); y[6] = b[2] + d1[2] * bf2f(uu.w & 0xffffu); y[7] = b[3] + d1[3] * bf2f(uu.w >> 16);
#pragma unroll
                    for (int j = 0; j < 8; ++j) y[j] = gelu_tanh_f(y[j]);
                    u32x4 w; w.x = cvt_pk_bf16(y[0], y[1]); w.y = cvt_pk_bf16(y[2], y[3]); w.z = cvt_pk_bf16(y[4], y[5]); w.w = cvt_pk_bf16(y[6], y[7]);
                    *(u32x4*)(yg + (size_t)(row * 16 + tl) * DS + g * 16 + h0) = w; }
                asm volatile("" ::: "memory"); }
    }
};
struct EpiGlu {
    static constexpr bool PERM = true, AFTER_DRAIN = false, MIDK = false;
    const bf16_t* yg; const bf16_t* gs; const float* bias; bf16_t* ycat; float* ssq2;
    __device__ __forceinline__ void operator()(const Acc& acc, const Unit& u, int wr, int wc, int fr, int fq) const {
        asm volatile("" : "+v"(fr), "+v"(fq));
        const int col0 = u.pn * 256 + wc * 32 + 8 * fq;
        f32x4 bv[2][2];
#pragma unroll
        for (int bj = 0; bj < 2; ++bj)
#pragma unroll
            for (int n = 0; n < 2; ++n) bv[bj][n] = *(const f32x4*)(bias + col0 + bj * 128 + 4 * n);
#pragma unroll
        for (int ai = 0; ai < 2; ++ai)
#pragma unroll
            for (int m = 0; m < 4; ++m) { const int r = u.pm * 256 + ai * 128 + wr * 64 + m * 16 + fr; float ss = 0.f;
#pragma unroll
                for (int bj = 0; bj < 2; ++bj) { const size_t off = (size_t)r * DS + col0 + bj * 128;
                    const u32x4 yy = *(const u32x4*)(yg + off), gg = *(const u32x4*)(gs + off);
                    const f32x4 a = acc[ai][bj][m][0] + bv[bj][0], b = acc[ai][bj][m][1] + bv[bj][1];
                    float z[8];
                    z[0] = bf2f(yy.x & 0xffffu) * sigmoid_f(a[0]); z[1] = bf2f(yy.x >> 16) * sigmoid_f(a[1]); z[2] = bf2f(yy.y & 0xffffu) * sigmoid_f(a[2]); z[3] = bf2f(yy.y >> 16) * sigmoid_f(a[3]);
                    z[4] = bf2f(yy.z & 0xffffu) * sigmoid_f(b[0]); z[5] = bf2f(yy.z >> 16) * sigmoid_f(b[1]); z[6] = bf2f(yy.w & 0xffffu) * sigmoid_f(b[2]); z[7] = bf2f(yy.w >> 16) * sigmoid_f(b[3]);
#pragma unroll
                    for (int j = 0; j < 8; ++j) ss += z[j] * z[j];
                    z[0] *= bf2f(gg.x & 0xffffu); z[1] *= bf2f(gg.x >> 16); z[2] *= bf2f(gg.y & 0xffffu); z[3] *= bf2f(gg.y >> 16);
                    z[4] *= bf2f(gg.z & 0xffffu); z[5] *= bf2f(gg.z >> 16); z[6] *= bf2f(gg.w & 0xffffu); z[7] *= bf2f(gg.w >> 16);
                    u32x4 w; w.x = cvt_pk_bf16(z[0], z[1]); w.y = cvt_pk_bf16(z[2], z[3]); w.z = cvt_pk_bf16(z[4], z[5]); w.w = cvt_pk_bf16(z[6], z[7]);
                    *(u32x4*)(ycat + (size_t)r * DM + col0 + bj * 128) = w; }
                ss = xor_add<16>(ss); ss = xor_add<32>(ss);
                if (fq == 0) ssq2[(size_t)r * 32 + u.pn * 4 + wc] = ss;
                asm volatile("" ::: "memory"); }
    }
};
struct EpiOut {
    static constexpr bool PERM = false, AFTER_DRAIN = false, MIDK = true;
    const LAS float* rs2; const float* res; float* out; bf16_t* xb; float* ssq;
    __device__ __forceinline__ void midk(Acc& acc, int wr, int fr) const {
        asm volatile("" : "+v"(fr));
#pragma unroll
        for (int ai = 0; ai < 2; ++ai)
#pragma unroll
            for (int m = 0; m < 4; ++m) { const float s = rs2[ai * 128 + wr * 64 + m * 16 + fr];
#pragma unroll
                for (int bj = 0; bj < 2; ++bj)
#pragma unroll
                    for (int n = 0; n < 2; ++n) acc[ai][bj][m][n] *= s; }
    }
    __device__ __forceinline__ void operator()(const Acc& acc, const Unit& u, int wr, int wc, int fr, int fq) const {
        asm volatile("" : "+v"(fr), "+v"(fq));
        const int col0 = u.pn * 256 + wc * 32 + 4 * fq;
#pragma unroll
        for (int ai = 0; ai < 2; ++ai)
#pragma unroll
            for (int m = 0; m < 4; ++m) { const int r = u.pm * 256 + ai * 128 + wr * 64 + m * 16 + fr; float ss = 0.f;
#pragma unroll
                for (int bj = 0; bj < 2; ++bj)
#pragma unroll
                    for (int n = 0; n < 2; ++n) { const size_t off = (size_t)r * DM + col0 + bj * 128 + n * 16;
                        const f32x4 x = *(const f32x4*)(res + off) + acc[ai][bj][m][n];
                        *(f32x4*)(out + off) = x; ss += (x[0] * x[0] + x[1] * x[1]) + (x[2] * x[2] + x[3] * x[3]);
                        if (xb) { u32x2 w; w.x = cvt_pk_bf16(x[0], x[1]); w.y = cvt_pk_bf16(x[2], x[3]); *(u32x2*)(xb + off) = w; } }
                ss = xor_add<16>(ss); ss = xor_add<32>(ss);
                if (fq == 0) ssq[(size_t)r * 64 + u.pn * 4 + wc] = ss;
                asm volatile("" ::: "memory"); }
    }
};

struct Args { const float* in[17]; float* out; unsigned char* ws; int ph_lo, ph_hi; };
enum { I_X = 0, I_NORMW, I_WIN, I_LRE, I_LIM, I_BRE, I_BIM, I_CRE, I_CIM, I_D, I_LOGDT, I_WGLU, I_BGLU, I_SNW, I_RNW, I_WOUT, I_FNW };

typedef const __attribute__((address_space(4))) Args* ArgsP;
struct Frame {
    LAS unsigned char* lds; int tid, lane, wave, vcu, G, bid; unsigned char* ws;
};

__device__ __forceinline__ void transpose_item(const float* W, int K, int N, bf16_t* WT, const float* ks0, const float* ks1, int ksplit, int remap, int item, int lane) {
    const int nblk = N / 64, kb = item / nblk, nb = item % nblk, k0 = 64 * kb, nq = lane & 15, kq = lane >> 4; int n0 = 64 * nb;
    const float* wp = W + (size_t)(k0 + 16 * kq) * N + n0 + 4 * nq;
    f32x4 v[16];
#pragma unroll
    for (int i = 0; i < 16; ++i) v[i] = *(const f32x4*)(wp + (size_t)i * N);
    if (ks0) { const float* ks = ((k0 < ksplit) ? ks0 + k0 : ks1 + (k0 - ksplit)) + 16 * kq;
#pragma unroll
        for (int i = 0; i < 4; ++i) { const f32x4 sc = *(const f32x4*)(ks + 4 * i);
#pragma unroll
            for (int j = 0; j < 4; ++j) v[4 * i + j] = v[4 * i + j] * sc[j]; } }
    if (remap) { if (n0 >= 10240) n0 -= 2048; else if (n0 >= 8192) n0 += 2048; }
#pragma unroll
    for (int c = 0; c < 4; ++c) { bf16_t* dst = WT + (size_t)(n0 + 4 * nq + c) * K + k0 + 16 * kq;
        u32x4 o0, o1;
        o0.x = pk2(v[0][c], v[1][c]); o0.y = pk2(v[2][c], v[3][c]); o0.z = pk2(v[4][c], v[5][c]); o0.w = pk2(v[6][c], v[7][c]);
        o1.x = pk2(v[8][c], v[9][c]); o1.y = pk2(v[10][c], v[11][c]); o1.z = pk2(v[12][c], v[13][c]); o1.w = pk2(v[14][c], v[15][c]);
        *(u32x4*)dst = o0; *(u32x4*)(dst + 8) = o1; }
}

__device__ __forceinline__ void ssm_mats_item(const Frame& F, ArgsP a, int l, int g) {
    const int lg = l * NG + g, tid = F.tid;
    LAS float* apr = (LAS float*)F.lds;
    LAS float* api = apr + 17 * 64;
    LAS float* bbr = api + 17 * 64;
    LAS float* bbi = bbr + 1024;
    LAS float* crs = bbi + 1024;
    LAS float* cis = crs + 1024;
    LAS float* crt = cis + 1024;
    LAS float* cit = crt + 1024;
    LAS float* Kt = cit + 1024;
    LAS float* lrs = Kt + 4096;
    LAS float* lis = lrs + 64;
    { const float b0r = a->in[I_BRE][(size_t)lg * 1024 + tid], b1r = a->in[I_BRE][(size_t)lg * 1024 + 512 + tid], b0i = a->in[I_BIM][(size_t)lg * 1024 + tid], b1i = a->in[I_BIM][(size_t)lg * 1024 + 512 + tid];
      const float c0r = a->in[I_CRE][(size_t)lg * 1024 + tid], c1r = a->in[I_CRE][(size_t)lg * 1024 + 512 + tid], c0i = a->in[I_CIM][(size_t)lg * 1024 + tid], c1i = a->in[I_CIM][(size_t)lg * 1024 + 512 + tid];
      const float lx = (tid < 64) ? a->in[I_LRE][lg * 64 + tid] : ((tid < 128) ? a->in[I_LIM][lg * 64 + tid - 64] : 0.f);
      bbr[tid] = b0r; bbr[512 + tid] = b1r; bbi[tid] = b0i; bbi[512 + tid] = b1i;
      crs[tid] = c0r; crs[512 + tid] = c1r; cis[tid] = c0i; cis[512 + tid] = c1i;
      { const int hp0 = tid >> 6, n0 = tid & 63; crt[n0 * 16 + hp0] = c0r; crt[n0 * 16 + hp0 + 8] = c1r; cit[n0 * 16 + hp0] = c0i; cit[n0 * 16 + hp0 + 8] = c1i; }
      if (tid < 128) lrs[tid] = lx; }
    const float dtf = expf(a->in[I_LOGDT][lg]);
    __syncthreads();
    for (int e = tid; e < 17 * 64; e += 512) { const int tau = e >> 6, n = e & 63; const float lr = lrs[n], li = lis[n];
        float c, s; cis_d((double)li * (double)dtf * tau, c, s); const float mag = expf(lr * dtf * (float)tau); apr[e] = mag * c; api[e] = mag * s; }
    __syncthreads();
#pragma unroll
    for (int k = 0; k < 2; ++k) { const int e = tid + 512 * k, n = e >> 4; const float lr = lrs[n], li = lis[n];
        const float nr = apr[64 + n] - 1.f, ni = api[64 + n], den = lr * lr + li * li, cor = (nr * lr + ni * li) / den, coi = (ni * lr - nr * li) / den;
        const float br = bbr[e], bi = bbi[e];
        bbr[e] = cor * br - coi * bi; bbi[e] = cor * bi + coi * br; }
    if (tid < 64) ((float2*)(F.ws + WS_A16))[lg * 64 + tid] = make_float2(apr[16 * 64 + tid], api[16 * 64 + tid]);
    __syncthreads();
    { const int tau = tid >> 5, hp = (tid >> 1) & 15, h0 = (tid & 1) * 8; float sum[8];
#pragma unroll
      for (int j = 0; j < 8; ++j) sum[j] = 0.f;
#pragma unroll 4
      for (int n = 0; n < 64; ++n) { const float cr = crt[n * 16 + hp], ci = cit[n * 16 + hp], ar = apr[tau * 64 + n], ai = api[tau * 64 + n], pr = cr * ar - ci * ai, pi = cr * ai + ci * ar;
          const f32x4 b0 = *(const LAS f32x4*)(bbr + n * 16 + h0), b1 = *(const LAS f32x4*)(bbr + n * 16 + h0 + 4), d0 = *(const LAS f32x4*)(bbi + n * 16 + h0), d1 = *(const LAS f32x4*)(bbi + n * 16 + h0 + 4);
#pragma unroll
          for (int j = 0; j < 4; ++j) { sum[j] += pr * b0[j] - pi * d0[j]; sum[4 + j] += pr * b1[j] - pi * d1[j]; } }
#pragma unroll
      for (int j = 0; j < 8; ++j) Kt[(tau << 8) + (hp << 4) + h0 + j] = sum[j]; }
    __syncthreads();
    bf16_t* bt2 = (bf16_t*)(F.ws + WS_BT2) + (size_t)lg * 256 * A2LD;
#pragma unroll 2
    for (int e = tid; e < 256 * A2LD / 8; e += 512) { const int row = e / 48, c0 = (e % 48) * 8, t = row >> 4, hp = row & 15; float v[8];
        if (c0 < 256) { const int j = c0 >> 4, h0 = c0 & 15;
#pragma unroll
            for (int i = 0; i < 8; ++i) v[i] = (t >= j) ? Kt[((t - j) << 8) + (hp << 4) + h0 + i] : 0.f;
        } else { const int nn = c0 - 256;
#pragma unroll
            for (int i = 0; i < 8; ++i) { const int n = (nn + i) & 63; const float cr = crs[hp * 64 + n], ci = cis[hp * 64 + n], ar = apr[(t + 1) * 64 + n], ai = api[(t + 1) * 64 + n];
                v[i] = (nn < 64) ? (cr * ar - ci * ai) : -(cr * ai + ci * ar); } }
        u32x4 w; w.x = pk2(v[0], v[1]); w.y = pk2(v[2], v[3]); w.z = pk2(v[4], v[5]); w.w = pk2(v[6], v[7]);
        *(u32x4*)(bt2 + (size_t)row * A2LD + c0) = w; }
    bf16_t* pm = (bf16_t*)(F.ws + WS_PM) + (size_t)lg * 256 * 256;
#pragma unroll 2
    for (int e = tid; e < 256 * 256 / 8; e += 512) { const int row = e >> 5, c0 = (e & 31) * 8; float v[8];
        if (row < 128) { const int n = row & 63, im = row >> 6, j = c0 >> 4, h0 = c0 & 15; const float ar = apr[(15 - j) * 64 + n], ai = api[(15 - j) * 64 + n];
#pragma unroll
            for (int i = 0; i < 8; ++i) { const float br = bbr[n * 16 + h0 + i], bi = bbi[n * 16 + h0 + i]; v[i] = im ? (ar * bi + ai * br) : (ar * br - ai * bi); }
        } else {
#pragma unroll
            for (int i = 0; i < 8; ++i) v[i] = 0.f; }
        u32x4 w; w.x = pk2(v[0], v[1]); w.y = pk2(v[2], v[3]); w.z = pk2(v[4], v[5]); w.w = pk2(v[6], v[7]);
        *(u32x4*)(pm + (size_t)row * 256 + c0) = w; }
    __syncthreads();
}

__device__ __forceinline__ void p0_prologue(const Frame& F, ArgsP a, int parts = 7) {
    if (parts & 1) for (int it = F.vcu; it < DEPTH * NG; it += F.G) ssm_mats_item(F, a, it / NG, it % NG);
    if (parts & 2) { float2* rope = (float2*)(F.ws + WS_ROPE);
      for (int e = F.vcu * 512 + F.tid; e < SEQ * 128; e += F.G * 512) { const int pos = e >> 7, i = e & 127;
          const double inv = (double)expf(-(float)(2 * i) * (9.210340371976184f / 256.0f)); float c, s; cis_d((double)pos * inv, c, s); rope[e] = make_float2(c, s); } }
    const int gw = F.vcu * 8 + F.wave, NGW = F.G * 8;
    if (parts & 2) for (int m = gw; m < MTOK; m += NGW) {
        const f32x4* xr = (const f32x4*)(a->in[I_X] + (size_t)m * DM) + F.lane; float ss = 0.f; f32x4 v[16];
#pragma unroll
        for (int j = 0; j < 16; ++j) { v[j] = xr[64 * j]; ss += (v[j][0] * v[j][0] + v[j][1] * v[j][1]) + (v[j][2] * v[j][2] + v[j][3] * v[j][3]); }
        ss = wave_sum(ss);
        u32x2* o = (u32x2*)((bf16_t*)(F.ws + WS_XB) + (size_t)m * DM) + F.lane;
#pragma unroll
        for (int j = 0; j < 16; ++j) { u32x2 w; w.x = pk2(v[j][0], v[j][1]); w.y = pk2(v[j][2], v[j][3]); o[64 * j] = w; }
        ((float*)(F.ws + WS_SSQX))[(size_t)m * 64 + F.lane] = (F.lane == 0) ? ss : 0.f;
    }
    constexpr int I_IN = (DM / 64) * (NPROJ / 64), I_GLU = (DS / 64) * (DS / 64), I_OUT = (DM / 64) * (DM / 64), I_L = I_IN + I_GLU + I_OUT;
    if (parts & 4) for (int it = gw; it < DEPTH * I_L; it += NGW) {
        const int l = it / I_L; int r = it % I_L;
        if (r < I_IN) { transpose_item(a->in[I_WIN] + (size_t)l * DM * NPROJ, DM, NPROJ, (bf16_t*)(F.ws + WS_WTIN) + (size_t)l * NPROJ * DM, a->in[I_NORMW] + l * DM, a->in[I_NORMW] + l * DM, 1 << 30, 1, r, F.lane); continue; } r -= I_IN;
        if (r < I_GLU) { transpose_item(a->in[I_WGLU] + (size_t)l * DS * DS, DS, DS, (bf16_t*)(F.ws + WS_WTGLU) + (size_t)l * DS * DS, nullptr, nullptr, 1 << 30, 0, r, F.lane); continue; } r -= I_GLU;
        transpose_item(a->in[I_WOUT] + (size_t)l * DM * DM, DM, DM, (bf16_t*)(F.ws + WS_WTOUT) + (size_t)l * DM * DM, a->in[I_SNW] + l * DS, a->in[I_RNW] + l * DR, DS, 0, r, F.lane);
    }
}

__device__ __forceinline__ void stash_rstd(const Frame& F, const float* slots, int nslot, int panel, float inv_dim) {
    __syncthreads();
    if (F.tid < 256) { const f32x4* p = (const f32x4*)(slots + (size_t)(panel * 256 + F.tid) * nslot); float s = 0.f;
        for (int j = 0; j < nslot / 4; ++j) { const f32x4 t = p[j]; s += (t[0] + t[1]) + (t[2] + t[3]); }
        ((LAS float*)(F.lds + STASH_OFF))[F.tid] = __builtin_amdgcn_rsqf(s * inv_dim + EPS); }
    __syncthreads();
}

__device__ __forceinline__ void p1_inproj(const Frame& F, int l) {
    const bf16_t* xb = (const bf16_t*)(F.ws + WS_XB); const bf16_t* wt = (const bf16_t*)(F.ws + WS_WTIN) + (size_t)l * NPROJ * DM;
    const LAS float* rs = (const LAS float*)(F.lds + STASH_OFF);
    { pg8::StaticOrder S; S.init(MTOK, 10240, F.G, F.bid); Unit u0; S.next(0, u0);
      stash_rstd(F, (const float*)(F.ws + WS_SSQX), 64, u0.pm, 1.f / DM);
      pg8::Gemm g{xb, wt, DM, DM, DM, -1};
      EpiInProj E{rs, (bf16_t*)(F.ws + WS_A2U), (bf16_t*)(F.ws + WS_GS), (bf16_t*)(F.ws + WS_Q), (bf16_t*)(F.ws + WS_K), (bf16_t*)(F.ws + WS_GR), (const float*)(F.ws + WS_ROPE)};
      pg8::gemm_phase<EpiInProj, pg8::StaticOrder, true, true>(F.lds, g, S, E, F.tid); }
    { pg8::StaticOrder S; S.init(DR, MTOK, F.G, F.bid); Unit u0; S.next(0, u0);
      stash_rstd(F, (const float*)(F.ws + WS_SSQX), 64, u0.pn, 1.f / DM);
      pg8::Gemm g{wt + (size_t)10240 * DM, xb, DM, DM, DM, -1};
      EpiVT E{rs, (bf16_t*)(F.ws + WS_VT)};
      pg8::gemm_phase<EpiVT, pg8::StaticOrder, true, true>(F.lds, g, S, E, F.tid); }
}

__device__ __forceinline__ void p2_ssm(const Frame& F, ArgsP a, int l) {
    for (int it = F.vcu; it < NG * 2; it += F.G) {
        const int g = it >> 1, bp = it & 1, lg = l * NG + g;
        bf16_t* a2g = (bf16_t*)(F.ws + WS_A2U) + (size_t)g * 512 * A2LD;
        { pg8::Gemm g1{a2g, (const bf16_t*)(F.ws + WS_PM) + (size_t)lg * 256 * 256, 256, A2LD, 256, -1}; pg8::OneUnit S{bp, 0}; EpiSloc E{};
          pg8::gemm_phase<EpiSloc, pg8::OneUnit, false, true>(F.lds, g1, S, E, F.tid); }
        LDS_WAIT(); __syncthreads();
        int t2 = F.tid; asm volatile("" : "+v"(t2));
        if (t2 < 128) {
            const int bb = t2 >> 6, n = t2 & 63; const float2 a16 = ((const float2*)(F.ws + WS_A16))[lg * 64 + n];
            const LAS float* S = (const LAS float*)F.lds + (bb * 128) * SLD; bf16_t* dst = a2g + (size_t)(bp * 256 + bb * 128) * A2LD + 256 + n;
            float sr = 0.f, si = 0.f;
#pragma unroll 8
            for (int c = 0; c < 128; ++c) { dst[(size_t)c * A2LD] = (bf16_t)f2bf(sr); dst[(size_t)c * A2LD + 64] = (bf16_t)f2bf(si);
                const float lr = S[c * SLD + n], li = S[c * SLD + 64 + n]; const float nr = a16.x * sr - a16.y * si + lr, ni = a16.x * si + a16.y * sr + li; sr = nr; si = ni; }
        }
        VM_WAIT(); __syncthreads();
        if (F.tid == 0) { __builtin_amdgcn_fence(__ATOMIC_ACQUIRE, "agent"); VM_WAIT(); }
        __syncthreads();
        { pg8::Gemm g2{a2g, (const bf16_t*)(F.ws + WS_BT2) + (size_t)lg * 256 * A2LD, A2LD, A2LD, A2LD, -1}; pg8::OneUnit S{bp, 0};
          EpiSsmOut E{a2g, a->in[I_D] + (size_t)l * DS + g * 16, (bf16_t*)(F.ws + WS_YG), g};
          pg8::gemm_phase<EpiSsmOut, pg8::OneUnit, false, true>(F.lds, g2, S, E, F.tid); }
        __syncthreads();
    }
}


typedef float f32x16 __attribute__((ext_vector_type(16)));
constexpr int RT_K0 = 0, RT_V0 = 65536, RT_P = 131072, RT_RED = 147456, RT_OLD = 528;
#define RT_BAR() do { asm volatile("s_waitcnt lgkmcnt(0)" ::: "memory"); __builtin_amdgcn_s_barrier(); asm volatile("" ::: "memory"); } while (0)
__device__ __forceinline__ void p2_ret(const Frame& F) {
    int t_ = F.tid; asm volatile("" : "+v"(t_));
    const int tid = t_, lane = tid & 63, w = __builtin_amdgcn_readfirstlane(tid >> 6), wr = w & 3, wc = w >> 2, l31 = lane & 31, hh = lane >> 5;
    LAS unsigned char* lds = F.lds;
    const bf16_t* qg = (const bf16_t*)(F.ws + WS_Q); const bf16_t* kg = (const bf16_t*)(F.ws + WS_K); const bf16_t* vtg = (const bf16_t*)(F.ws + WS_VT);
    const bf16_t* grg = (const bf16_t*)(F.ws + WS_GR); bf16_t* ycat = (bf16_t*)(F.ws + WS_YCAT);
    const unsigned koff = (unsigned)((2 * w + hh) * 4096 + ((l31 ^ ((2 * w + hh) & 15)) << 4));
    const unsigned voff = (unsigned)((8 * w + (lane >> 3)) * 16384 + (((lane & 7) ^ (((lane >> 4) + 4 * w) & 7)) << 4));
    for (int it = F.vcu; it < BATCH * RH * 8; it += F.G) {
        const int bh = it >> 3, p = it & 7, b = bh >> 3, h = bh & 7;
        const float e = __builtin_amdgcn_exp2f((float)(-5 - h));
        const float lg2 = -(e * (1.f + e * (0.5f + e * (0.33333334f + e * (0.25f + e * (0.2f + e * 0.16666667f)))))) * 1.4426950408889634f;
        for (int uu = 0; uu < 2; ++uu) {
            const int qi = uu ? p : 15 - p, ntile = 2 * (qi + 1);
            const size_t tokq = (size_t)b * SEQ + qi * 128;
            bf16x8 qf[16];
            { const bf16_t* qp = qg + (tokq + wr * 32 + l31) * DR + h * 256 + 8 * hh;
#pragma unroll
              for (int s = 0; s < 16; ++s) qf[s] = *(const bf16x8*)(qp + 16 * s); }
            f32x16 oacc[4];
#pragma unroll
            for (int db = 0; db < 4; ++db)
#pragma unroll
                for (int r = 0; r < 16; ++r) oacc[db][r] = 0.f;
#define RT_DMA(kt_, bf_) do { const char* kb_ = (const char*)(kg + ((size_t)(b * SEQ + (kt_) * 64) * DR + h * 256)) + koff; const char* vb_ = (const char*)(vtg + ((size_t)(h * 256) * MTOK + b * SEQ + (kt_) * 64)) + voff; \
            _Pragma("unroll") for (int i_ = 0; i_ < 4; ++i_) __builtin_amdgcn_global_load_lds((const unsigned*)(kb_ + i_ * 65536), (LAS unsigned*)(lds + RT_K0 + (bf_) * 32768 + (w + 8 * i_) * 1024), 16, 0, 0); \
            _Pragma("unroll") for (int i_ = 0; i_ < 4; ++i_) __builtin_amdgcn_global_load_lds((const unsigned*)(vb_ + i_ * 1048576), (LAS unsigned*)(lds + RT_V0 + (bf_) * 32768 + (w + 8 * i_) * 1024), 16, 0, 0); } while (0)
            RT_DMA(0, 0);
            asm volatile("s_waitcnt vmcnt(0)" ::: "memory"); RT_BAR();
            for (int kt = 0; kt < ntile; ++kt) {
                const int bf = kt & 1;
                if (kt + 1 < ntile) RT_DMA(kt + 1, bf ^ 1);
                int lo_ = lane; asm volatile("" : "+v"(lo_));
                const int l31 = lo_ & 31, hh = lo_ >> 5, x15 = l31 & 15, m4 = ((l31 >> 1) & 7) << 4, lane = lo_;
                f32x16 st;
#pragma unroll
                for (int r = 0; r < 16; ++r) st[r] = 0.f;
                { const LAS unsigned char* kb = lds + RT_K0 + bf * 32768 + (32 * wc + l31) * 512;
#define RT_KRD(dst, s0) do { _Pragma("unroll") for (int j_ = 0; j_ < 4; ++j_) dst[j_] = *(const LAS bf16x8*)(kb + ((((2 * ((s0) + j_)) | hh) ^ x15) << 4)); } while (0)
#define RT_KMM(src, s0) do { _Pragma("unroll") for (int j_ = 0; j_ < 4; ++j_) st = __builtin_amdgcn_mfma_f32_32x32x16_bf16(src[j_], qf[(s0) + j_], st, 0, 0, 0); } while (0)
                  bf16x8 ka[4], kc[4];
                  RT_KRD(ka, 0); __builtin_amdgcn_sched_barrier(0);
                  RT_KRD(kc, 4); RT_KMM(ka, 0); __builtin_amdgcn_sched_barrier(0);
                  RT_KRD(ka, 8); RT_KMM(kc, 4); __builtin_amdgcn_sched_barrier(0);
                  RT_KRD(kc, 12); RT_KMM(ka, 8); __builtin_amdgcn_sched_barrier(0);
                  RT_KMM(kc, 12); __builtin_amdgcn_sched_barrier(0);
#undef RT_KRD
#undef RT_KMM
                }
                { const bool diag = kt >= 2 * qi;
                  unsigned pk[8];
                  if (!diag) { const float tf = __builtin_amdgcn_exp2f((float)(128 * (qi - (kt >> 1))) * lg2);
#pragma unroll
                      for (int i = 0; i < 8; ++i) pk[i] = cvt_pk_bf16(st[2 * i] * tf, st[2 * i + 1] * tf);
                  } else { const int lim = wr * 32 + l31 + (2 * qi - kt) * 64 - 32 * wc - 4 * hh;
#pragma unroll
                      for (int i = 0; i < 8; ++i) { const int r0 = 2 * i, r1 = 2 * i + 1, o0 = (r0 & 3) + 8 * (r0 >> 2), o1 = (r1 & 3) + 8 * (r1 >> 2);
                          pk[i] = cvt_pk_bf16((o0 <= lim) ? st[r0] : 0.f, (o1 <= lim) ? st[r1] : 0.f); } }
                  LAS unsigned char* pw = lds + RT_P + ((wr * 2 + wc) * 2) * 1024 + lane * 16;
                  *(LAS u32x4*)pw = (u32x4){pk[0], pk[1], pk[2], pk[3]}; *(LAS u32x4*)(pw + 1024) = (u32x4){pk[4], pk[5], pk[6], pk[7]}; }
                RT_BAR();
                { bf16x8 pf[2][2];
#pragma unroll
                  for (int kb2 = 0; kb2 < 2; ++kb2)
#pragma unroll
                      for (int s = 0; s < 2; ++s) pf[kb2][s] = *(const LAS bf16x8*)(lds + RT_P + ((wr * 2 + kb2) * 2 + s) * 1024 + lane * 16);
                  const LAS unsigned char* vb = lds + RT_V0 + bf * 32768 + (128 * wc + l31) * 128 + 8 * hh;
#define RT_VRD(dst, db) do { _Pragma("unroll") for (int j_ = 0; j_ < 4; ++j_) { const int v_ = 4 * (j_ >> 1) + 2 * (j_ & 1); \
                      const u32x2 lo_ = *(const LAS u32x2*)(vb + (db) * 4096 + ((v_ << 4) ^ m4)), hi_ = *(const LAS u32x2*)(vb + (db) * 4096 + (((v_ + 1) << 4) ^ m4)); \
                      dst[j_] = (u32x4){lo_.x, lo_.y, hi_.x, hi_.y}; } } while (0)
#define RT_VMM(src, db) do { _Pragma("unroll") for (int j_ = 0; j_ < 4; ++j_) oacc[db] = __builtin_amdgcn_mfma_f32_32x32x16_bf16(pf[j_ >> 1][j_ & 1], __builtin_bit_cast(bf16x8, src[j_]), oacc[db], 0, 0, 0); } while (0)
                  u32x4 va[4], vc[4];
                  RT_VRD(va, 0); __builtin_amdgcn_sched_barrier(0);
                  RT_VRD(vc, 1); RT_VMM(va, 0); __builtin_amdgcn_sched_barrier(0);
                  RT_VRD(va, 2); RT_VMM(vc, 1); __builtin_amdgcn_sched_barrier(0);
                  RT_VRD(vc, 3); RT_VMM(va, 2); __builtin_amdgcn_sched_barrier(0);
                  RT_VMM(vc, 3); __builtin_amdgcn_sched_barrier(0);
#undef RT_VRD
#undef RT_VMM
                }
                asm volatile("s_waitcnt vmcnt(0)" ::: "memory"); RT_BAR();
            }
            int le_ = tid; asm volatile("" : "+v"(le_));
            const int tide = le_, l31e = le_ & 31, hhe = (le_ >> 5) & 1;
            float ssr[16];
#pragma unroll
            for (int r = 0; r < 16; ++r) { float s2 = 0.f;
#pragma unroll
                for (int db = 0; db < 4; ++db) { const float o = oacc[db][r]; s2 += o * o; }
                s2 = xor_add<1>(s2); s2 = xor_add<2>(s2); s2 = xor_add<4>(s2); s2 = xor_add<8>(s2); s2 = xor_add<16>(s2); ssr[r] = s2; }
            if (l31e == 0) {
#pragma unroll
                for (int i = 0; i < 4; ++i) *(LAS f32x4*)(lds + RT_RED + w * 128 + hhe * 64 + i * 16) = (f32x4){ssr[4 * i], ssr[4 * i + 1], ssr[4 * i + 2], ssr[4 * i + 3]}; }
            RT_BAR();
#pragma unroll
            for (int i = 0; i < 4; ++i) { const f32x4 t = *(const LAS f32x4*)(lds + RT_RED + (w ^ 4) * 128 + hhe * 64 + i * 16);
#pragma unroll
                for (int j = 0; j < 4; ++j) ssr[4 * i + j] = __builtin_amdgcn_rsqf((ssr[4 * i + j] + t[j]) * (1.f / 256.f) + EPS); }
#pragma unroll
            for (int r = 0; r < 16; ++r) { LAS unsigned char* ow = lds + (wr * 32 + 4 * hhe + (r & 3) + 8 * (r >> 2)) * RT_OLD + (128 * wc + l31e) * 2;
#pragma unroll
                for (int db = 0; db < 4; ++db) *(LAS unsigned short*)(ow + db * 64) = (unsigned short)f2bf(oacc[db][r] * ssr[r]); }
            RT_BAR();
#pragma unroll
            for (int i = 0; i < 8; ++i) { const int idx = i * 512 + tide, row = idx >> 5, ch = idx & 31; const size_t tok = tokq + row;
                const u32x4 o = *(const LAS u32x4*)(lds + row * RT_OLD + ch * 16), gv = *(const u32x4*)(grg + tok * DR + h * 256 + ch * 8);
                u32x4 y;
                y.x = cvt_pk_bf16(bf2f(o.x & 0xffffu) * bf2f(gv.x & 0xffffu), bf2f(o.x >> 16) * bf2f(gv.x >> 16)); y.y = cvt_pk_bf16(bf2f(o.y & 0xffffu) * bf2f(gv.y & 0xffffu), bf2f(o.y >> 16) * bf2f(gv.y >> 16));
                y.z = cvt_pk_bf16(bf2f(o.z & 0xffffu) * bf2f(gv.z & 0xffffu), bf2f(o.z >> 16) * bf2f(gv.z >> 16)); y.w = cvt_pk_bf16(bf2f(o.w & 0xffffu) * bf2f(gv.w & 0xffffu), bf2f(o.w >> 16) * bf2f(gv.w >> 16));
                *(u32x4*)(ycat + tok * DM + DS + h * 256 + ch * 8) = y; }
            asm volatile("s_waitcnt vmcnt(0)" ::: "memory"); RT_BAR();
#undef RT_DMA
        }
    }
}

__device__ __forceinline__ void p3_glu(const Frame& F, ArgsP a, int l) {
    pg8::StaticOrder S; S.init(MTOK, DS, F.G, F.bid);
    pg8::Gemm g{(const bf16_t*)(F.ws + WS_YG), (const bf16_t*)(F.ws + WS_WTGLU) + (size_t)l * DS * DS, DS, DS, DS, -1};
    EpiGlu E{(const bf16_t*)(F.ws + WS_YG), (const bf16_t*)(F.ws + WS_GS), a->in[I_BGLU] + (size_t)l * DS, (bf16_t*)(F.ws + WS_YCAT), (float*)(F.ws + WS_SSQ2)};
    pg8::gemm_phase<EpiGlu, pg8::StaticOrder, true, true>(F.lds, g, S, E, F.tid);
}

__device__ __forceinline__ void p4_out(const Frame& F, ArgsP a, int l) {
    pg8::StaticOrder S; S.init(MTOK, DM, F.G, F.bid); Unit u0; S.next(0, u0);
    stash_rstd(F, (const float*)(F.ws + WS_SSQ2), 32, u0.pm, 1.f / DS);
    pg8::Gemm g{(const bf16_t*)(F.ws + WS_YCAT), (const bf16_t*)(F.ws + WS_WTOUT) + (size_t)l * DM * DM, DM, DM, DM, DS / 64};
    const bool lastl = (l == DEPTH - 1);
    EpiOut E{(const LAS float*)(F.lds + STASH_OFF), l == 0 ? a->in[I_X] : (const float*)(F.ws + WS_X1), lastl ? a->out : (float*)(F.ws + WS_X1), lastl ? nullptr : (bf16_t*)(F.ws + WS_XB), (float*)(F.ws + WS_SSQX)};
    pg8::gemm_phase<EpiOut, pg8::StaticOrder, true, true>(F.lds, g, S, E, F.tid);
}

__device__ __forceinline__ void p5_final(const Frame& F, ArgsP a) {
    const int gw = F.vcu * 8 + F.wave, NGW = F.G * 8; const f32x4* fw = (const f32x4*)a->in[I_FNW] + F.lane;
    for (int m = gw; m < MTOK; m += NGW) {
        const float s = wave_sum(((const float*)(F.ws + WS_SSQX))[(size_t)m * 64 + F.lane]); const float rstd = __builtin_amdgcn_rsqf(s * (1.f / DM) + EPS);
        f32x4* xr = (f32x4*)(a->out + (size_t)m * DM) + F.lane;
#pragma unroll
        for (int j = 0; j < 16; ++j) xr[64 * j] = xr[64 * j] * rstd * fw[64 * j];
    }
}

constexpr int NPH = 2 + 4 * DEPTH;
__global__ void __launch_bounds__(512, 2) mk_fwd(Args args) {
    extern __shared__ __attribute__((aligned(16))) unsigned char lds_raw[];
    cg::grid_group grid = cg::this_grid();
    Frame F; F.lds = (LAS unsigned char*)lds_raw; F.G = gridDim.x;
    const int wave0 = __builtin_amdgcn_readfirstlane((int)threadIdx.x >> 6);
    for (int ph = args.ph_lo; ph < args.ph_hi; ++ph) {
        ArgsP ap = (ArgsP)__builtin_amdgcn_kernarg_segment_ptr(); asm volatile("" : "+s"(ap));
        { unsigned m_ = ~0u; asm volatile("" : "+s"(m_)); int t_ = wave0 * 64 + (int)__builtin_amdgcn_mbcnt_hi(m_, __builtin_amdgcn_mbcnt_lo(m_, 0u)); asm volatile("" : "+v"(t_)); F.tid = t_; F.lane = t_ & 63; F.wave = wave0;
          int b_ = blockIdx.x; asm volatile("" : "+s"(b_)); F.bid = b_; F.vcu = (F.G % 8 == 0) ? (b_ % 8) * (F.G / 8) + b_ / 8 : b_;
          size_t z_ = 0; asm volatile("" : "+s"(z_)); F.ws = ap->ws + z_; }
#ifndef PHMASK
#define PHMASK 127
#endif
        if (ph == 0) { if (PHMASK & 1) p0_prologue(F, ap); }
        else if (ph == NPH - 1) { if (PHMASK & 32) p5_final(F, ap); }
        else { const int l = (ph - 1) >> 2, s = (ph - 1) & 3;
            if (s == 0) { if (PHMASK & 2) p1_inproj(F, l); }
            else if (s == 1) {
#if FAST_SSM
                if (PHMASK & 4) p2_ssm(F, ap, l);
#endif
#if FAST_RET
                if (PHMASK & 64) p2_ret(F);
#endif
            }
            else if (s == 2) { if (PHMASK & 8) p3_glu(F, ap, l); }
            else { if (PHMASK & 16) p4_out(F, ap, l); } }
#ifdef REPEAT_MASK
        __syncthreads();
        { const int s2 = (ph - 1) & 3, l2 = (ph - 1) >> 2;
          if (ph == 0) { if (REPEAT_MASK & 1) p0_prologue(F, ap); if (REPEAT_MASK >> 8) p0_prologue(F, ap, REPEAT_MASK >> 8); }
          else if (ph < NPH - 1) {
            if (s2 == 0 && (REPEAT_MASK & 2)) p1_inproj(F, l2);
            if (s2 == 1 && (REPEAT_MASK & 4)) p2_ssm(F, ap, l2);
            if (s2 == 1 && (REPEAT_MASK & 64)) p2_ret(F);
            if (s2 == 2 && (REPEAT_MASK & 8)) p3_glu(F, ap, l2);
            if (s2 == 3 && (REPEAT_MASK & 16)) p4_out(F, ap, l2); } }
#endif
        if (ph + 1 < args.ph_hi) grid.sync();
    }
}

__global__ void __launch_bounds__(64) naive_ssm(Args args, int l) {
    const int b = blockIdx.x >> 7, g = blockIdx.x & 127, lg = l * NG + g, n = threadIdx.x;
    const double dt = (double)expf(args.in[I_LOGDT][lg]);
    const float lr = args.in[I_LRE][lg * 64 + n], li = args.in[I_LIM][lg * 64 + n];
    float ac, as; cis_d((double)li * dt, ac, as); const float mag = expf(lr * (float)dt); const float ar = mag * ac, ai = mag * as;
    const float nr = ar - 1.f, ni = ai, den = lr * lr + li * li, cor = (nr * lr + ni * li) / den, coi = (ni * lr - nr * li) / den;
    float bbr[16], bbi[16], cr[16], ci[16];
#pragma unroll
    for (int h = 0; h < 16; ++h) { const float br = args.in[I_BRE][(size_t)(lg * 64 + n) * 16 + h], bi = args.in[I_BIM][(size_t)(lg * 64 + n) * 16 + h];
        bbr[h] = cor * br - coi * bi; bbi[h] = cor * bi + coi * br; cr[h] = args.in[I_CRE][(size_t)(lg * 16 + h) * 64 + n]; ci[h] = args.in[I_CIM][(size_t)(lg * 16 + h) * 64 + n]; }
    const float dsk = args.in[I_D][(size_t)l * DS + g * 16 + (n & 15)];
    const bf16_t* a2g = (const bf16_t*)(args.ws + WS_A2U) + (size_t)g * 512 * A2LD; bf16_t* yg = (bf16_t*)(args.ws + WS_YG);
    float sr = 0.f, si = 0.f;
    for (int t = 0; t < SEQ; ++t) {
        const u32x4* up = (const u32x4*)(a2g + (size_t)(b * 128 + (t >> 4)) * A2LD + (t & 15) * 16); const u32x4 u0 = up[0], u1 = up[1];
        float uv[16];
        uv[0] = bf2f(u0.x & 0xffffu); uv[1] = bf2f(u0.x >> 16); uv[2] = bf2f(u0.y & 0xffffu); uv[3] = bf2f(u0.y >> 16); uv[4] = bf2f(u0.z & 0xffffu); uv[5] = bf2f(u0.z >> 16); uv[6] = bf2f(u0.w & 0xffffu); uv[7] = bf2f(u0.w >> 16);
        uv[8] = bf2f(u1.x & 0xffffu); uv[9] = bf2f(u1.x >> 16); uv[10] = bf2f(u1.y & 0xffffu); uv[11] = bf2f(u1.y >> 16); uv[12] = bf2f(u1.z & 0xffffu); uv[13] = bf2f(u1.z >> 16); uv[14] = bf2f(u1.w & 0xffffu); uv[15] = bf2f(u1.w >> 16);
        float bur = 0.f, bui = 0.f;
#pragma unroll
        for (int h = 0; h < 16; ++h) { bur += bbr[h] * uv[h]; bui += bbi[h] * uv[h]; }
        const float nsr = ar * sr - ai * si + bur, nsi = ar * si + ai * sr + bui; sr = nsr; si = nsi;
        float y = 0.f, um = 0.f;
#pragma unroll
        for (int h = 0; h < 16; ++h) { const float p = wave_sum(cr[h] * sr - ci[h] * si); if (n == h) { y = p; um = uv[h]; } }
        if (n < 16) yg[(size_t)(b * SEQ + t) * DS + g * 16 + n] = (bf16_t)f2bf(gelu_tanh_f(y + dsk * um));
    }
}

constexpr int NR_KLD = 264;
__global__ void __launch_bounds__(256) naive_ret(Args args, int l) {
    extern __shared__ __attribute__((aligned(16))) unsigned char sm[];
    bf16_t* Qs = (bf16_t*)sm;
    bf16_t* Ks = Qs + 32 * 256;
    float* Ss = (float*)(Ks + 64 * NR_KLD);
    float* red = Ss + 32 * 64;
    const int qt = blockIdx.x & 63, h = (blockIdx.x >> 6) & 7, b = blockIdx.x >> 9, tid = threadIdx.x, lane = tid & 63, wv = tid >> 6;
    const bf16_t* q = (const bf16_t*)(args.ws + WS_Q); const bf16_t* k = (const bf16_t*)(args.ws + WS_K); const bf16_t* vt = (const bf16_t*)(args.ws + WS_VT); const bf16_t* gr = (const bf16_t*)(args.ws + WS_GR);
    const int tok0 = b * SEQ + qt * 32;
    for (int e = tid; e < 32 * 32; e += 256) { const int r = e >> 5, c = (e & 31) * 8; *(u32x4*)(Qs + r * 256 + c) = *(const u32x4*)(q + (size_t)(tok0 + r) * DR + h * 256 + c); }
    const float lg2 = log2f(1.f - exp2f(-5.f - (float)h));
    float o[32];
#pragma unroll
    for (int r = 0; r < 32; ++r) o[r] = 0.f;
    const int ntile = qt / 2 + 1;
    for (int kt = 0; kt < ntile; ++kt) {
        __syncthreads();
        for (int e = tid; e < 64 * 32; e += 256) { const int r = e >> 5, c = (e & 31) * 8; *(u32x4*)(Ks + r * NR_KLD + c) = *(const u32x4*)(k + (size_t)(b * SEQ + kt * 64 + r) * DR + h * 256 + c); }
        __syncthreads();
        { const int key = lane, rg = wv; float acc[8];
#pragma unroll
          for (int r = 0; r < 8; ++r) acc[r] = 0.f;
          for (int d = 0; d < 256; d += 8) { const u32x4 kv = *(const u32x4*)(Ks + key * NR_KLD + d);
              const float k0 = bf2f(kv.x & 0xffffu), k1 = bf2f(kv.x >> 16), k2 = bf2f(kv.y & 0xffffu), k3 = bf2f(kv.y >> 16), k4 = bf2f(kv.z & 0xffffu), k5 = bf2f(kv.z >> 16), k6 = bf2f(kv.w & 0xffffu), k7 = bf2f(kv.w >> 16);
#pragma unroll
              for (int r = 0; r < 8; ++r) { const u32x4 qv = *(const u32x4*)(Qs + (rg * 8 + r) * 256 + d);
                  acc[r] += bf2f(qv.x & 0xffffu) * k0 + bf2f(qv.x >> 16) * k1 + bf2f(qv.y & 0xffffu) * k2 + bf2f(qv.y >> 16) * k3 + bf2f(qv.z & 0xffffu) * k4 + bf2f(qv.z >> 16) * k5 + bf2f(qv.w & 0xffffu) * k6 + bf2f(qv.w >> 16) * k7; } }
#pragma unroll
          for (int r = 0; r < 8; ++r) { const int i = qt * 32 + rg * 8 + r, j = kt * 64 + key; Ss[(rg * 8 + r) * 64 + key] = (i >= j) ? acc[r] * exp2f((float)(128 * ((i >> 7) - (j >> 7))) * lg2) : 0.f; } }
        __syncthreads();
        { const bf16_t* vr = vt + (size_t)(h * 256 + tid) * MTOK + b * SEQ + kt * 64;
          for (int kk = 0; kk < 64; kk += 8) { const u32x4 vv = *(const u32x4*)(vr + kk);
              const float v0 = bf2f(vv.x & 0xffffu), v1 = bf2f(vv.x >> 16), v2 = bf2f(vv.y & 0xffffu), v3 = bf2f(vv.y >> 16), v4 = bf2f(vv.z & 0xffffu), v5 = bf2f(vv.z >> 16), v6 = bf2f(vv.w & 0xffffu), v7 = bf2f(vv.w >> 16);
#pragma unroll
              for (int r = 0; r < 32; ++r) { const f32x4 s0 = *(const f32x4*)(Ss + r * 64 + kk), s1 = *(const f32x4*)(Ss + r * 64 + kk + 4);
                  o[r] += s0[0] * v0 + s0[1] * v1 + s0[2] * v2 + s0[3] * v3 + s1[0] * v4 + s1[1] * v5 + s1[2] * v6 + s1[3] * v7; } } }
    }
    __syncthreads();
#pragma unroll
    for (int r = 0; r < 32; ++r) { const float p = wave_sum(o[r] * o[r]); if (lane == 0) red[r * 4 + wv] = p; }
    __syncthreads();
    bf16_t* ycat = (bf16_t*)(args.ws + WS_YCAT);
#pragma unroll
    for (int r = 0; r < 32; ++r) { const float ss = (red[r * 4] + red[r * 4 + 1]) + (red[r * 4 + 2] + red[r * 4 + 3]); const float rstd = __builtin_amdgcn_rsqf(ss * (1.f / 256.f) + EPS);
        const size_t tok = (size_t)(tok0 + r); ycat[tok * DM + DS + h * 256 + tid] = (bf16_t)f2bf(o[r] * rstd * bf2f(gr[tok * DR + h * 256 + tid])); }
}

extern "C" void kernel_launch(void* const* d_in, const int* in_sizes, int n_in, void* d_out, int out_size, void* d_ws, size_t ws_size, hipStream_t stream) {
    static int grid = 0;
    if (grid == 0) {
        if (n_in != 17 || in_sizes[0] != MTOK * DM || out_size != MTOK * DM || ws_size < WS_END) { fprintf(stderr, "kernel_launch: unexpected problem (n_in %d, x %d, out %d, ws %zu)\n", n_in, n_in > 0 ? in_sizes[0] : -1, out_size, ws_size); grid = -1; return; }
        int dev = 0, cus = 0, per_cu = 0;
        hipGetDevice(&dev); hipDeviceGetAttribute(&cus, hipDeviceAttributeMultiprocessorCount, dev);
        if (hipFuncSetAttribute((const void*)mk_fwd, hipFuncAttributeMaxDynamicSharedMemorySize, LDS_BYTES) != hipSuccess) { fprintf(stderr, "kernel_launch: hipFuncSetAttribute failed\n"); grid = -1; return; }
        hipFuncSetAttribute((const void*)naive_ret, hipFuncAttributeMaxDynamicSharedMemorySize, 65536);
        hipOccupancyMaxActiveBlocksPerMultiprocessor(&per_cu, (const void*)mk_fwd, 512, LDS_BYTES);
        (void)hipGetLastError();
        if (per_cu < 1) fprintf(stderr, "kernel_launch: occupancy query says %d blocks per CU\n", per_cu);
        grid = cus;
        if (grid != 256) fprintf(stderr, "kernel_launch: %d CUs (phase balance assumes 256)\n", grid);
        for (int c = 0; c < grid; ++c) { pg8::StaticOrder S; Unit u0, u;
            S.init(MTOK, 10240, grid, c); S.next(0, u0); for (int i = 1; S.next(i, u); ++i) if (u.pm != u0.pm) { fprintf(stderr, "kernel_launch: in-proj unit order breaks the one-panel-per-workgroup assumption\n"); grid = -1; return; }
            S.init(DR, MTOK, grid, c); S.next(0, u0); for (int i = 1; S.next(i, u); ++i) if (u.pn != u0.pn) { fprintf(stderr, "kernel_launch: V^T unit order breaks the assumption\n"); grid = -1; return; }
            S.init(MTOK, DM, grid, c); S.next(0, u0); for (int i = 1; S.next(i, u); ++i) if (u.pm != u0.pm) { fprintf(stderr, "kernel_launch: out-proj unit order breaks the assumption\n"); grid = -1; return; } }
    }
    if (grid < 0) return;
    Args a{};
    for (int i = 0; i < 17; ++i) a.in[i] = (const float*)d_in[i];
    a.out = (float*)d_out; a.ws = (unsigned char*)d_ws;
    auto launch = [&](int lo, int hi) { a.ph_lo = lo; a.ph_hi = hi; void* kargs[] = {&a};
        hipError_t e = hipLaunchCooperativeKernel((const void*)mk_fwd, dim3(grid), dim3(512), kargs, LDS_BYTES, stream);
        if (e != hipSuccess) fprintf(stderr, "kernel_launch: cooperative launch [%d,%d) failed: %s\n", lo, hi, hipGetErrorString(e)); };
#if FAST_SSM && FAST_RET && ONE_LAUNCH
    launch(0, NPH);
#else
    launch(0, 1);
    for (int l = 0; l < DEPTH; ++l) {
        launch(1 + 4 * l, 2 + 4 * l);
        launch(2 + 4 * l, 3 + 4 * l);
#if !FAST_SSM
        hipLaunchKernelGGL(naive_ssm, dim3(BATCH * NG), dim3(64), 0, stream, a, l);
#endif
#if !FAST_RET
        hipLaunchKernelGGL(naive_ret, dim3(BATCH * RH * 64), dim3(256), 32 * 256 * 2 + 64 * NR_KLD * 2 + 32 * 64 * 4 + 32 * 4 * 4, stream, a, l);
#endif
        launch(3 + 4 * l, 4 + 4 * l);
        launch(4 + 4 * l, 5 + 4 * l);
    }
    launch(NPH - 1, NPH);
#endif
}
```

```cpp
#include <hip/hip_runtime.h>
#include <hip/hip_cooperative_groups.h>
#include <cstdio>
#include <cstdint>
namespace cg = cooperative_groups;

#ifndef FAST_SSM
#define FAST_SSM 1
#endif
#ifndef FAST_RET
#define FAST_RET 1
#endif

#ifndef ONE_LAUNCH
#define ONE_LAUNCH 1
#endif

#define LAS __attribute__((address_space(3)))
typedef unsigned short bf16_t;
typedef short bf16x8 __attribute__((ext_vector_type(8)));
typedef float f32x4 __attribute__((ext_vector_type(4)));
typedef float f32x2 __attribute__((ext_vector_type(2)));
typedef unsigned u32x4 __attribute__((ext_vector_type(4)));
typedef unsigned u32x2 __attribute__((ext_vector_type(2)));

constexpr int BATCH = 4, SEQ = 2048, DM = 4096, DEPTH = 2, DS = 2048, DR = 2048, NG = 128, SG = 16, NST = 64, RH = 8, RD = 256;
constexpr int NPROJ = 12288, MTOK = BATCH * SEQ;
constexpr float EPS = 1e-6f;
constexpr int TCH = 16;
constexpr int A2LD = 384;

constexpr size_t MiB = 1u << 20;
constexpr size_t WS_CTL = 0;
constexpr size_t WS_WTIN = 16 * MiB;
constexpr size_t WS_WTGLU = 208 * MiB;
constexpr size_t WS_WTOUT = 224 * MiB;
constexpr size_t WS_BT2 = 288 * MiB;
constexpr size_t WS_PM = 336 * MiB;
constexpr size_t WS_A16 = 368 * MiB;
constexpr size_t WS_ROPE = 369 * MiB;
constexpr size_t WS_SSQX = 371 * MiB;
constexpr size_t WS_SSQ2 = 373 * MiB;
constexpr size_t WS_XB = 384 * MiB;
constexpr size_t WS_X1 = 448 * MiB;
constexpr size_t WS_A2U = 576 * MiB;
constexpr size_t WS_GS = 624 * MiB, WS_Q = 656 * MiB, WS_K = 688 * MiB, WS_VT = 720 * MiB, WS_GR = 752 * MiB, WS_YG = 784 * MiB;
constexpr size_t WS_YCAT = 816 * MiB;
constexpr size_t WS_END = 880 * MiB;

constexpr int RING_BYTES = 131072;
constexpr int STASH_OFF = 155648;
constexpr int LDS_BYTES = 163840 - 4096;

__device__ __forceinline__ unsigned f2bf(float f) { unsigned u = __builtin_bit_cast(unsigned, f); return (u + 0x7fffu + ((u >> 16) & 1u)) >> 16; }
__device__ __forceinline__ unsigned pk2(float lo, float hi) { return f2bf(lo) | (f2bf(hi) << 16); }
__device__ __forceinline__ float bf2f(unsigned v) { return __builtin_bit_cast(float, v << 16); }
__device__ __forceinline__ unsigned cvt_pk_bf16(float lo, float hi) { unsigned r; asm volatile("v_cvt_pk_bf16_f32 %0, %1, %2" : "=v"(r) : "v"(lo), "v"(hi)); return r; }
__device__ __forceinline__ float silu_f(float x) { return x * __builtin_amdgcn_rcpf(1.f + __expf(-x)); }
__device__ __forceinline__ float sigmoid_f(float x) { return __builtin_amdgcn_rcpf(1.f + __expf(-x)); }
__device__ __forceinline__ float gelu_tanh_f(float x) {
    const float z = 0.7978845608028654f * (x + 0.044715f * x * x * x);
    const float th = 1.f - 2.f * __builtin_amdgcn_rcpf(1.f + __expf(2.f * z));
    return 0.5f * x * (1.f + th);
}
template <int X> __device__ __forceinline__ float xor_add(float v) {
    if constexpr (X == 32) { const unsigned u = __builtin_bit_cast(unsigned, v); auto r = __builtin_amdgcn_permlane32_swap(u, u, false, false);
        return __builtin_bit_cast(float, (unsigned)r[0]) + __builtin_bit_cast(float, (unsigned)r[1]); }
    else return v + __builtin_bit_cast(float, __builtin_amdgcn_ds_swizzle(__builtin_bit_cast(int, v), (X << 10) | 0x1f));
}
__device__ __forceinline__ float wave_sum(float v) {
    v = xor_add<1>(v); v = xor_add<2>(v); v = xor_add<4>(v); v = xor_add<8>(v); v = xor_add<16>(v); v = xor_add<32>(v);
    return v;
}
__device__ __forceinline__ void cis_d(double ph, float& c, float& s) {
    const double rv = ph * 0.15915494309189535;
    const float r = (float)(rv - __builtin_rint(rv));
    c = __builtin_amdgcn_cosf(r); s = __builtin_amdgcn_sinf(r);
}
#define LDS_WAIT() asm volatile("s_waitcnt lgkmcnt(0)" ::: "memory")
#define VM_WAIT() asm volatile("s_waitcnt vmcnt(0)" ::: "memory")

namespace pg8 {
constexpr int BM = 256, BK = 64, HALF = 128, HTB = HALF * BK * 2, STAGE_BYTES = 8 * HTB, NXCD = 8, WGM = 8;
__host__ __device__ __forceinline__ int lds_byte(int r, int c) { const int st = (r >> 4) * 2 + (c >> 5), rr = r & 15, cc = c & 31, ob = rr * 64 + cc * 2; return st * 1024 + (ob ^ (((ob >> 9) & 1) << 5)); }
__host__ __device__ __forceinline__ void stage_rc(int b, int& R, int& C) { const int st = b / 1024, sb = b % 1024, swz = sb ^ (((sb >> 9) & 1) << 5); R = (st >> 1) * 16 + swz / 64; C = (st & 1) * 32 + (swz % 64) / 2; }
__host__ __device__ __forceinline__ int perm32(int rho) { const int n = rho >> 4, i = rho & 15; return 8 * (i >> 2) + 4 * n + (i & 3); }

struct Unit { int pm, pn; };
struct Gemm { const bf16_t* A; const bf16_t* Bt; int K, lda, ldb, kmid; };

struct StaticOrder {
    int nM, nN, nwg, G, c;
    __host__ __device__ void init(int M, int N, int G_, int c_) { nM = M / BM; nN = N / BM; nwg = nM * nN; G = G_; c = c_; }
    __host__ __device__ bool next(int i, Unit& u) const {
        const long L = (long)i * G + c; if (L >= nwg) return false;
        int wgid = (int)L; { const int q = nwg / NXCD, r = nwg % NXCD, xcd = wgid % NXCD, off = wgid / NXCD; wgid = (xcd < r ? xcd * (q + 1) : r * (q + 1) + (xcd - r) * q) + off; }
        const int nig = WGM * nN, gid = wgid / nig, fm = gid * WGM, gsz = (nM - fm) < WGM ? (nM - fm) : WGM;
        u.pm = fm + ((wgid % nig) % gsz); u.pn = (wgid % nig) / gsz; return true;
    }
};
struct OneUnit {
    int pm, pn;
    __device__ __forceinline__ bool next(int i, Unit& u) const { if (i) return false; u.pm = pm; u.pn = pn; return true; }
};

template <class Epi, class Sched, bool ALIGN_EPI, bool SP2>
__device__ __forceinline__ void gemm_phase(LAS unsigned char* lds, const Gemm g, const Sched& S, const Epi& E, int tid_in) {
    int tid_ = tid_in; asm volatile("" : "+v"(tid_));
    const int tid = tid_, wid = __builtin_amdgcn_readfirstlane(tid >> 6), lane = tid & 63, wr = wid >> 2, wc = wid & 3, fr = lane & 15, fq = lane >> 4;
    const int K = g.K, nt = K / BK;
    unsigned voffA[2], voffB[2];
#pragma unroll
    for (int i = 0; i < 2; ++i) { int R, C; stage_rc(tid * 16 + i * 8192, R, C); const int Rb = Epi::PERM ? ((R & ~31) + perm32(R & 31)) : R;
        voffA[i] = (unsigned)(R * g.lda + C) * 2u; voffB[i] = (unsigned)(Rb * g.ldb + C) * 2u; }
    const size_t kstep = (size_t)(BK * 2);
    const size_t hstepA = (size_t)HALF * g.lda * 2, hstepB = (size_t)HALF * g.ldb * 2;
    const size_t tstepA = 2 * hstepA, tstepB = 2 * hstepB;
    const unsigned ldsw = (unsigned)wid * 1024u;
    const int aoff = lds_byte(wr * 64 + fr, fq * 8), boff = lds_byte(wc * 32 + fr, fq * 8);
#define PG8_SA(b, h) (((b) * 2 + (h)) * HTB)
#define PG8_SB(b, h) ((4 + (b) * 2 + (h)) * HTB)
#define PG8_STAGE(bufoff, gbase, voff) do { _Pragma("unroll") for (int _i = 0; _i < 2; ++_i) \
        __builtin_amdgcn_global_load_lds((const unsigned*)((const char*)(gbase) + (voff)[_i]), (LAS unsigned*)(lds + (bufoff) + ldsw + _i * 8192), 16, 0, 0); } while (0)
#define PG8_LDA(dst, b, h) do { _Pragma("unroll") for (int m = 0; m < 4; ++m) _Pragma("unroll") for (int k = 0; k < 2; ++k) dst[m][k] = *(const LAS bf16x8*)(lds + PG8_SA(b, h) + aoff + m * 2048 + k * 1024); } while (0)
#define PG8_LDB(dst, b, h) do { _Pragma("unroll") for (int n = 0; n < 2; ++n) _Pragma("unroll") for (int k = 0; k < 2; ++k) dst[n][k] = *(const LAS bf16x8*)(lds + PG8_SB(b, h) + boff + n * 2048 + k * 1024); } while (0)
#define PG8_MMA(ai, bj, At, Bt) do { __builtin_amdgcn_s_setprio(1); _Pragma("unroll") for (int m = 0; m < 4; ++m) _Pragma("unroll") for (int n = 0; n < 2; ++n) _Pragma("unroll") for (int k = 0; k < 2; ++k) \
        acc[ai][bj][m][n] = __builtin_amdgcn_mfma_f32_16x16x32_bf16(Bt[n][k], At[m][k], acc[ai][bj][m][n], 0, 0, 0); __builtin_amdgcn_s_setprio(0); } while (0)
#define PG8_WAIT_V(n) asm volatile("s_waitcnt vmcnt(" #n ")" ::: "memory")
#define PG8_WAIT_L(n) asm volatile("s_waitcnt lgkmcnt(" #n ")" ::: "memory")
#define PG8_BAR __builtin_amdgcn_s_barrier()
#define PG8_SCHED __builtin_amdgcn_sched_barrier(0)
    Unit cur, nxt; int ui = 0;
    if (!S.next(0, cur)) return;
    f32x4 acc[2][2][4][2];
#pragma unroll
    for (int a = 0; a < 2; ++a)
#pragma unroll
        for (int b = 0; b < 2; ++b)
#pragma unroll
            for (int m = 0; m < 4; ++m)
#pragma unroll
                for (int n = 0; n < 2; ++n) acc[a][b][m][n] = (f32x4){0.f, 0.f, 0.f, 0.f};
    bf16x8 At[4][2], B0[2][2], B1[2][2];
    const char* cA = (const char*)g.A + (size_t)cur.pm * tstepA; const char* cB = (const char*)g.Bt + (size_t)cur.pn * tstepB;
    if constexpr (SP2) {
        PG8_STAGE(PG8_SB(0, 0), cB, voffB); PG8_STAGE(PG8_SB(0, 1), cB + hstepB, voffB); PG8_STAGE(PG8_SA(0, 0), cA, voffA); PG8_STAGE(PG8_SA(0, 1), cA + hstepA, voffA);
        if (wr == 1) PG8_BAR;
        PG8_WAIT_V(2); PG8_BAR;
        PG8_STAGE(PG8_SB(1, 0), cB + kstep, voffB); PG8_STAGE(PG8_SA(1, 0), cA + kstep, voffA); PG8_STAGE(PG8_SB(1, 1), cB + hstepB + kstep, voffB);
        PG8_WAIT_V(6); PG8_BAR;
    } else {
        PG8_STAGE(PG8_SB(0, 0), cB, voffB); PG8_STAGE(PG8_SA(0, 0), cA, voffA); PG8_STAGE(PG8_SB(0, 1), cB + hstepB, voffB); PG8_STAGE(PG8_SA(0, 1), cA + hstepA, voffA);
        if (wr == 1) PG8_BAR;
        PG8_WAIT_V(4); PG8_BAR;
        PG8_STAGE(PG8_SB(1, 0), cB + kstep, voffB); PG8_STAGE(PG8_SA(1, 0), cA + kstep, voffA); PG8_STAGE(PG8_SB(1, 1), cB + hstepB + kstep, voffB);
        PG8_WAIT_V(6); PG8_BAR;
    }
    for (;;) {
        const bool has_next = S.next(ui + 1, nxt);
        const char* nA = has_next ? (const char*)g.A + (size_t)nxt.pm * tstepA : cA; const char* nB = has_next ? (const char*)g.Bt + (size_t)nxt.pn * tstepB : cB;
        for (int t = 0; t < nt; t += 2) {
            const bool last = (t == nt - 2);
            const char* a1 = cA + (size_t)(t + 1) * kstep;
            const char* a2 = last ? nA : cA + (size_t)(t + 2) * kstep; const char* b2 = last ? nB : cB + (size_t)(t + 2) * kstep;
            const char* a3 = a2 + kstep; const char* b3 = b2 + kstep;
            if constexpr (Epi::MIDK) { if (t == g.kmid) E.midk(acc, wr, fr); }
            if constexpr (SP2) {
            PG8_LDB(B0, 0, 0); PG8_LDB(B1, 0, 1); PG8_SCHED; PG8_LDA(At, 0, 0); PG8_STAGE(PG8_SA(1, 1), a1 + hstepA, voffA);
            PG8_WAIT_V(8); PG8_WAIT_L(0); PG8_BAR; PG8_MMA(0, 0, At, B0); PG8_MMA(0, 1, At, B1); PG8_BAR; PG8_SCHED;
            PG8_LDA(At, 0, 1); PG8_STAGE(PG8_SB(0, 0), b2, voffB); PG8_STAGE(PG8_SB(0, 1), b2 + hstepB, voffB); PG8_STAGE(PG8_SA(0, 0), a2, voffA);
            PG8_WAIT_V(8); PG8_WAIT_L(0); PG8_BAR; PG8_MMA(1, 0, At, B0); PG8_MMA(1, 1, At, B1); PG8_BAR; PG8_SCHED;
            PG8_LDB(B0, 1, 0); PG8_LDB(B1, 1, 1); PG8_SCHED; PG8_LDA(At, 1, 0); PG8_STAGE(PG8_SA(0, 1), a2 + hstepA, voffA);
            PG8_WAIT_V(8); PG8_WAIT_L(0); PG8_BAR; PG8_MMA(0, 0, At, B0); PG8_MMA(0, 1, At, B1); PG8_BAR; PG8_SCHED;
            PG8_LDA(At, 1, 1); PG8_STAGE(PG8_SB(1, 0), b3, voffB); PG8_STAGE(PG8_SB(1, 1), b3 + hstepB, voffB); PG8_STAGE(PG8_SA(1, 0), a3, voffA);
            PG8_WAIT_V(8); PG8_WAIT_L(0); PG8_BAR; PG8_MMA(1, 0, At, B0); PG8_MMA(1, 1, At, B1); PG8_BAR; PG8_SCHED;
            } else {
            PG8_LDB(B0, 0, 0); PG8_SCHED; PG8_LDA(At, 0, 0); PG8_STAGE(PG8_SA(1, 1), a1 + hstepA, voffA);
            PG8_WAIT_L(8); PG8_BAR; PG8_WAIT_L(0); PG8_MMA(0, 0, At, B0); PG8_BAR; PG8_SCHED;
            PG8_LDB(B1, 0, 1); PG8_STAGE(PG8_SB(0, 0), b2, voffB);
            PG8_BAR; PG8_WAIT_L(0); PG8_MMA(0, 1, At, B1); PG8_BAR;
            PG8_LDA(At, 0, 1); PG8_STAGE(PG8_SA(0, 0), a2, voffA);
            PG8_BAR; PG8_WAIT_L(0); PG8_MMA(1, 0, At, B0); PG8_BAR; PG8_SCHED;
            PG8_STAGE(PG8_SB(0, 1), b2 + hstepB, voffB);
            PG8_WAIT_V(6); PG8_BAR; PG8_MMA(1, 1, At, B1); PG8_BAR;
            PG8_LDB(B0, 1, 0); PG8_SCHED; PG8_LDA(At, 1, 0); PG8_STAGE(PG8_SA(0, 1), a2 + hstepA, voffA);
            PG8_WAIT_L(8); PG8_BAR; PG8_WAIT_L(0); PG8_MMA(0, 0, At, B0); PG8_BAR; PG8_SCHED;
            PG8_LDB(B1, 1, 1); PG8_STAGE(PG8_SB(1, 0), b3, voffB);
            PG8_BAR; PG8_WAIT_L(0); PG8_MMA(0, 1, At, B1); PG8_BAR;
            PG8_LDA(At, 1, 1); PG8_STAGE(PG8_SA(1, 0), a3, voffA);
            PG8_BAR; PG8_WAIT_L(0); PG8_MMA(1, 0, At, B0); PG8_BAR; PG8_SCHED;
            PG8_STAGE(PG8_SB(1, 1), b3 + hstepB, voffB);
            PG8_WAIT_V(6); PG8_BAR; PG8_MMA(1, 1, At, B1); PG8_BAR;
            }
        }
        if constexpr (ALIGN_EPI) { if (wr == 0) PG8_BAR; }
        if constexpr (!Epi::AFTER_DRAIN) { E(acc, cur, wr, wc, fr, fq); }
        if (!has_next) break;
#pragma unroll
        for (int a = 0; a < 2; ++a)
#pragma unroll
            for (int b = 0; b < 2; ++b)
#pragma unroll
                for (int m = 0; m < 4; ++m)
#pragma unroll
                    for (int n = 0; n < 2; ++n) acc[a][b][m][n] = (f32x4){0.f, 0.f, 0.f, 0.f};
        cur = nxt; cA = nA; cB = nB; ++ui;
        if constexpr (ALIGN_EPI) { if (wr == 1) PG8_BAR; }
    }
    PG8_WAIT_V(0);
    if constexpr (!ALIGN_EPI) { if (wr == 0) PG8_BAR; }
    PG8_BAR;
    if constexpr (Epi::AFTER_DRAIN) { E.fused(acc, cur, wr, wc, fr, fq, lds); }
#undef PG8_SA
#undef PG8_SB
#undef PG8_STAGE
#undef PG8_LDA
#undef PG8_LDB
#undef PG8_MMA
#undef PG8_WAIT_V
#undef PG8_WAIT_L
#undef PG8_BAR
#undef PG8_SCHED
}
}
using pg8::Unit;
typedef f32x4 Acc[2][2][4][2];

struct EpiInProj {
    static constexpr bool PERM = true, AFTER_DRAIN = false, MIDK = false;
    const LAS float* rs; bf16_t *a2u, *gs, *q, *k, *gr; const float* rope;
    __device__ __forceinline__ void operator()(const Acc& acc, const Unit& u, int wr, int wc, int fr, int fq) const {
        asm volatile("" : "+v"(fr), "+v"(fq));
        const int type = u.pn >> 3, colt = (u.pn & 7) << 8, c8 = wc * 32 + 8 * fq;
#pragma unroll
        for (int ai = 0; ai < 2; ++ai)
#pragma unroll
            for (int m = 0; m < 4; ++m) {
                const int lr = wr * 64 + fr + ai * 128 + m * 16, r = u.pm * 256 + lr; const float s = rs[lr];
                f32x4 v[2][2];
#pragma unroll
                for (int bj = 0; bj < 2; ++bj)
#pragma unroll
                    for (int n = 0; n < 2; ++n) v[bj][n] = acc[ai][bj][m][n] * s;
                if (type == 0) {
#pragma unroll
                    for (int bj = 0; bj < 2; ++bj) { const int col = colt + bj * 128 + c8;
                        u32x4 w; w.x = cvt_pk_bf16(v[bj][0][0], v[bj][0][1]); w.y = cvt_pk_bf16(v[bj][0][2], v[bj][0][3]); w.z = cvt_pk_bf16(v[bj][1][0], v[bj][1][1]); w.w = cvt_pk_bf16(v[bj][1][2], v[bj][1][3]);
                        *(u32x4*)(a2u + ((size_t)((col >> 4) * 512 + (r >> 4)) * A2LD + (r & 15) * 16 + (col & 15))) = w; }
                } else if (type == 1 || type == 4) {
                    bf16_t* dst = (type == 1 ? gs : gr) + (size_t)r * 2048 + colt + c8;
#pragma unroll
                    for (int bj = 0; bj < 2; ++bj) {
                        u32x4 w; w.x = cvt_pk_bf16(silu_f(v[bj][0][0]), silu_f(v[bj][0][1])); w.y = cvt_pk_bf16(silu_f(v[bj][0][2]), silu_f(v[bj][0][3]));
                        w.z = cvt_pk_bf16(silu_f(v[bj][1][0]), silu_f(v[bj][1][1])); w.w = cvt_pk_bf16(silu_f(v[bj][1][2]), silu_f(v[bj][1][3]));
                        *(u32x4*)(dst + bj * 128) = w; }
                } else {
                    const float eh = __builtin_amdgcn_exp2f((float)(-5 - (u.pn & 7)));
                    const float lg2h = -(eh * (1.f + eh * (0.5f + eh * (0.33333334f + eh * (0.25f + eh * (0.2f + eh * 0.16666667f)))))) * 1.4426950408889634f;
                    const float sc = (type == 3) ? 0.0625f * __builtin_amdgcn_exp2f(-(float)(r & 127) * lg2h) : __builtin_amdgcn_exp2f((float)(r & 127) * lg2h);
                    const f32x4* cs = (const f32x4*)(rope + ((size_t)(r & 2047) * 128 + c8) * 2);
                    float o1[8], o2[8];
#pragma unroll
                    for (int jj = 0; jj < 4; ++jj) { const f32x4 t = cs[jj];
                        const float a0 = v[0][jj >> 1][(jj & 1) * 2], b0 = v[1][jj >> 1][(jj & 1) * 2], a1 = v[0][jj >> 1][(jj & 1) * 2 + 1], b1 = v[1][jj >> 1][(jj & 1) * 2 + 1];
                        o1[2 * jj] = (a0 * t[0] - b0 * t[1]) * sc; o2[2 * jj] = (b0 * t[0] + a0 * t[1]) * sc;
                        o1[2 * jj + 1] = (a1 * t[2] - b1 * t[3]) * sc; o2[2 * jj + 1] = (b1 * t[2] + a1 * t[3]) * sc; }
                    bf16_t* dst = (type == 2 ? q : k) + (size_t)r * 2048 + colt + c8;
                    u32x4 w; w.x = cvt_pk_bf16(o1[0], o1[1]); w.y = cvt_pk_bf16(o1[2], o1[3]); w.z = cvt_pk_bf16(o1[4], o1[5]); w.w = cvt_pk_bf16(o1[6], o1[7]);
                    *(u32x4*)dst = w;
                    w.x = cvt_pk_bf16(o2[0], o2[1]); w.y = cvt_pk_bf16(o2[2], o2[3]); w.z = cvt_pk_bf16(o2[4], o2[5]); w.w = cvt_pk_bf16(o2[6], o2[7]);
                    *(u32x4*)(dst + 128) = w;
                }
                asm volatile("" ::: "memory");
            }
    }
};
struct EpiVT {
    static constexpr bool PERM = true, AFTER_DRAIN = false, MIDK = false;
    const LAS float* rs; bf16_t* vt;
    __device__ __forceinline__ void operator()(const Acc& acc, const Unit& u, int wr, int wc, int fr, int fq) const {
        asm volatile("" : "+v"(fr), "+v"(fq));
        f32x4 sv[2][2];
#pragma unroll
        for (int bj = 0; bj < 2; ++bj)
#pragma unroll
            for (int n = 0; n < 2; ++n) sv[bj][n] = *(const LAS f32x4*)(rs + bj * 128 + wc * 32 + 8 * fq + 4 * n);
#pragma unroll
        for (int ai = 0; ai < 2; ++ai)
#pragma unroll
            for (int m = 0; m < 4; ++m) { bf16_t* dst = vt + (size_t)(u.pm * 256 + wr * 64 + fr + ai * 128 + m * 16) * MTOK + u.pn * 256 + wc * 32 + 8 * fq;
#pragma unroll
                for (int bj = 0; bj < 2; ++bj) { const f32x4 a = acc[ai][bj][m][0] * sv[bj][0], b = acc[ai][bj][m][1] * sv[bj][1];
                    u32x4 w; w.x = cvt_pk_bf16(a[0], a[1]); w.y = cvt_pk_bf16(a[2], a[3]); w.z = cvt_pk_bf16(b[0], b[1]); w.w = cvt_pk_bf16(b[2], b[3]);
                    *(u32x4*)(dst + bj * 128) = w; } }
    }
};
constexpr int SLD = 132;
struct EpiSloc {
    static constexpr bool PERM = false, AFTER_DRAIN = true, MIDK = false;
    __device__ __forceinline__ void fused(const Acc& acc, const Unit&, int wr, int wc, int fr, int fq, LAS unsigned char* lds) const {
        asm volatile("" : "+v"(fr), "+v"(fq));
        LAS float* S = (LAS float*)lds;
#pragma unroll
        for (int ai = 0; ai < 2; ++ai)
#pragma unroll
            for (int m = 0; m < 4; ++m)
#pragma unroll
                for (int n = 0; n < 2; ++n) *(LAS f32x4*)(S + (ai * 128 + wr * 64 + m * 16 + fr) * SLD + wc * 32 + n * 16 + 4 * fq) = acc[ai][0][m][n];
    }
};
struct EpiSsmOut {
    static constexpr bool PERM = true, AFTER_DRAIN = false, MIDK = false;
    const bf16_t* a2g; const float* dsk; bf16_t* yg; int g;
    __device__ __forceinline__ void operator()(const Acc& acc, const Unit& u, int wr, int wc, int fr, int fq) const {
        asm volatile("" : "+v"(fr), "+v"(fq));
        const int h0 = 8 * (fq & 1);
        const f32x4 d0 = *(const f32x4*)(dsk + h0), d1 = *(const f32x4*)(dsk + h0 + 4);
#pragma unroll
        for (int ai = 0; ai < 2; ++ai)
#pragma unroll
            for (int m = 0; m < 4; ++m) { const int row = u.pm * 256 + ai * 128 + wr * 64 + m * 16 + fr;
#pragma unroll
                for (int bj = 0; bj < 2; ++bj) { const int col = bj * 128 + wc * 32 + 8 * fq, tl = col >> 4;
                    const u32x4 uu = *(const u32x4*)(a2g + (size_t)row * A2LD + col);
                    const f32x4 a = acc[ai][bj][m][0], b = acc[ai][bj][m][1];
                    float y[8];
                    y[0] = a[0] + d0[0] * bf2f(uu.x & 0xffffu); y[1] = a[1] + d0[1] * bf2f(uu.x >> 16); y[2] = a[2] + d0[2] * bf2f(uu.y & 0xffffu); y[3] = a[3] + d0[3] * bf2f(uu.y >> 16);
                    y[4] = b[0] + d1[0] * bf2f(uu.z & 0xffffu); y[5] = b[1] + d1[1] * bf2f(uu.z >> 16); y[6] = b[2] + d1[2] * bf2f(uu.w & 0xffffu); y[7] = b[3] + d1[3] * bf2f(uu.w >> 16);
#pragma unroll
                    for (int j = 0; j < 8; ++j) y[j] = gelu_tanh_f(y[j]);
                    u32x4 w; w.x = cvt_pk_bf16(y[0], y[1]); w.y = cvt_pk_bf16(y[2], y[3]); w.z = cvt_pk_bf16(y[4], y[5]); w.w = cvt_pk_bf16(y[6], y[7]);
                    *(u32x4*)(yg + (size_t)(row * 16 + tl) * DS + g * 16 + h0) = w; }
                asm volatile("" ::: "memory"); }
    }
};
struct EpiGlu {
    static constexpr bool PERM = true, AFTER_DRAIN = false, MIDK = false;
    const bf16_t* yg; const bf16_t* gs; const float* bias; bf16_t* ycat; float* ssq2;
    __device__ __forceinline__ void operator()(const Acc& acc, const Unit& u, int wr, int wc, int fr, int fq) const {
        asm volatile("" : "+v"(fr), "+v"(fq));
        const int col0 = u.pn * 256 + wc * 32 + 8 * fq;
        f32x4 bv[2][2];
#pragma unroll
        for (int bj = 0; bj < 2; ++bj)
#pragma unroll
            for (int n = 0; n < 2; ++n) bv[bj][n] = *(const f32x4*)(bias + col0 + bj * 128 + 4 * n);
#pragma unroll
        for (int ai = 0; ai < 2; ++ai)
#pragma unroll
            for (int m = 0; m < 4; ++m) { const int r = u.pm * 256 + ai * 128 + wr * 64 + m * 16 + fr; float ss = 0.f;
#pragma unroll
                for (int bj = 0; bj < 2; ++bj) { const size_t off = (size_t)r * DS + col0 + bj * 128;
                    const u32x4 yy = *(const u32x4*)(yg + off), gg = *(const u32x4*)(gs + off);
                    const f32x4 a = acc[ai][bj][m][0] + bv[bj][0], b = acc[ai][bj][m][1] + bv[bj][1];
                    float z[8];
                    z[0] = bf2f(yy.x & 0xffffu) * sigmoid_f(a[0]); z[1] = bf2f(yy.x >> 16) * sigmoid_f(a[1]); z[2] = bf2f(yy.y & 0xffffu) * sigmoid_f(a[2]); z[3] = bf2f(yy.y >> 16) * sigmoid_f(a[3]);
                    z[4] = bf2f(yy.z & 0xffffu) * sigmoid_f(b[0]); z[5] = bf2f(yy.z >> 16) * sigmoid_f(b[1]); z[6] = bf2f(yy.w & 0xffffu) * sigmoid_f(b[2]); z[7] = bf2f(yy.w >> 16) * sigmoid_f(b[3]);
#pragma unroll
                    for (int j = 0; j < 8; ++j) ss += z[j] * z[j];
                    z[0] *= bf2f(gg.x & 0xffffu); z[1] *= bf2f(gg.x >> 16); z[2] *= bf2f(gg.y & 0xffffu); z[3] *= bf2f(gg.y >> 16);
                    z[4] *= bf2f(gg.z & 0xffffu); z[5] *= bf2f(gg.z >> 16); z[6] *= bf2f(gg.w & 0xffffu); z[7] *= bf2f(gg.w >> 16);
                    u32x4 w; w.x = cvt_pk_bf16(z[0], z[1]); w.y = cvt_pk_bf16(z[2], z[3]); w.z = cvt_pk_bf16(z[4], z[5]); w.w = cvt_pk_bf16(z[6], z[7]);
                    *(u32x4*)(ycat + (size_t)r * DM + col0 + bj * 128) = w; }
                ss = xor_add<16>(ss); ss = xor_add<32>(ss);
                if (fq == 0) ssq2[(size_t)r * 32 + u.pn * 4 + wc] = ss;
                asm volatile("" ::: "memory"); }
    }
};
template <bool RESBF> struct EpiOut {
    static constexpr bool PERM = true, AFTER_DRAIN = false, MIDK = true;
    const LAS float* rs2; const void* res; bf16_t* xo; float* ssq;
    __device__ __forceinline__ void midk(Acc& acc, int wr, int fr) const {
        asm volatile("" : "+v"(fr));
#pragma unroll
        for (int ai = 0; ai < 2; ++ai)
#pragma unroll
            for (int m = 0; m < 4; ++m) { const float s = rs2[ai * 128 + wr * 64 + m * 16 + fr];
#pragma unroll
                for (int bj = 0; bj < 2; ++bj)
#pragma unroll
                    for (int n = 0; n < 2; ++n) acc[ai][bj][m][n] *= s; }
    }
    __device__ __forceinline__ void operator()(const Acc& acc, const Unit& u, int wr, int wc, int fr, int fq) const {
        asm volatile("" : "+v"(fr), "+v"(fq));
        const int col0 = u.pn * 256 + wc * 32 + 8 * fq;
#pragma unroll
        for (int ai = 0; ai < 2; ++ai)
#pragma unroll
            for (int m = 0; m < 4; ++m) { const int r = u.pm * 256 + ai * 128 + wr * 64 + m * 16 + fr; float ss = 0.f;
#pragma unroll
                for (int bj = 0; bj < 2; ++bj) { const size_t off = (size_t)r * DM + col0 + bj * 128; f32x4 x0, x1;
                    if constexpr (RESBF) { const u32x4 rv = *(const u32x4*)((const bf16_t*)res + off);
                        x0 = (f32x4){bf2f(rv.x & 0xffffu), bf2f(rv.x >> 16), bf2f(rv.y & 0xffffu), bf2f(rv.y >> 16)}; x1 = (f32x4){bf2f(rv.z & 0xffffu), bf2f(rv.z >> 16), bf2f(rv.w & 0xffffu), bf2f(rv.w >> 16)};
                    } else { x0 = *(const f32x4*)((const float*)res + off); x1 = *(const f32x4*)((const float*)res + off + 4); }
                    x0 = x0 + acc[ai][bj][m][0]; x1 = x1 + acc[ai][bj][m][1];
                    ss += ((x0[0] * x0[0] + x0[1] * x0[1]) + (x0[2] * x0[2] + x0[3] * x0[3])) + ((x1[0] * x1[0] + x1[1] * x1[1]) + (x1[2] * x1[2] + x1[3] * x1[3]));
                    u32x4 w; w.x = cvt_pk_bf16(x0[0], x0[1]); w.y = cvt_pk_bf16(x0[2], x0[3]); w.z = cvt_pk_bf16(x1[0], x1[1]); w.w = cvt_pk_bf16(x1[2], x1[3]);
                    *(u32x4*)(xo + off) = w; }
                ss = xor_add<16>(ss); ss = xor_add<32>(ss);
                if (fq == 0) ssq[(size_t)r * 64 + u.pn * 4 + wc] = ss;
                asm volatile("" ::: "memory"); }
    }
};

struct Args { const float* in[17]; float* out; unsigned char* ws; int ph_lo, ph_hi; };
enum { I_X = 0, I_NORMW, I_WIN, I_LRE, I_LIM, I_BRE, I_BIM, I_CRE, I_CIM, I_D, I_LOGDT, I_WGLU, I_BGLU, I_SNW, I_RNW, I_WOUT, I_FNW };

typedef const __attribute__((address_space(4))) Args* ArgsP;
struct Frame {
    LAS unsigned char* lds; int tid, lane, wave, vcu, G, bid; unsigned char* ws;
};

__device__ __forceinline__ void transpose_item(const float* W, int K, int N, bf16_t* WT, const float* ks0, const float* ks1, int ksplit, int remap, int item, int lane) {
    const int nblk = N / 64, kb = item / nblk, nb = item % nblk, k0 = 64 * kb, nq = lane & 15, kq = lane >> 4; int n0 = 64 * nb;
    const float* wp = W + (size_t)(k0 + 16 * kq) * N + n0 + 4 * nq;
    f32x4 v[16];
#pragma unroll
    for (int i = 0; i < 16; ++i) v[i] = *(const f32x4*)(wp + (size_t)i * N);
    if (ks0) { const float* ks = ((k0 < ksplit) ? ks0 + k0 : ks1 + (k0 - ksplit)) + 16 * kq;
#pragma unroll
        for (int i = 0; i < 4; ++i) { const f32x4 sc = *(const f32x4*)(ks + 4 * i);
#pragma unroll
            for (int j = 0; j < 4; ++j) v[4 * i + j] = v[4 * i + j] * sc[j]; } }
    if (remap) { if (n0 >= 10240) n0 -= 2048; else if (n0 >= 8192) n0 += 2048; }
#pragma unroll
    for (int c = 0; c < 4; ++c) { bf16_t* dst = WT + (size_t)(n0 + 4 * nq + c) * K + k0 + 16 * kq;
        u32x4 o0, o1;
        o0.x = pk2(v[0][c], v[1][c]); o0.y = pk2(v[2][c], v[3][c]); o0.z = pk2(v[4][c], v[5][c]); o0.w = pk2(v[6][c], v[7][c]);
        o1.x = pk2(v[8][c], v[9][c]); o1.y = pk2(v[10][c], v[11][c]); o1.z = pk2(v[12][c], v[13][c]); o1.w = pk2(v[14][c], v[15][c]);
        *(u32x4*)dst = o0; *(u32x4*)(dst + 8) = o1; }
}

__device__ __forceinline__ void ssm_mats_item(const Frame& F, ArgsP a, int l, int g) {
    const int lg = l * NG + g, tid = F.tid;
    LAS float* apr = (LAS float*)F.lds;
    LAS float* api = apr + 17 * 64;
    LAS float* bbr = api + 17 * 64;
    LAS float* bbi = bbr + 1024;
    LAS float* crs = bbi + 1024;
    LAS float* cis = crs + 1024;
    LAS float* crt = cis + 1024;
    LAS float* cit = crt + 1024;
    LAS float* Kt = cit + 1024;
    LAS float* lrs = Kt + 4096;
    LAS float* lis = lrs + 64;
    { const float b0r = a->in[I_BRE][(size_t)lg * 1024 + tid], b1r = a->in[I_BRE][(size_t)lg * 1024 + 512 + tid], b0i = a->in[I_BIM][(size_t)lg * 1024 + tid], b1i = a->in[I_BIM][(size_t)lg * 1024 + 512 + tid];
      const float c0r = a->in[I_CRE][(size_t)lg * 1024 + tid], c1r = a->in[I_CRE][(size_t)lg * 1024 + 512 + tid], c0i = a->in[I_CIM][(size_t)lg * 1024 + tid], c1i = a->in[I_CIM][(size_t)lg * 1024 + 512 + tid];
      const float lx = (tid < 64) ? a->in[I_LRE][lg * 64 + tid] : ((tid < 128) ? a->in[I_LIM][lg * 64 + tid - 64] : 0.f);
      bbr[tid] = b0r; bbr[512 + tid] = b1r; bbi[tid] = b0i; bbi[512 + tid] = b1i;
      crs[tid] = c0r; crs[512 + tid] = c1r; cis[tid] = c0i; cis[512 + tid] = c1i;
      { const int hp0 = tid >> 6, n0 = tid & 63; crt[n0 * 16 + hp0] = c0r; crt[n0 * 16 + hp0 + 8] = c1r; cit[n0 * 16 + hp0] = c0i; cit[n0 * 16 + hp0 + 8] = c1i; }
      if (tid < 128) lrs[tid] = lx; }
    const float dtf = expf(a->in[I_LOGDT][lg]);
    __syncthreads();
    for (int e = tid; e < 17 * 64; e += 512) { const int tau = e >> 6, n = e & 63; const float lr = lrs[n], li = lis[n];
        float c, s; cis_d((double)li * (double)dtf * tau, c, s); const float mag = expf(lr * dtf * (float)tau); apr[e] = mag * c; api[e] = mag * s; }
    __syncthreads();
#pragma unroll
    for (int k = 0; k < 2; ++k) { const int e = tid + 512 * k, n = e >> 4; const float lr = lrs[n], li = lis[n];
        const float nr = apr[64 + n] - 1.f, ni = api[64 + n], den = lr * lr + li * li, cor = (nr * lr + ni * li) / den, coi = (ni * lr - nr * li) / den;
        const float br = bbr[e], bi = bbi[e];
        bbr[e] = cor * br - coi * bi; bbi[e] = cor * bi + coi * br; }
    if (tid < 64) ((float2*)(F.ws + WS_A16))[lg * 64 + tid] = make_float2(apr[16 * 64 + tid], api[16 * 64 + tid]);
    __syncthreads();
    { const int tau = tid >> 5, hp = (tid >> 1) & 15, h0 = (tid & 1) * 8; float sum[8];
#pragma unroll
      for (int j = 0; j < 8; ++j) sum[j] = 0.f;
#pragma unroll 4
      for (int n = 0; n < 64; ++n) { const float cr = crt[n * 16 + hp], ci = cit[n * 16 + hp], ar = apr[tau * 64 + n], ai = api[tau * 64 + n], pr = cr * ar - ci * ai, pi = cr * ai + ci * ar;
          const f32x4 b0 = *(const LAS f32x4*)(bbr + n * 16 + h0), b1 = *(const LAS f32x4*)(bbr + n * 16 + h0 + 4), d0 = *(const LAS f32x4*)(bbi + n * 16 + h0), d1 = *(const LAS f32x4*)(bbi + n * 16 + h0 + 4);
#pragma unroll
          for (int j = 0; j < 4; ++j) { sum[j] += pr * b0[j] - pi * d0[j]; sum[4 + j] += pr * b1[j] - pi * d1[j]; } }
#pragma unroll
      for (int j = 0; j < 8; ++j) Kt[(tau << 8) + (hp << 4) + h0 + j] = sum[j]; }
    __syncthreads();
    bf16_t* bt2 = (bf16_t*)(F.ws + WS_BT2) + (size_t)lg * 256 * A2LD;
#pragma unroll 2
    for (int e = tid; e < 256 * A2LD / 8; e += 512) { const int row = e / 48, c0 = (e % 48) * 8, t = row >> 4, hp = row & 15; float v[8];
        if (c0 < 256) { const int j = c0 >> 4, h0 = c0 & 15;
#pragma unroll
            for (int i = 0; i < 8; ++i) v[i] = (t >= j) ? Kt[((t - j) << 8) + (hp << 4) + h0 + i] : 0.f;
        } else { const int nn = c0 - 256;
#pragma unroll
            for (int i = 0; i < 8; ++i) { const int n = (nn + i) & 63; const float cr = crs[hp * 64 + n], ci = cis[hp * 64 + n], ar = apr[(t + 1) * 64 + n], ai = api[(t + 1) * 64 + n];
                v[i] = (nn < 64) ? (cr * ar - ci * ai) : -(cr * ai + ci * ar); } }
        u32x4 w; w.x = pk2(v[0], v[1]); w.y = pk2(v[2], v[3]); w.z = pk2(v[4], v[5]); w.w = pk2(v[6], v[7]);
        *(u32x4*)(bt2 + (size_t)row * A2LD + c0) = w; }
    bf16_t* pm = (bf16_t*)(F.ws + WS_PM) + (size_t)lg * 256 * 256;
#pragma unroll 2
    for (int e = tid; e < 256 * 256 / 8; e += 512) { const int row = e >> 5, c0 = (e & 31) * 8; float v[8];
        if (row < 128) { const int n = row & 63, im = row >> 6, j = c0 >> 4, h0 = c0 & 15; const float ar = apr[(15 - j) * 64 + n], ai = api[(15 - j) * 64 + n];
#pragma unroll
            for (int i = 0; i < 8; ++i) { const float br = bbr[n * 16 + h0 + i], bi = bbi[n * 16 + h0 + i]; v[i] = im ? (ar * bi + ai * br) : (ar * br - ai * bi); }
        } else {
#pragma unroll
            for (int i = 0; i < 8; ++i) v[i] = 0.f; }
        u32x4 w; w.x = pk2(v[0], v[1]); w.y = pk2(v[2], v[3]); w.z = pk2(v[4], v[5]); w.w = pk2(v[6], v[7]);
        *(u32x4*)(pm + (size_t)row * 256 + c0) = w; }
    __syncthreads();
}

__device__ __forceinline__ void p0_prologue(const Frame& F, ArgsP a, int parts = 7) {
    if (parts & 1) for (int it = F.vcu; it < DEPTH * NG; it += F.G) ssm_mats_item(F, a, it / NG, it % NG);
    if (parts & 2) { float2* rope = (float2*)(F.ws + WS_ROPE);
      for (int e = F.vcu * 512 + F.tid; e < SEQ * 128; e += F.G * 512) { const int pos = e >> 7, i = e & 127;
          const double inv = (double)expf(-(float)(2 * i) * (9.210340371976184f / 256.0f)); float c, s; cis_d((double)pos * inv, c, s); rope[e] = make_float2(c, s); } }
    const int gw = F.vcu * 8 + F.wave, NGW = F.G * 8;
    if (parts & 2) for (int m = gw; m < MTOK; m += NGW) {
        const f32x4* xr = (const f32x4*)(a->in[I_X] + (size_t)m * DM) + F.lane; float ss = 0.f; f32x4 v[16];
#pragma unroll
        for (int j = 0; j < 16; ++j) { v[j] = xr[64 * j]; ss += (v[j][0] * v[j][0] + v[j][1] * v[j][1]) + (v[j][2] * v[j][2] + v[j][3] * v[j][3]); }
        ss = wave_sum(ss);
        u32x2* o = (u32x2*)((bf16_t*)(F.ws + WS_XB) + (size_t)m * DM) + F.lane;
#pragma unroll
        for (int j = 0; j < 16; ++j) { u32x2 w; w.x = pk2(v[j][0], v[j][1]); w.y = pk2(v[j][2], v[j][3]); o[64 * j] = w; }
        ((float*)(F.ws + WS_SSQX))[(size_t)m * 64 + F.lane] = (F.lane == 0) ? ss : 0.f;
    }
    constexpr int I_IN = (DM / 64) * (NPROJ / 64), I_GLU = (DS / 64) * (DS / 64), I_OUT = (DM / 64) * (DM / 64), I_L = I_IN + I_GLU + I_OUT;
    if (parts & 4) for (int it = gw; it < DEPTH * I_L; it += NGW) {
        const int l = it / I_L; int r = it % I_L;
        if (r < I_IN) { transpose_item(a->in[I_WIN] + (size_t)l * DM * NPROJ, DM, NPROJ, (bf16_t*)(F.ws + WS_WTIN) + (size_t)l * NPROJ * DM, a->in[I_NORMW] + l * DM, a->in[I_NORMW] + l * DM, 1 << 30, 1, r, F.lane); continue; } r -= I_IN;
        if (r < I_GLU) { transpose_item(a->in[I_WGLU] + (size_t)l * DS * DS, DS, DS, (bf16_t*)(F.ws + WS_WTGLU) + (size_t)l * DS * DS, nullptr, nullptr, 1 << 30, 0, r, F.lane); continue; } r -= I_GLU;
        transpose_item(a->in[I_WOUT] + (size_t)l * DM * DM, DM, DM, (bf16_t*)(F.ws + WS_WTOUT) + (size_t)l * DM * DM, a->in[I_SNW] + l * DS, a->in[I_RNW] + l * DR, DS, 0, r, F.lane);
    }
}

__device__ __forceinline__ void stash_rstd(const Frame& F, const float* slots, int nslot, int panel, float inv_dim) {
    __syncthreads();
    if (F.tid < 256) { const f32x4* p = (const f32x4*)(slots + (size_t)(panel * 256 + F.tid) * nslot); float s = 0.f;
        for (int j = 0; j < nslot / 4; ++j) { const f32x4 t = p[j]; s += (t[0] + t[1]) + (t[2] + t[3]); }
        ((LAS float*)(F.lds + STASH_OFF))[F.tid] = __builtin_amdgcn_rsqf(s * inv_dim + EPS); }
    __syncthreads();
}

__device__ __forceinline__ void p1_inproj(const Frame& F, int l) {
    const bf16_t* xb = (const bf16_t*)(F.ws + WS_XB); const bf16_t* wt = (const bf16_t*)(F.ws + WS_WTIN) + (size_t)l * NPROJ * DM;
    const LAS float* rs = (const LAS float*)(F.lds + STASH_OFF);
    { pg8::StaticOrder S; S.init(MTOK, 10240, F.G, F.bid); Unit u0; S.next(0, u0);
      stash_rstd(F, (const float*)(F.ws + WS_SSQX), 64, u0.pm, 1.f / DM);
      pg8::Gemm g{xb, wt, DM, DM, DM, -1};
      EpiInProj E{rs, (bf16_t*)(F.ws + WS_A2U), (bf16_t*)(F.ws + WS_GS), (bf16_t*)(F.ws + WS_Q), (bf16_t*)(F.ws + WS_K), (bf16_t*)(F.ws + WS_GR), (const float*)(F.ws + WS_ROPE)};
      pg8::gemm_phase<EpiInProj, pg8::StaticOrder, true, true>(F.lds, g, S, E, F.tid); }
    { pg8::StaticOrder S; S.init(DR, MTOK, F.G, F.bid); Unit u0; S.next(0, u0);
      stash_rstd(F, (const float*)(F.ws + WS_SSQX), 64, u0.pn, 1.f / DM);
      pg8::Gemm g{wt + (size_t)10240 * DM, xb, DM, DM, DM, -1};
      EpiVT E{rs, (bf16_t*)(F.ws + WS_VT)};
      pg8::gemm_phase<EpiVT, pg8::StaticOrder, true, true>(F.lds, g, S, E, F.tid); }
}

__device__ __forceinline__ void p2_ssm(const Frame& F, ArgsP a, int l) {
    for (int it = F.vcu; it < NG * 2; it += F.G) {
        const int g = it >> 1, bp = it & 1, lg = l * NG + g;
        bf16_t* a2g = (bf16_t*)(F.ws + WS_A2U) + (size_t)g * 512 * A2LD;
        { pg8::Gemm g1{a2g, (const bf16_t*)(F.ws + WS_PM) + (size_t)lg * 256 * 256, 256, A2LD, 256, -1}; pg8::OneUnit S{bp, 0}; EpiSloc E{};
          pg8::gemm_phase<EpiSloc, pg8::OneUnit, false, true>(F.lds, g1, S, E, F.tid); }
        LDS_WAIT(); __syncthreads();
        int t2 = F.tid; asm volatile("" : "+v"(t2));
        if (t2 < 128) {
            const int bb = t2 >> 6, n = t2 & 63; const float2 a16 = ((const float2*)(F.ws + WS_A16))[lg * 64 + n];
            const LAS float* S = (const LAS float*)F.lds + (bb * 128) * SLD; bf16_t* dst = a2g + (size_t)(bp * 256 + bb * 128) * A2LD + 256 + n;
            float sr = 0.f, si = 0.f;
#pragma unroll 8
            for (int c = 0; c < 128; ++c) { dst[(size_t)c * A2LD] = (bf16_t)f2bf(sr); dst[(size_t)c * A2LD + 64] = (bf16_t)f2bf(si);
                const float lr = S[c * SLD + n], li = S[c * SLD + 64 + n]; const float nr = a16.x * sr - a16.y * si + lr, ni = a16.x * si + a16.y * sr + li; sr = nr; si = ni; }
        }
        VM_WAIT(); __syncthreads();
        if (F.tid == 0) { __builtin_amdgcn_fence(__ATOMIC_ACQUIRE, "agent"); VM_WAIT(); }
        __syncthreads();
        { pg8::Gemm g2{a2g, (const bf16_t*)(F.ws + WS_BT2) + (size_t)lg * 256 * A2LD, A2LD, A2LD, A2LD, -1}; pg8::OneUnit S{bp, 0};
          EpiSsmOut E{a2g, a->in[I_D] + (size_t)l * DS + g * 16, (bf16_t*)(F.ws + WS_YG), g};
          pg8::gemm_phase<EpiSsmOut, pg8::OneUnit, false, true>(F.lds, g2, S, E, F.tid); }
        __syncthreads();
    }
}


typedef float f32x16 __attribute__((ext_vector_type(16)));
constexpr int RT_K0 = 0, RT_V0 = 65536, RT_P = 131072, RT_RED = 147456, RT_OLD = 528;
#define RT_BAR() do { asm volatile("s_waitcnt lgkmcnt(0)" ::: "memory"); __builtin_amdgcn_s_barrier(); asm volatile("" ::: "memory"); } while (0)
__device__ __forceinline__ void p2_ret(const Frame& F) {
    int t_ = F.tid; asm volatile("" : "+v"(t_));
    const int tid = t_, lane = tid & 63, w = __builtin_amdgcn_readfirstlane(tid >> 6), wr = w & 3, wc = w >> 2, l31 = lane & 31, hh = lane >> 5;
    LAS unsigned char* lds = F.lds;
    const bf16_t* qg = (const bf16_t*)(F.ws + WS_Q); const bf16_t* kg = (const bf16_t*)(F.ws + WS_K); const bf16_t* vtg = (const bf16_t*)(F.ws + WS_VT);
    const bf16_t* grg = (const bf16_t*)(F.ws + WS_GR); bf16_t* ycat = (bf16_t*)(F.ws + WS_YCAT);
    const unsigned koff = (unsigned)((2 * w + hh) * 4096 + ((l31 ^ ((2 * w + hh) & 15)) << 4));
    const unsigned voff = (unsigned)((8 * w + (lane >> 3)) * 16384 + (((lane & 7) ^ (((lane >> 4) + 4 * w) & 7)) << 4));
    for (int it = F.vcu; it < BATCH * RH * 8; it += F.G) {
        const int bh = it >> 3, p = it & 7, b = bh >> 3, h = bh & 7;
        const float e = __builtin_amdgcn_exp2f((float)(-5 - h));
        const float lg2 = -(e * (1.f + e * (0.5f + e * (0.33333334f + e * (0.25f + e * (0.2f + e * 0.16666667f)))))) * 1.4426950408889634f;
        for (int uu = 0; uu < 2; ++uu) {
            const int qi = uu ? p : 15 - p, ntile = 2 * (qi + 1);
            const size_t tokq = (size_t)b * SEQ + qi * 128;
            bf16x8 qf[16];
            { const bf16_t* qp = qg + (tokq + wr * 32 + l31) * DR + h * 256 + 8 * hh;
#pragma unroll
              for (int s = 0; s < 16; ++s) qf[s] = *(const bf16x8*)(qp + 16 * s); }
            f32x16 oacc[4];
#pragma unroll
            for (int db = 0; db < 4; ++db)
#pragma unroll
                for (int r = 0; r < 16; ++r) oacc[db][r] = 0.f;
#define RT_DMA(kt_, bf_) do { const char* kb_ = (const char*)(kg + ((size_t)(b * SEQ + (kt_) * 64) * DR + h * 256)) + koff; const char* vb_ = (const char*)(vtg + ((size_t)(h * 256) * MTOK + b * SEQ + (kt_) * 64)) + voff; \
            _Pragma("unroll") for (int i_ = 0; i_ < 4; ++i_) __builtin_amdgcn_global_load_lds((const unsigned*)(kb_ + i_ * 65536), (LAS unsigned*)(lds + RT_K0 + (bf_) * 32768 + (w + 8 * i_) * 1024), 16, 0, 0); \
            _Pragma("unroll") for (int i_ = 0; i_ < 4; ++i_) __builtin_amdgcn_global_load_lds((const unsigned*)(vb_ + i_ * 1048576), (LAS unsigned*)(lds + RT_V0 + (bf_) * 32768 + (w + 8 * i_) * 1024), 16, 0, 0); } while (0)
            RT_DMA(0, 0);
            asm volatile("s_waitcnt vmcnt(0)" ::: "memory"); RT_BAR();
            for (int kt = 0; kt < ntile; ++kt) {
                const int bf = kt & 1;
                if (kt + 1 < ntile) RT_DMA(kt + 1, bf ^ 1);
                int lo_ = lane; asm volatile("" : "+v"(lo_));
                const int l31 = lo_ & 31, hh = lo_ >> 5, x15 = l31 & 15, m4 = ((l31 >> 1) & 7) << 4, lane = lo_;
                f32x16 st;
#pragma unroll
                for (int r = 0; r < 16; ++r) st[r] = 0.f;
                { const LAS unsigned char* kb = lds + RT_K0 + bf * 32768 + (32 * wc + l31) * 512;
#define RT_KRD(dst, s0) do { _Pragma("unroll") for (int j_ = 0; j_ < 4; ++j_) dst[j_] = *(const LAS bf16x8*)(kb + ((((2 * ((s0) + j_)) | hh) ^ x15) << 4)); } while (0)
#define RT_KMM(src, s0) do { _Pragma("unroll") for (int j_ = 0; j_ < 4; ++j_) st = __builtin_amdgcn_mfma_f32_32x32x16_bf16(src[j_], qf[(s0) + j_], st, 0, 0, 0); } while (0)
                  bf16x8 ka[4], kc[4];
                  RT_KRD(ka, 0); __builtin_amdgcn_sched_barrier(0);
                  RT_KRD(kc, 4); RT_KMM(ka, 0); __builtin_amdgcn_sched_barrier(0);
                  RT_KRD(ka, 8); RT_KMM(kc, 4); __builtin_amdgcn_sched_barrier(0);
                  RT_KRD(kc, 12); RT_KMM(ka, 8); __builtin_amdgcn_sched_barrier(0);
                  RT_KMM(kc, 12); __builtin_amdgcn_sched_barrier(0);
#undef RT_KRD
#undef RT_KMM
                }
                { const bool diag = kt >= 2 * qi;
                  unsigned pk[8];
                  if (!diag) { const float tf = __builtin_amdgcn_exp2f((float)(128 * (qi - (kt >> 1))) * lg2);
#pragma unroll
                      for (int i = 0; i < 8; ++i) pk[i] = cvt_pk_bf16(st[2 * i] * tf, st[2 * i + 1] * tf);
                  } else { const int lim = wr * 32 + l31 + (2 * qi - kt) * 64 - 32 * wc - 4 * hh;
#pragma unroll
                      for (int i = 0; i < 8; ++i) { const int r0 = 2 * i, r1 = 2 * i + 1, o0 = (r0 & 3) + 8 * (r0 >> 2), o1 = (r1 & 3) + 8 * (r1 >> 2);
                          pk[i] = cvt_pk_bf16((o0 <= lim) ? st[r0] : 0.f, (o1 <= lim) ? st[r1] : 0.f); } }
                  LAS unsigned char* pw = lds + RT_P + ((wr * 2 + wc) * 2) * 1024 + lane * 16;
                  *(LAS u32x4*)pw = (u32x4){pk[0], pk[1], pk[2], pk[3]}; *(LAS u32x4*)(pw + 1024) = (u32x4){pk[4], pk[5], pk[6], pk[7]}; }
                RT_BAR();
                { bf16x8 pf[2][2];
#pragma unroll
                  for (int kb2 = 0; kb2 < 2; ++kb2)
#pragma unroll
                      for (int s = 0; s < 2; ++s) pf[kb2][s] = *(const LAS bf16x8*)(lds + RT_P + ((wr * 2 + kb2) * 2 + s) * 1024 + lane * 16);
                  const LAS unsigned char* vb = lds + RT_V0 + bf * 32768 + (128 * wc + l31) * 128 + 8 * hh;
#define RT_VRD(dst, db) do { _Pragma("unroll") for (int j_ = 0; j_ < 4; ++j_) { const int v_ = 4 * (j_ >> 1) + 2 * (j_ & 1); \
                      const u32x2 lo_ = *(const LAS u32x2*)(vb + (db) * 4096 + ((v_ << 4) ^ m4)), hi_ = *(const LAS u32x2*)(vb + (db) * 4096 + (((v_ + 1) << 4) ^ m4)); \
                      dst[j_] = (u32x4){lo_.x, lo_.y, hi_.x, hi_.y}; } } while (0)
#define RT_VMM(src, db) do { _Pragma("unroll") for (int j_ = 0; j_ < 4; ++j_) oacc[db] = __builtin_amdgcn_mfma_f32_32x32x16_bf16(pf[j_ >> 1][j_ & 1], __builtin_bit_cast(bf16x8, src[j_]), oacc[db], 0, 0, 0); } while (0)
                  u32x4 va[4], vc[4];
                  RT_VRD(va, 0); __builtin_amdgcn_sched_barrier(0);
                  RT_VRD(vc, 1); RT_VMM(va, 0); __builtin_amdgcn_sched_barrier(0);
                  RT_VRD(va, 2); RT_VMM(vc, 1); __builtin_amdgcn_sched_barrier(0);
                  RT_VRD(vc, 3); RT_VMM(va, 2); __builtin_amdgcn_sched_barrier(0);
                  RT_VMM(vc, 3); __builtin_amdgcn_sched_barrier(0);
#undef RT_VRD
#undef RT_VMM
                }
                asm volatile("s_waitcnt vmcnt(0)" ::: "memory"); RT_BAR();
            }
            int le_ = tid; asm volatile("" : "+v"(le_));
            const int tide = le_, l31e = le_ & 31, hhe = (le_ >> 5) & 1;
            float ssr[16];
#pragma unroll
            for (int r = 0; r < 16; ++r) { float s2 = 0.f;
#pragma unroll
                for (int db = 0; db < 4; ++db) { const float o = oacc[db][r]; s2 += o * o; }
                s2 = xor_add<1>(s2); s2 = xor_add<2>(s2); s2 = xor_add<4>(s2); s2 = xor_add<8>(s2); s2 = xor_add<16>(s2); ssr[r] = s2; }
            if (l31e == 0) {
#pragma unroll
                for (int i = 0; i < 4; ++i) *(LAS f32x4*)(lds + RT_RED + w * 128 + hhe * 64 + i * 16) = (f32x4){ssr[4 * i], ssr[4 * i + 1], ssr[4 * i + 2], ssr[4 * i + 3]}; }
            RT_BAR();
#pragma unroll
            for (int i = 0; i < 4; ++i) { const f32x4 t = *(const LAS f32x4*)(lds + RT_RED + (w ^ 4) * 128 + hhe * 64 + i * 16);
#pragma unroll
                for (int j = 0; j < 4; ++j) ssr[4 * i + j] = __builtin_amdgcn_rsqf((ssr[4 * i + j] + t[j]) * (1.f / 256.f) + EPS); }
#pragma unroll
            for (int r = 0; r < 16; ++r) { LAS unsigned char* ow = lds + (wr * 32 + 4 * hhe + (r & 3) + 8 * (r >> 2)) * RT_OLD + (128 * wc + l31e) * 2;
#pragma unroll
                for (int db = 0; db < 4; ++db) *(LAS unsigned short*)(ow + db * 64) = (unsigned short)f2bf(oacc[db][r] * ssr[r]); }
            RT_BAR();
#pragma unroll
            for (int i = 0; i < 8; ++i) { const int idx = i * 512 + tide, row = idx >> 5, ch = idx & 31; const size_t tok = tokq + row;
                const u32x4 o = *(const LAS u32x4*)(lds + row * RT_OLD + ch * 16), gv = *(const u32x4*)(grg + tok * DR + h * 256 + ch * 8);
                u32x4 y;
                y.x = cvt_pk_bf16(bf2f(o.x & 0xffffu) * bf2f(gv.x & 0xffffu), bf2f(o.x >> 16) * bf2f(gv.x >> 16)); y.y = cvt_pk_bf16(bf2f(o.y & 0xffffu) * bf2f(gv.y & 0xffffu), bf2f(o.y >> 16) * bf2f(gv.y >> 16));
                y.z = cvt_pk_bf16(bf2f(o.z & 0xffffu) * bf2f(gv.z & 0xffffu), bf2f(o.z >> 16) * bf2f(gv.z >> 16)); y.w = cvt_pk_bf16(bf2f(o.w & 0xffffu) * bf2f(gv.w & 0xffffu), bf2f(o.w >> 16) * bf2f(gv.w >> 16));
                *(u32x4*)(ycat + tok * DM + DS + h * 256 + ch * 8) = y; }
            asm volatile("s_waitcnt vmcnt(0)" ::: "memory"); RT_BAR();
#undef RT_DMA
        }
    }
}

__device__ __forceinline__ void p3_glu(const Frame& F, ArgsP a, int l) {
    pg8::StaticOrder S; S.init(MTOK, DS, F.G, F.bid);
    pg8::Gemm g{(const bf16_t*)(F.ws + WS_YG), (const bf16_t*)(F.ws + WS_WTGLU) + (size_t)l * DS * DS, DS, DS, DS, -1};
    EpiGlu E{(const bf16_t*)(F.ws + WS_YG), (const bf16_t*)(F.ws + WS_GS), a->in[I_BGLU] + (size_t)l * DS, (bf16_t*)(F.ws + WS_YCAT), (float*)(F.ws + WS_SSQ2)};
    pg8::gemm_phase<EpiGlu, pg8::StaticOrder, true, true>(F.lds, g, S, E, F.tid);
}

__device__ __forceinline__ void p4_out(const Frame& F, ArgsP a, int l) {
    pg8::StaticOrder S; S.init(MTOK, DM, F.G, F.bid); Unit u0; S.next(0, u0);
    stash_rstd(F, (const float*)(F.ws + WS_SSQ2), 32, u0.pm, 1.f / DS);
    pg8::Gemm g{(const bf16_t*)(F.ws + WS_YCAT), (const bf16_t*)(F.ws + WS_WTOUT) + (size_t)l * DM * DM, DM, DM, DM, DS / 64};
    if (l == 0) { EpiOut<false> E{(const LAS float*)(F.lds + STASH_OFF), a->in[I_X], (bf16_t*)(F.ws + WS_XB), (float*)(F.ws + WS_SSQX)};
        pg8::gemm_phase<EpiOut<false>, pg8::StaticOrder, true, true>(F.lds, g, S, E, F.tid); }
    else { EpiOut<true> E{(const LAS float*)(F.lds + STASH_OFF), (const void*)(F.ws + WS_XB), (bf16_t*)(F.ws + WS_XB), (float*)(F.ws + WS_SSQX)};
        pg8::gemm_phase<EpiOut<true>, pg8::StaticOrder, true, true>(F.lds, g, S, E, F.tid); }
}

__device__ __forceinline__ void p5_final(const Frame& F, ArgsP a) {
    const int gw = F.vcu * 8 + F.wave, NGW = F.G * 8; const f32x4* fw = (const f32x4*)a->in[I_FNW];
    for (int m = gw; m < MTOK; m += NGW) {
        const float s = wave_sum(((const float*)(F.ws + WS_SSQX))[(size_t)m * 64 + F.lane]); const float rstd = __builtin_amdgcn_rsqf(s * (1.f / DM) + EPS);
        const u32x4* xr = (const u32x4*)((const bf16_t*)(F.ws + WS_XB) + (size_t)m * DM) + F.lane; f32x4* orow = (f32x4*)(a->out + (size_t)m * DM);
#pragma unroll
        for (int j = 0; j < 8; ++j) { const u32x4 v = xr[64 * j]; const int c4 = (64 * j + F.lane) * 2;
            const f32x4 w0 = fw[c4], w1 = fw[c4 + 1];
            orow[c4] = (f32x4){bf2f(v.x & 0xffffu), bf2f(v.x >> 16), bf2f(v.y & 0xffffu), bf2f(v.y >> 16)} * rstd * w0;
            orow[c4 + 1] = (f32x4){bf2f(v.z & 0xffffu), bf2f(v.z >> 16), bf2f(v.w & 0xffffu), bf2f(v.w >> 16)} * rstd * w1; }
    }
}

constexpr int NPH = 2 + 4 * DEPTH;
__global__ void __launch_bounds__(512, 2) mk_fwd(Args args) {
    extern __shared__ __attribute__((aligned(16))) unsigned char lds_raw[];
    cg::grid_group grid = cg::this_grid();
    Frame F; F.lds = (LAS unsigned char*)lds_raw; F.G = gridDim.x;
    const int wave0 = __builtin_amdgcn_readfirstlane((int)threadIdx.x >> 6);
    for (int ph = args.ph_lo; ph < args.ph_hi; ++ph) {
        ArgsP ap = (ArgsP)__builtin_amdgcn_kernarg_segment_ptr(); asm volatile("" : "+s"(ap));
        { unsigned m_ = ~0u; asm volatile("" : "+s"(m_)); int t_ = wave0 * 64 + (int)__builtin_amdgcn_mbcnt_hi(m_, __builtin_amdgcn_mbcnt_lo(m_, 0u)); asm volatile("" : "+v"(t_)); F.tid = t_; F.lane = t_ & 63; F.wave = wave0;
          int b_ = blockIdx.x; asm volatile("" : "+s"(b_)); F.bid = b_; F.vcu = (F.G % 8 == 0) ? (b_ % 8) * (F.G / 8) + b_ / 8 : b_;
          size_t z_ = 0; asm volatile("" : "+s"(z_)); F.ws = ap->ws + z_; }
#ifndef PHMASK
#define PHMASK 127
#endif
        if (ph == 0) { if (PHMASK & 1) p0_prologue(F, ap); }
        else if (ph == NPH - 1) { if (PHMASK & 32) p5_final(F, ap); }
        else { const int l = (ph - 1) >> 2, s = (ph - 1) & 3;
            if (s == 0) { if (PHMASK & 2) p1_inproj(F, l); }
            else if (s == 1) {
#if FAST_SSM
                if (PHMASK & 4) p2_ssm(F, ap, l);
#endif
#if FAST_RET
                if (PHMASK & 64) p2_ret(F);
#endif
            }
            else if (s == 2) { if (PHMASK & 8) p3_glu(F, ap, l); }
            else { if (PHMASK & 16) p4_out(F, ap, l); } }
#ifdef REPEAT_MASK
        __syncthreads();
        { const int s2 = (ph - 1) & 3, l2 = (ph - 1) >> 2;
          if (ph == 0) { if (REPEAT_MASK & 1) p0_prologue(F, ap); if (REPEAT_MASK >> 8) p0_prologue(F, ap, REPEAT_MASK >> 8); }
          else if (ph < NPH - 1) {
            if (s2 == 0 && (REPEAT_MASK & 2)) p1_inproj(F, l2);
            if (s2 == 1 && (REPEAT_MASK & 4)) p2_ssm(F, ap, l2);
            if (s2 == 1 && (REPEAT_MASK & 64)) p2_ret(F);
            if (s2 == 2 && (REPEAT_MASK & 8)) p3_glu(F, ap, l2);
            if (s2 == 3 && (REPEAT_MASK & 16)) p4_out(F, ap, l2); } }
#endif
        if (ph + 1 < args.ph_hi) grid.sync();
    }
}

__global__ void __launch_bounds__(64) naive_ssm(Args args, int l) {
    const int b = blockIdx.x >> 7, g = blockIdx.x & 127, lg = l * NG + g, n = threadIdx.x;
    const double dt = (double)expf(args.in[I_LOGDT][lg]);
    const float lr = args.in[I_LRE][lg * 64 + n], li = args.in[I_LIM][lg * 64 + n];
    float ac, as; cis_d((double)li * dt, ac, as); const float mag = expf(lr * (float)dt); const float ar = mag * ac, ai = mag * as;
    const float nr = ar - 1.f, ni = ai, den = lr * lr + li * li, cor = (nr * lr + ni * li) / den, coi = (ni * lr - nr * li) / den;
    float bbr[16], bbi[16], cr[16], ci[16];
#pragma unroll
    for (int h = 0; h < 16; ++h) { const float br = args.in[I_BRE][(size_t)(lg * 64 + n) * 16 + h], bi = args.in[I_BIM][(size_t)(lg * 64 + n) * 16 + h];
        bbr[h] = cor * br - coi * bi; bbi[h] = cor * bi + coi * br; cr[h] = args.in[I_CRE][(size_t)(lg * 16 + h) * 64 + n]; ci[h] = args.in[I_CIM][(size_t)(lg * 16 + h) * 64 + n]; }
    const float dsk = args.in[I_D][(size_t)l * DS + g * 16 + (n & 15)];
    const bf16_t* a2g = (const bf16_t*)(args.ws + WS_A2U) + (size_t)g * 512 * A2LD; bf16_t* yg = (bf16_t*)(args.ws + WS_YG);
    float sr = 0.f, si = 0.f;
    for (int t = 0; t < SEQ; ++t) {
        const u32x4* up = (const u32x4*)(a2g + (size_t)(b * 128 + (t >> 4)) * A2LD + (t & 15) * 16); const u32x4 u0 = up[0], u1 = up[1];
        float uv[16];
        uv[0] = bf2f(u0.x & 0xffffu); uv[1] = bf2f(u0.x >> 16); uv[2] = bf2f(u0.y & 0xffffu); uv[3] = bf2f(u0.y >> 16); uv[4] = bf2f(u0.z & 0xffffu); uv[5] = bf2f(u0.z >> 16); uv[6] = bf2f(u0.w & 0xffffu); uv[7] = bf2f(u0.w >> 16);
        uv[8] = bf2f(u1.x & 0xffffu); uv[9] = bf2f(u1.x >> 16); uv[10] = bf2f(u1.y & 0xffffu); uv[11] = bf2f(u1.y >> 16); uv[12] = bf2f(u1.z & 0xffffu); uv[13] = bf2f(u1.z >> 16); uv[14] = bf2f(u1.w & 0xffffu); uv[15] = bf2f(u1.w >> 16);
        float bur = 0.f, bui = 0.f;
#pragma unroll
        for (int h = 0; h < 16; ++h) { bur += bbr[h] * uv[h]; bui += bbi[h] * uv[h]; }
        const float nsr = ar * sr - ai * si + bur, nsi = ar * si + ai * sr + bui; sr = nsr; si = nsi;
        float y = 0.f, um = 0.f;
#pragma unroll
        for (int h = 0; h < 16; ++h) { const float p = wave_sum(cr[h] * sr - ci[h] * si); if (n == h) { y = p; um = uv[h]; } }
        if (n < 16) yg[(size_t)(b * SEQ + t) * DS + g * 16 + n] = (bf16_t)f2bf(gelu_tanh_f(y + dsk * um));
    }
}

constexpr int NR_KLD = 264;
__global__ void __launch_bounds__(256) naive_ret(Args args, int l) {
    extern __shared__ __attribute__((aligned(16))) unsigned char sm[];
    bf16_t* Qs = (bf16_t*)sm;
    bf16_t* Ks = Qs + 32 * 256;
    float* Ss = (float*)(Ks + 64 * NR_KLD);
    float* red = Ss + 32 * 64;
    const int qt = blockIdx.x & 63, h = (blockIdx.x >> 6) & 7, b = blockIdx.x >> 9, tid = threadIdx.x, lane = tid & 63, wv = tid >> 6;
    const bf16_t* q = (const bf16_t*)(args.ws + WS_Q); const bf16_t* k = (const bf16_t*)(args.ws + WS_K); const bf16_t* vt = (const bf16_t*)(args.ws + WS_VT); const bf16_t* gr = (const bf16_t*)(args.ws + WS_GR);
    const int tok0 = b * SEQ + qt * 32;
    for (int e = tid; e < 32 * 32; e += 256) { const int r = e >> 5, c = (e & 31) * 8; *(u32x4*)(Qs + r * 256 + c) = *(const u32x4*)(q + (size_t)(tok0 + r) * DR + h * 256 + c); }
    const float lg2 = log2f(1.f - exp2f(-5.f - (float)h));
    float o[32];
#pragma unroll
    for (int r = 0; r < 32; ++r) o[r] = 0.f;
    const int ntile = qt / 2 + 1;
    for (int kt = 0; kt < ntile; ++kt) {
        __syncthreads();
        for (int e = tid; e < 64 * 32; e += 256) { const int r = e >> 5, c = (e & 31) * 8; *(u32x4*)(Ks + r * NR_KLD + c) = *(const u32x4*)(k + (size_t)(b * SEQ + kt * 64 + r) * DR + h * 256 + c); }
        __syncthreads();
        { const int key = lane, rg = wv; float acc[8];
#pragma unroll
          for (int r = 0; r < 8; ++r) acc[r] = 0.f;
          for (int d = 0; d < 256; d += 8) { const u32x4 kv = *(const u32x4*)(Ks + key * NR_KLD + d);
              const float k0 = bf2f(kv.x & 0xffffu), k1 = bf2f(kv.x >> 16), k2 = bf2f(kv.y & 0xffffu), k3 = bf2f(kv.y >> 16), k4 = bf2f(kv.z & 0xffffu), k5 = bf2f(kv.z >> 16), k6 = bf2f(kv.w & 0xffffu), k7 = bf2f(kv.w >> 16);
#pragma unroll
              for (int r = 0; r < 8; ++r) { const u32x4 qv = *(const u32x4*)(Qs + (rg * 8 + r) * 256 + d);
                  acc[r] += bf2f(qv.x & 0xffffu) * k0 + bf2f(qv.x >> 16) * k1 + bf2f(qv.y & 0xffffu) * k2 + bf2f(qv.y >> 16) * k3 + bf2f(qv.z & 0xffffu) * k4 + bf2f(qv.z >> 16) * k5 + bf2f(qv.w & 0xffffu) * k6 + bf2f(qv.w >> 16) * k7; } }
#pragma unroll
          for (int r = 0; r < 8; ++r) { const int i = qt * 32 + rg * 8 + r, j = kt * 64 + key; Ss[(rg * 8 + r) * 64 + key] = (i >= j) ? acc[r] * exp2f((float)(128 * ((i >> 7) - (j >> 7))) * lg2) : 0.f; } }
        __syncthreads();
        { const bf16_t* vr = vt + (size_t)(h * 256 + tid) * MTOK + b * SEQ + kt * 64;
          for (int kk = 0; kk < 64; kk += 8) { const u32x4 vv = *(const u32x4*)(vr + kk);
              const float v0 = bf2f(vv.x & 0xffffu), v1 = bf2f(vv.x >> 16), v2 = bf2f(vv.y & 0xffffu), v3 = bf2f(vv.y >> 16), v4 = bf2f(vv.z & 0xffffu), v5 = bf2f(vv.z >> 16), v6 = bf2f(vv.w & 0xffffu), v7 = bf2f(vv.w >> 16);
#pragma unroll
              for (int r = 0; r < 32; ++r) { const f32x4 s0 = *(const f32x4*)(Ss + r * 64 + kk), s1 = *(const f32x4*)(Ss + r * 64 + kk + 4);
                  o[r] += s0[0] * v0 + s0[1] * v1 + s0[2] * v2 + s0[3] * v3 + s1[0] * v4 + s1[1] * v5 + s1[2] * v6 + s1[3] * v7; } } }
    }
    __syncthreads();
#pragma unroll
    for (int r = 0; r < 32; ++r) { const float p = wave_sum(o[r] * o[r]); if (lane == 0) red[r * 4 + wv] = p; }
    __syncthreads();
    bf16_t* ycat = (bf16_t*)(args.ws + WS_YCAT);
#pragma unroll
    for (int r = 0; r < 32; ++r) { const float ss = (red[r * 4] + red[r * 4 + 1]) + (red[r * 4 + 2] + red[r * 4 + 3]); const float rstd = __builtin_amdgcn_rsqf(ss * (1.f / 256.f) + EPS);
        const size_t tok = (size_t)(tok0 + r); ycat[tok * DM + DS + h * 256 + tid] = (bf16_t)f2bf(o[r] * rstd * bf2f(gr[tok * DR + h * 256 + tid])); }
}

extern "C" void kernel_launch(void* const* d_in, const int* in_sizes, int n_in, void* d_out, int out_size, void* d_ws, size_t ws_size, hipStream_t stream) {
    static int grid = 0;
    if (grid == 0) {
        if (n_in != 17 || in_sizes[0] != MTOK * DM || out_size != MTOK * DM || ws_size < WS_END) { fprintf(stderr, "kernel_launch: unexpected problem (n_in %d, x %d, out %d, ws %zu)\n", n_in, n_in > 0 ? in_sizes[0] : -1, out_size, ws_size); grid = -1; return; }
        int dev = 0, cus = 0, per_cu = 0;
        hipGetDevice(&dev); hipDeviceGetAttribute(&cus, hipDeviceAttributeMultiprocessorCount, dev);
        if (hipFuncSetAttribute((const void*)mk_fwd, hipFuncAttributeMaxDynamicSharedMemorySize, LDS_BYTES) != hipSuccess) { fprintf(stderr, "kernel_launch: hipFuncSetAttribute failed\n"); grid = -1; return; }
        hipFuncSetAttribute((const void*)naive_ret, hipFuncAttributeMaxDynamicSharedMemorySize, 65536);
        hipOccupancyMaxActiveBlocksPerMultiprocessor(&per_cu, (const void*)mk_fwd, 512, LDS_BYTES);
        (void)hipGetLastError();
        if (per_cu < 1) fprintf(stderr, "kernel_launch: occupancy query says %d blocks per CU\n", per_cu);
        grid = cus;
        if (grid != 256) fprintf(stderr, "kernel_launch: %d CUs (phase balance assumes 256)\n", grid);
        for (int c = 0; c < grid; ++c) { pg8::StaticOrder S; Unit u0, u;
            S.init(MTOK, 10240, grid, c); S.next(0, u0); for (int i = 1; S.next(i, u); ++i) if (u.pm != u0.pm) { fprintf(stderr, "kernel_launch: in-proj unit order breaks the one-panel-per-workgroup assumption\n"); grid = -1; return; }
            S.init(DR, MTOK, grid, c); S.next(0, u0); for (int i = 1; S.next(i, u); ++i) if (u.pn != u0.pn) { fprintf(stderr, "kernel_launch: V^T unit order breaks the assumption\n"); grid = -1; return; }
            S.init(MTOK, DM, grid, c); S.next(0, u0); for (int i = 1; S.next(i, u); ++i) if (u.pm != u0.pm) { fprintf(stderr, "kernel_launch: out-proj unit order breaks the assumption\n"); grid = -1; return; } }
    }
    if (grid < 0) return;
    Args a{};
    for (int i = 0; i < 17; ++i) a.in[i] = (const float*)d_in[i];
    a.out = (float*)d_out; a.ws = (unsigned char*)d_ws;
    auto launch = [&](int lo, int hi) { a.ph_lo = lo; a.ph_hi = hi; void* kargs[] = {&a};
        hipError_t e = hipLaunchCooperativeKernel((const void*)mk_fwd, dim3(grid), dim3(512), kargs, LDS_BYTES, stream);
        if (e != hipSuccess) fprintf(stderr, "kernel_launch: cooperative launch [%d,%d) failed: %s\n", lo, hi, hipGetErrorString(e)); };
#if FAST_SSM && FAST_RET && ONE_LAUNCH
    launch(0, NPH);
#else
    launch(0, 1);
    for (int l = 0; l < DEPTH; ++l) {
        launch(1 + 4 * l, 2 + 4 * l);
        launch(2 + 4 * l, 3 + 4 * l);
#if !FAST_SSM
        hipLaunchKernelGGL(naive_ssm, dim3(BATCH * NG), dim3(64), 0, stream, a, l);
#endif
#if !FAST_RET
        hipLaunchKernelGGL(naive_ret, dim3(BATCH * RH * 64), dim3(256), 32 * 256 * 2 + 64 * NR_KLD * 2 + 32 * 64 * 4 + 32 * 4 * 4, stream, a, l);
#endif
        launch(3 + 4 * l, 4 + 4 * l);
        launch(4 + 4 * l, 5 + 4 * l);
    }
    launch(NPH - 1, NPH);
#endif
}
```

```cpp
#include <hip/hip_runtime.h>
#include <hip/hip_cooperative_groups.h>
#include <cstdio>
#include <cstdint>
namespace cg = cooperative_groups;

#ifndef FAST_SSM
#define FAST_SSM 1
#endif
#ifndef FAST_RET
#define FAST_RET 1
#endif

#ifndef ONE_LAUNCH
#define ONE_LAUNCH 1
#endif

#define LAS __attribute__((address_space(3)))
typedef unsigned short bf16_t;
typedef short bf16x8 __attribute__((ext_vector_type(8)));
typedef float f32x4 __attribute__((ext_vector_type(4)));
typedef float f32x2 __attribute__((ext_vector_type(2)));
typedef unsigned u32x4 __attribute__((ext_vector_type(4)));
typedef unsigned u32x2 __attribute__((ext_vector_type(2)));

constexpr int BATCH = 4, SEQ = 2048, DM = 4096, DEPTH = 2, DS = 2048, DR = 2048, NG = 128, SG = 16, NST = 64, RH = 8, RD = 256;
constexpr int NPROJ = 12288, MTOK = BATCH * SEQ;
constexpr float EPS = 1e-6f;
constexpr int TCH = 16;
constexpr int A2LD = 384;

constexpr size_t MiB = 1u << 20;
constexpr size_t WS_CTL = 0;
constexpr size_t WS_WTIN = 16 * MiB;
constexpr size_t WS_WTGLU = 208 * MiB;
constexpr size_t WS_WTOUT = 224 * MiB;
constexpr size_t WS_BT2 = 288 * MiB;
constexpr size_t WS_PM = 336 * MiB;
constexpr size_t WS_A16 = 368 * MiB;
constexpr size_t WS_ROPE = 369 * MiB;
constexpr size_t WS_SSQX = 371 * MiB;
constexpr size_t WS_SSQ2 = 373 * MiB;
constexpr size_t WS_XB = 384 * MiB;
constexpr size_t WS_X1 = 448 * MiB;
constexpr size_t WS_A2U = 576 * MiB;
constexpr size_t WS_GS = 624 * MiB, WS_Q = 656 * MiB, WS_K = 688 * MiB, WS_VT = 720 * MiB, WS_GR = 752 * MiB, WS_YG = 784 * MiB;
constexpr size_t WS_YCAT = 816 * MiB;
constexpr size_t WS_END = 880 * MiB;

constexpr int RING_BYTES = 131072;
constexpr int STASH_OFF = 155648;
constexpr int LDS_BYTES = 163840 - 4096;

__device__ __forceinline__ unsigned f2bf(float f) { unsigned u = __builtin_bit_cast(unsigned, f); return (u + 0x7fffu + ((u >> 16) & 1u)) >> 16; }
__device__ __forceinline__ unsigned pk2(float lo, float hi) { return f2bf(lo) | (f2bf(hi) << 16); }
__device__ __forceinline__ float bf2f(unsigned v) { return __builtin_bit_cast(float, v << 16); }
__device__ __forceinline__ unsigned cvt_pk_bf16(float lo, float hi) { unsigned r; asm volatile("v_cvt_pk_bf16_f32 %0, %1, %2" : "=v"(r) : "v"(lo), "v"(hi)); return r; }
__device__ __forceinline__ float silu_f(float x) { return x * __builtin_amdgcn_rcpf(1.f + __expf(-x)); }
__device__ __forceinline__ float sigmoid_f(float x) { return __builtin_amdgcn_rcpf(1.f + __expf(-x)); }
__device__ __forceinline__ float gelu_tanh_f(float x) {
    const float z = 0.7978845608028654f * (x + 0.044715f * x * x * x);
    const float th = 1.f - 2.f * __builtin_amdgcn_rcpf(1.f + __expf(2.f * z));
    return 0.5f * x * (1.f + th);
}
template <int X> __device__ __forceinline__ float xor_add(float v) {
    if constexpr (X == 32) { const unsigned u = __builtin_bit_cast(unsigned, v); auto r = __builtin_amdgcn_permlane32_swap(u, u, false, false);
        return __builtin_bit_cast(float, (unsigned)r[0]) + __builtin_bit_cast(float, (unsigned)r[1]); }
    else return v + __builtin_bit_cast(float, __builtin_amdgcn_ds_swizzle(__builtin_bit_cast(int, v), (X << 10) | 0x1f));
}
__device__ __forceinline__ float wave_sum(float v) {
    v = xor_add<1>(v); v = xor_add<2>(v); v = xor_add<4>(v); v = xor_add<8>(v); v = xor_add<16>(v); v = xor_add<32>(v);
    return v;
}
__device__ __forceinline__ void cis_d(double ph, float& c, float& s) {
    const double rv = ph * 0.15915494309189535;
    const float r = (float)(rv - __builtin_rint(rv));
    c = __builtin_amdgcn_cosf(r); s = __builtin_amdgcn_sinf(r);
}
#define LDS_WAIT() asm volatile("s_waitcnt lgkmcnt(0)" ::: "memory")
#define VM_WAIT() asm volatile("s_waitcnt vmcnt(0)" ::: "memory")

namespace pg8 {
constexpr int BM = 256, BK = 64, HALF = 128, HTB = HALF * BK * 2, STAGE_BYTES = 8 * HTB, NXCD = 8, WGM = 8;
__host__ __device__ __forceinline__ int lds_byte(int r, int c) { const int st = (r >> 4) * 2 + (c >> 5), rr = r & 15, cc = c & 31, ob = rr * 64 + cc * 2; return st * 1024 + (ob ^ (((ob >> 9) & 1) << 5)); }
__host__ __device__ __forceinline__ void stage_rc(int b, int& R, int& C) { const int st = b / 1024, sb = b % 1024, swz = sb ^ (((sb >> 9) & 1) << 5); R = (st >> 1) * 16 + swz / 64; C = (st & 1) * 32 + (swz % 64) / 2; }
__host__ __device__ __forceinline__ int perm32(int rho) { const int n = rho >> 4, i = rho & 15; return 8 * (i >> 2) + 4 * n + (i & 3); }

struct Unit { int pm, pn; };
struct Gemm { const bf16_t* A; const bf16_t* Bt; int K, lda, ldb, kmid; };

struct StaticOrder {
    int nM, nN, nwg, G, c;
    __host__ __device__ void init(int M, int N, int G_, int c_) { nM = M / BM; nN = N / BM; nwg = nM * nN; G = G_; c = c_; }
    __host__ __device__ bool next(int i, Unit& u) const {
        const long L = (long)i * G + c; if (L >= nwg) return false;
        int wgid = (int)L; { const int q = nwg / NXCD, r = nwg % NXCD, xcd = wgid % NXCD, off = wgid / NXCD; wgid = (xcd < r ? xcd * (q + 1) : r * (q + 1) + (xcd - r) * q) + off; }
        const int nig = WGM * nN, gid = wgid / nig, fm = gid * WGM, gsz = (nM - fm) < WGM ? (nM - fm) : WGM;
        u.pm = fm + ((wgid % nig) % gsz); u.pn = (wgid % nig) / gsz; return true;
    }
};
struct OneUnit {
    int pm, pn;
    __device__ __forceinline__ bool next(int i, Unit& u) const { if (i) return false; u.pm = pm; u.pn = pn; return true; }
};

template <class Epi, class Sched, bool ALIGN_EPI, bool SP2>
__device__ __forceinline__ void gemm_phase(LAS unsigned char* lds, const Gemm g, const Sched& S, const Epi& E, int tid_in) {
    int tid_ = tid_in; asm volatile("" : "+v"(tid_));
    const int tid = tid_, wid = __builtin_amdgcn_readfirstlane(tid >> 6), lane = tid & 63, wr = wid >> 2, wc = wid & 3, fr = lane & 15, fq = lane >> 4;
    const int K = g.K, nt = K / BK;
    unsigned voffA[2], voffB[2];
#pragma unroll
    for (int i = 0; i < 2; ++i) { int R, C; stage_rc(tid * 16 + i * 8192, R, C); const int Rb = Epi::PERM ? ((R & ~31) + perm32(R & 31)) : R;
        voffA[i] = (unsigned)(R * g.lda + C) * 2u; voffB[i] = (unsigned)(Rb * g.ldb + C) * 2u; }
    const size_t kstep = (size_t)(BK * 2);
    const size_t hstepA = (size_t)HALF * g.lda * 2, hstepB = (size_t)HALF * g.ldb * 2;
    const size_t tstepA = 2 * hstepA, tstepB = 2 * hstepB;
    const unsigned ldsw = (unsigned)wid * 1024u;
    const int aoff = lds_byte(wr * 64 + fr, fq * 8), boff = lds_byte(wc * 32 + fr, fq * 8);
#define PG8_SA(b, h) (((b) * 2 + (h)) * HTB)
#define PG8_SB(b, h) ((4 + (b) * 2 + (h)) * HTB)
#define PG8_STAGE(bufoff, gbase, voff) do { _Pragma("unroll") for (int _i = 0; _i < 2; ++_i) \
        __builtin_amdgcn_global_load_lds((const unsigned*)((const char*)(gbase) + (voff)[_i]), (LAS unsigned*)(lds + (bufoff) + ldsw + _i * 8192), 16, 0, 0); } while (0)
#define PG8_LDA(dst, b, h) do { _Pragma("unroll") for (int m = 0; m < 4; ++m) _Pragma("unroll") for (int k = 0; k < 2; ++k) dst[m][k] = *(const LAS bf16x8*)(lds + PG8_SA(b, h) + aoff + m * 2048 + k * 1024); } while (0)
#define PG8_LDB(dst, b, h) do { _Pragma("unroll") for (int n = 0; n < 2; ++n) _Pragma("unroll") for (int k = 0; k < 2; ++k) dst[n][k] = *(const LAS bf16x8*)(lds + PG8_SB(b, h) + boff + n * 2048 + k * 1024); } while (0)
#define PG8_MMA(ai, bj, At, Bt) do { __builtin_amdgcn_s_setprio(1); _Pragma("unroll") for (int m = 0; m < 4; ++m) _Pragma("unroll") for (int n = 0; n < 2; ++n) _Pragma("unroll") for (int k = 0; k < 2; ++k) \
        acc[ai][bj][m][n] = __builtin_amdgcn_mfma_f32_16x16x32_bf16(Bt[n][k], At[m][k], acc[ai][bj][m][n], 0, 0, 0); __builtin_amdgcn_s_setprio(0); } while (0)
#define PG8_WAIT_V(n) asm volatile("s_waitcnt vmcnt(" #n ")" ::: "memory")
#define PG8_WAIT_L(n) asm volatile("s_waitcnt lgkmcnt(" #n ")" ::: "memory")
#define PG8_BAR __builtin_amdgcn_s_barrier()
#define PG8_SCHED __builtin_amdgcn_sched_barrier(0)
    Unit cur, nxt; int ui = 0;
    if (!S.next(0, cur)) return;
    f32x4 acc[2][2][4][2];
#pragma unroll
    for (int a = 0; a < 2; ++a)
#pragma unroll
        for (int b = 0; b < 2; ++b)
#pragma unroll
            for (int m = 0; m < 4; ++m)
#pragma unroll
                for (int n = 0; n < 2; ++n) acc[a][b][m][n] = (f32x4){0.f, 0.f, 0.f, 0.f};
    bf16x8 At[4][2], B0[2][2], B1[2][2];
    const char* cA = (const char*)g.A + (size_t)cur.pm * tstepA; const char* cB = (const char*)g.Bt + (size_t)cur.pn * tstepB;
    if constexpr (SP2) {
        PG8_STAGE(PG8_SB(0, 0), cB, voffB); PG8_STAGE(PG8_SB(0, 1), cB + hstepB, voffB); PG8_STAGE(PG8_SA(0, 0), cA, voffA); PG8_STAGE(PG8_SA(0, 1), cA + hstepA, voffA);
        if (wr == 1) PG8_BAR;
        PG8_WAIT_V(2); PG8_BAR;
        PG8_STAGE(PG8_SB(1, 0), cB + kstep, voffB); PG8_STAGE(PG8_SA(1, 0), cA + kstep, voffA); PG8_STAGE(PG8_SB(1, 1), cB + hstepB + kstep, voffB);
        PG8_WAIT_V(6); PG8_BAR;
    } else {
        PG8_STAGE(PG8_SB(0, 0), cB, voffB); PG8_STAGE(PG8_SA(0, 0), cA, voffA); PG8_STAGE(PG8_SB(0, 1), cB + hstepB, voffB); PG8_STAGE(PG8_SA(0, 1), cA + hstepA, voffA);
        if (wr == 1) PG8_BAR;
        PG8_WAIT_V(4); PG8_BAR;
        PG8_STAGE(PG8_SB(1, 0), cB + kstep, voffB); PG8_STAGE(PG8_SA(1, 0), cA + kstep, voffA); PG8_STAGE(PG8_SB(1, 1), cB + hstepB + kstep, voffB);
        PG8_WAIT_V(6); PG8_BAR;
    }
    for (;;) {
        const bool has_next = S.next(ui + 1, nxt);
        const char* nA = has_next ? (const char*)g.A + (size_t)nxt.pm * tstepA : cA; const char* nB = has_next ? (const char*)g.Bt + (size_t)nxt.pn * tstepB : cB;
        for (int t = 0; t < nt; t += 2) {
            const bool last = (t == nt - 2);
            const char* a1 = cA + (size_t)(t + 1) * kstep;
            const char* a2 = last ? nA : cA + (size_t)(t + 2) * kstep; const char* b2 = last ? nB : cB + (size_t)(t + 2) * kstep;
            const char* a3 = a2 + kstep; const char* b3 = b2 + kstep;
            if constexpr (Epi::MIDK) { if (t == g.kmid) E.midk(acc, wr, fr); }
            if constexpr (SP2) {
            PG8_LDB(B0, 0, 0); PG8_LDB(B1, 0, 1); PG8_SCHED; PG8_LDA(At, 0, 0); PG8_STAGE(PG8_SA(1, 1), a1 + hstepA, voffA);
            PG8_WAIT_V(8); PG8_WAIT_L(0); PG8_BAR; PG8_MMA(0, 0, At, B0); PG8_MMA(0, 1, At, B1); PG8_BAR; PG8_SCHED;
            PG8_LDA(At, 0, 1); PG8_STAGE(PG8_SB(0, 0), b2, voffB); PG8_STAGE(PG8_SB(0, 1), b2 + hstepB, voffB); PG8_STAGE(PG8_SA(0, 0), a2, voffA);
            PG8_WAIT_V(8); PG8_WAIT_L(0); PG8_BAR; PG8_MMA(1, 0, At, B0); PG8_MMA(1, 1, At, B1); PG8_BAR; PG8_SCHED;
            PG8_LDB(B0, 1, 0); PG8_LDB(B1, 1, 1); PG8_SCHED; PG8_LDA(At, 1, 0); PG8_STAGE(PG8_SA(0, 1), a2 + hstepA, voffA);
            PG8_WAIT_V(8); PG8_WAIT_L(0); PG8_BAR; PG8_MMA(0, 0, At, B0); PG8_MMA(0, 1, At, B1); PG8_BAR; PG8_SCHED;
            PG8_LDA(At, 1, 1); PG8_STAGE(PG8_SB(1, 0), b3, voffB); PG8_STAGE(PG8_SB(1, 1), b3 + hstepB, voffB); PG8_STAGE(PG8_SA(1, 0), a3, voffA);
            PG8_WAIT_V(8); PG8_WAIT_L(0); PG8_BAR; PG8_MMA(1, 0, At, B0); PG8_MMA(1, 1, At, B1); PG8_BAR; PG8_SCHED;
            } else {
            PG8_LDB(B0, 0, 0); PG8_SCHED; PG8_LDA(At, 0, 0); PG8_STAGE(PG8_SA(1, 1), a1 + hstepA, voffA);
            PG8_WAIT_L(8); PG8_BAR; PG8_WAIT_L(0); PG8_MMA(0, 0, At, B0); PG8_BAR; PG8_SCHED;
            PG8_LDB(B1, 0, 1); PG8_STAGE(PG8_SB(0, 0), b2, voffB);
            PG8_BAR; PG8_WAIT_L(0); PG8_MMA(0, 1, At, B1); PG8_BAR;
            PG8_LDA(At, 0, 1); PG8_STAGE(PG8_SA(0, 0), a2, voffA);
            PG8_BAR; PG8_WAIT_L(0); PG8_MMA(1, 0, At, B0); PG8_BAR; PG8_SCHED;
            PG8_STAGE(PG8_SB(0, 1), b2 + hstepB, voffB);
            PG8_WAIT_V(6); PG8_BAR; PG8_MMA(1, 1, At, B1); PG8_BAR;
            PG8_LDB(B0, 1, 0); PG8_SCHED; PG8_LDA(At, 1, 0); PG8_STAGE(PG8_SA(0, 1), a2 + hstepA, voffA);
            PG8_WAIT_L(8); PG8_BAR; PG8_WAIT_L(0); PG8_MMA(0, 0, At, B0); PG8_BAR; PG8_SCHED;
            PG8_LDB(B1, 1, 1); PG8_STAGE(PG8_SB(1, 0), b3, voffB);
            PG8_BAR; PG8_WAIT_L(0); PG8_MMA(0, 1, At, B1); PG8_BAR;
            PG8_LDA(At, 1, 1); PG8_STAGE(PG8_SA(1, 0), a3, voffA);
            PG8_BAR; PG8_WAIT_L(0); PG8_MMA(1, 0, At, B0); PG8_BAR; PG8_SCHED;
            PG8_STAGE(PG8_SB(1, 1), b3 + hstepB, voffB);
            PG8_WAIT_V(6); PG8_BAR; PG8_MMA(1, 1, At, B1); PG8_BAR;
            }
        }
        if constexpr (ALIGN_EPI) { if (wr == 0) PG8_BAR; }
        if constexpr (!Epi::AFTER_DRAIN) { E(acc, cur, wr, wc, fr, fq); }
        if (!has_next) break;
#pragma unroll
        for (int a = 0; a < 2; ++a)
#pragma unroll
            for (int b = 0; b < 2; ++b)
#pragma unroll
                for (int m = 0; m < 4; ++m)
#pragma unroll
                    for (int n = 0; n < 2; ++n) acc[a][b][m][n] = (f32x4){0.f, 0.f, 0.f, 0.f};
        cur = nxt; cA = nA; cB = nB; ++ui;
        if constexpr (ALIGN_EPI) { if (wr == 1) PG8_BAR; }
    }
    PG8_WAIT_V(0);
    if constexpr (!ALIGN_EPI) { if (wr == 0) PG8_BAR; }
    PG8_BAR;
    if constexpr (Epi::AFTER_DRAIN) { E.fused(acc, cur, wr, wc, fr, fq, lds); }
#undef PG8_SA
#undef PG8_SB
#undef PG8_STAGE
#undef PG8_LDA
#undef PG8_LDB
#undef PG8_MMA
#undef PG8_WAIT_V
#undef PG8_WAIT_L
#undef PG8_BAR
#undef PG8_SCHED
}
}
using pg8::Unit;
typedef f32x4 Acc[2][2][4][2];

struct EpiInProj {
    static constexpr bool PERM = true, AFTER_DRAIN = false, MIDK = false;
    const LAS float* rs; bf16_t *a2u, *gs, *q, *k, *gr; const float* rope;
    __device__ __forceinline__ void operator()(const Acc& acc, const Unit& u, int wr, int wc, int fr, int fq) const {
        asm volatile("" : "+v"(fr), "+v"(fq));
        const int type = u.pn >> 3, colt = (u.pn & 7) << 8, c8 = wc * 32 + 8 * fq, lr0 = wr * 64 + fr;
        const bool rot = (type == 2 || type == 3);
        const float eh = __builtin_amdgcn_exp2f((float)(-5 - (u.pn & 7)));
        const float lg2h = -(eh * (1.f + eh * (0.5f + eh * (0.33333334f + eh * (0.25f + eh * (0.2f + eh * 0.16666667f)))))) * 1.4426950408889634f;
        f32x4 cur[4], nxt[4];
        if (rot) { const f32x4* cs = (const f32x4*)(rope + ((size_t)((u.pm * 256 + lr0) & 2047) * 128 + c8) * 2);
#pragma unroll
            for (int j = 0; j < 4; ++j) cur[j] = cs[j]; }
#pragma unroll
        for (int idx = 0; idx < 8; ++idx) { const int ai = idx >> 2, m = idx & 3;
                const int lr = lr0 + ai * 128 + m * 16, r = u.pm * 256 + lr; const float s = rs[lr];
                if (rot && idx < 7) { const f32x4* cs = (const f32x4*)(rope + ((size_t)((u.pm * 256 + lr0 + ((idx + 1) >> 2) * 128 + ((idx + 1) & 3) * 16) & 2047) * 128 + c8) * 2);
#pragma unroll
                    for (int j = 0; j < 4; ++j) nxt[j] = cs[j]; }
                f32x4 v[2][2];
#pragma unroll
                for (int bj = 0; bj < 2; ++bj)
#pragma unroll
                    for (int n = 0; n < 2; ++n) v[bj][n] = acc[ai][bj][m][n] * s;
                if (type == 0) {
#pragma unroll
                    for (int bj = 0; bj < 2; ++bj) { const int col = colt + bj * 128 + c8;
                        u32x4 w; w.x = cvt_pk_bf16(v[bj][0][0], v[bj][0][1]); w.y = cvt_pk_bf16(v[bj][0][2], v[bj][0][3]); w.z = cvt_pk_bf16(v[bj][1][0], v[bj][1][1]); w.w = cvt_pk_bf16(v[bj][1][2], v[bj][1][3]);
                        *(u32x4*)(a2u + ((size_t)((col >> 4) * 512 + (r >> 4)) * A2LD + (r & 15) * 16 + (col & 15))) = w; }
                } else if (type == 1 || type == 4) {
                    bf16_t* dst = (type == 1 ? gs : gr) + (size_t)r * 2048 + colt + c8;
#pragma unroll
                    for (int bj = 0; bj < 2; ++bj) {
                        u32x4 w; w.x = cvt_pk_bf16(silu_f(v[bj][0][0]), silu_f(v[bj][0][1])); w.y = cvt_pk_bf16(silu_f(v[bj][0][2]), silu_f(v[bj][0][3]));
                        w.z = cvt_pk_bf16(silu_f(v[bj][1][0]), silu_f(v[bj][1][1])); w.w = cvt_pk_bf16(silu_f(v[bj][1][2]), silu_f(v[bj][1][3]));
                        *(u32x4*)(dst + bj * 128) = w; }
                } else {
                    const float sc = (type == 3) ? 0.0625f * __builtin_amdgcn_exp2f(-(float)(r & 127) * lg2h) : __builtin_amdgcn_exp2f((float)(r & 127) * lg2h);
                    float o1[8], o2[8];
#pragma unroll
                    for (int jj = 0; jj < 4; ++jj) { const f32x4 t = cur[jj];
                        const float a0 = v[0][jj >> 1][(jj & 1) * 2], b0 = v[1][jj >> 1][(jj & 1) * 2], a1 = v[0][jj >> 1][(jj & 1) * 2 + 1], b1 = v[1][jj >> 1][(jj & 1) * 2 + 1];
                        o1[2 * jj] = (a0 * t[0] - b0 * t[1]) * sc; o2[2 * jj] = (b0 * t[0] + a0 * t[1]) * sc;
                        o1[2 * jj + 1] = (a1 * t[2] - b1 * t[3]) * sc; o2[2 * jj + 1] = (b1 * t[2] + a1 * t[3]) * sc; }
                    bf16_t* dst = (type == 2 ? q : k) + (size_t)r * 2048 + colt + c8;
                    u32x4 w; w.x = cvt_pk_bf16(o1[0], o1[1]); w.y = cvt_pk_bf16(o1[2], o1[3]); w.z = cvt_pk_bf16(o1[4], o1[5]); w.w = cvt_pk_bf16(o1[6], o1[7]);
                    *(u32x4*)dst = w;
                    w.x = cvt_pk_bf16(o2[0], o2[1]); w.y = cvt_pk_bf16(o2[2], o2[3]); w.z = cvt_pk_bf16(o2[4], o2[5]); w.w = cvt_pk_bf16(o2[6], o2[7]);
                    *(u32x4*)(dst + 128) = w;
#pragma unroll
                    for (int j = 0; j < 4; ++j) cur[j] = nxt[j];
                }
                asm volatile("" ::: "memory");
            }
    }
};
struct EpiVT {
    static constexpr bool PERM = true, AFTER_DRAIN = false, MIDK = false;
    const LAS float* rs; bf16_t* vt;
    __device__ __forceinline__ void operator()(const Acc& acc, const Unit& u, int wr, int wc, int fr, int fq) const {
        asm volatile("" : "+v"(fr), "+v"(fq));
        f32x4 sv[2][2];
#pragma unroll
        for (int bj = 0; bj < 2; ++bj)
#pragma unroll
            for (int n = 0; n < 2; ++n) sv[bj][n] = *(const LAS f32x4*)(rs + bj * 128 + wc * 32 + 8 * fq + 4 * n);
#pragma unroll
        for (int ai = 0; ai < 2; ++ai)
#pragma unroll
            for (int m = 0; m < 4; ++m) { bf16_t* dst = vt + (size_t)(u.pm * 256 + wr * 64 + fr + ai * 128 + m * 16) * MTOK + u.pn * 256 + wc * 32 + 8 * fq;
#pragma unroll
                for (int bj = 0; bj < 2; ++bj) { const f32x4 a = acc[ai][bj][m][0] * sv[bj][0], b = acc[ai][bj][m][1] * sv[bj][1];
                    u32x4 w; w.x = cvt_pk_bf16(a[0], a[1]); w.y = cvt_pk_bf16(a[2], a[3]); w.z = cvt_pk_bf16(b[0], b[1]); w.w = cvt_pk_bf16(b[2], b[3]);
                    *(u32x4*)(dst + bj * 128) = w; } }
    }
};
constexpr int SLD = 132;
struct EpiSloc {
    static constexpr bool PERM = false, AFTER_DRAIN = true, MIDK = false;
    __device__ __forceinline__ void fused(const Acc& acc, const Unit&, int wr, int wc, int fr, int fq, LAS unsigned char* lds) const {
        asm volatile("" : "+v"(fr), "+v"(fq));
        LAS float* S = (LAS float*)lds;
#pragma unroll
        for (int ai = 0; ai < 2; ++ai)
#pragma unroll
            for (int m = 0; m < 4; ++m)
#pragma unroll
                for (int n = 0; n < 2; ++n) *(LAS f32x4*)(S + (ai * 128 + wr * 64 + m * 16 + fr) * SLD + wc * 32 + n * 16 + 4 * fq) = acc[ai][0][m][n];
    }
};
struct EpiSsmOut {
    static constexpr bool PERM = true, AFTER_DRAIN = false, MIDK = false;
    const bf16_t* a2g; const float* dsk; bf16_t* yg; int g;
    __device__ __forceinline__ void operator()(const Acc& acc, const Unit& u, int wr, int wc, int fr, int fq) const {
        asm volatile("" : "+v"(fr), "+v"(fq));
        const int h0 = 8 * (fq & 1), row0 = u.pm * 256 + wr * 64 + fr, colb = wc * 32 + 8 * fq;
        const f32x4 d0 = *(const f32x4*)(dsk + h0), d1 = *(const f32x4*)(dsk + h0 + 4);
        u32x4 cur[2], nxt[2];
        cur[0] = *(const u32x4*)(a2g + (size_t)row0 * A2LD + colb); cur[1] = *(const u32x4*)(a2g + (size_t)row0 * A2LD + colb + 128);
#pragma unroll
        for (int idx = 0; idx < 8; ++idx) { const int ai = idx >> 2, m = idx & 3, row = row0 + ai * 128 + m * 16;
            if (idx < 7) { const size_t ro = (size_t)(row0 + ((idx + 1) >> 2) * 128 + ((idx + 1) & 3) * 16) * A2LD + colb; nxt[0] = *(const u32x4*)(a2g + ro); nxt[1] = *(const u32x4*)(a2g + ro + 128); }
#pragma unroll
            for (int bj = 0; bj < 2; ++bj) { const int col = bj * 128 + colb, tl = col >> 4;
                const u32x4 uu = cur[bj];
                const f32x4 a = acc[ai][bj][m][0], b = acc[ai][bj][m][1];
                float y[8];
                y[0] = a[0] + d0[0] * bf2f(uu.x & 0xffffu); y[1] = a[1] + d0[1] * bf2f(uu.x >> 16); y[2] = a[2] + d0[2] * bf2f(uu.y & 0xffffu); y[3] = a[3] + d0[3] * bf2f(uu.y >> 16);
                y[4] = b[0] + d1[0] * bf2f(uu.z & 0xffffu); y[5] = b[1] + d1[1] * bf2f(uu.z >> 16); y[6] = b[2] + d1[2] * bf2f(uu.w & 0xffffu); y[7] = b[3] + d1[3] * bf2f(uu.w >> 16);
#pragma unroll
                for (int j = 0; j < 8; ++j) y[j] = gelu_tanh_f(y[j]);
                u32x4 w; w.x = cvt_pk_bf16(y[0], y[1]); w.y = cvt_pk_bf16(y[2], y[3]); w.z = cvt_pk_bf16(y[4], y[5]); w.w = cvt_pk_bf16(y[6], y[7]);
                *(u32x4*)(yg + (size_t)(row * 16 + tl) * DS + g * 16 + h0) = w; }
            cur[0] = nxt[0]; cur[1] = nxt[1];
            asm volatile("" ::: "memory"); }
    }
};
struct EpiGlu {
    static constexpr bool PERM = true, AFTER_DRAIN = false, MIDK = false;
    const bf16_t* yg; const bf16_t* gs; const float* bias; bf16_t* ycat; float* ssq2;
    __device__ __forceinline__ void preload(u32x4 (&p)[4], size_t rowoff) const {
#pragma unroll
        for (int bj = 0; bj < 2; ++bj) { p[2 * bj] = *(const u32x4*)(yg + rowoff + bj * 128); p[2 * bj + 1] = *(const u32x4*)(gs + rowoff + bj * 128); }
    }
    __device__ __forceinline__ void operator()(const Acc& acc, const Unit& u, int wr, int wc, int fr, int fq) const {
        asm volatile("" : "+v"(fr), "+v"(fq));
        const int col0 = u.pn * 256 + wc * 32 + 8 * fq, r0 = u.pm * 256 + wr * 64 + fr;
        f32x4 bv[2][2];
#pragma unroll
        for (int bj = 0; bj < 2; ++bj)
#pragma unroll
            for (int n = 0; n < 2; ++n) bv[bj][n] = *(const f32x4*)(bias + col0 + bj * 128 + 4 * n);
        u32x4 cur[4], nxt[4]; preload(cur, (size_t)r0 * DS + col0);
#pragma unroll
        for (int idx = 0; idx < 8; ++idx) { const int ai = idx >> 2, m = idx & 3, r = r0 + ai * 128 + m * 16; float ss = 0.f;
            if (idx < 7) preload(nxt, (size_t)(r0 + ((idx + 1) >> 2) * 128 + ((idx + 1) & 3) * 16) * DS + col0);
#pragma unroll
            for (int bj = 0; bj < 2; ++bj) { const u32x4 yy = cur[2 * bj], gg = cur[2 * bj + 1];
                const f32x4 a = acc[ai][bj][m][0] + bv[bj][0], b = acc[ai][bj][m][1] + bv[bj][1];
                float z[8];
                z[0] = bf2f(yy.x & 0xffffu) * sigmoid_f(a[0]); z[1] = bf2f(yy.x >> 16) * sigmoid_f(a[1]); z[2] = bf2f(yy.y & 0xffffu) * sigmoid_f(a[2]); z[3] = bf2f(yy.y >> 16) * sigmoid_f(a[3]);
                z[4] = bf2f(yy.z & 0xffffu) * sigmoid_f(b[0]); z[5] = bf2f(yy.z >> 16) * sigmoid_f(b[1]); z[6] = bf2f(yy.w & 0xffffu) * sigmoid_f(b[2]); z[7] = bf2f(yy.w >> 16) * sigmoid_f(b[3]);
#pragma unroll
                for (int j = 0; j < 8; ++j) ss += z[j] * z[j];
                z[0] *= bf2f(gg.x & 0xffffu); z[1] *= bf2f(gg.x >> 16); z[2] *= bf2f(gg.y & 0xffffu); z[3] *= bf2f(gg.y >> 16);
                z[4] *= bf2f(gg.z & 0xffffu); z[5] *= bf2f(gg.z >> 16); z[6] *= bf2f(gg.w & 0xffffu); z[7] *= bf2f(gg.w >> 16);
                u32x4 w; w.x = cvt_pk_bf16(z[0], z[1]); w.y = cvt_pk_bf16(z[2], z[3]); w.z = cvt_pk_bf16(z[4], z[5]); w.w = cvt_pk_bf16(z[6], z[7]);
                *(u32x4*)(ycat + (size_t)r * DM + col0 + bj * 128) = w; }
            ss = xor_add<16>(ss); ss = xor_add<32>(ss);
            if (fq == 0) ssq2[(size_t)r * 32 + u.pn * 4 + wc] = ss;
#pragma unroll
            for (int k = 0; k < 4; ++k) cur[k] = nxt[k];
            asm volatile("" ::: "memory"); }
    }
};
template <bool RESBF> struct EpiOut {
    static constexpr bool PERM = true, AFTER_DRAIN = false, MIDK = true;
    const LAS float* rs2; const void* res; bf16_t* xo; float* ssq;
    __device__ __forceinline__ void midk(Acc& acc, int wr, int fr) const {
        asm volatile("" : "+v"(fr));
#pragma unroll
        for (int ai = 0; ai < 2; ++ai)
#pragma unroll
            for (int m = 0; m < 4; ++m) { const float s = rs2[ai * 128 + wr * 64 + m * 16 + fr];
#pragma unroll
                for (int bj = 0; bj < 2; ++bj)
#pragma unroll
                    for (int n = 0; n < 2; ++n) acc[ai][bj][m][n] *= s; }
    }
    typedef f32x4 Pre[RESBF ? 2 : 4];
    __device__ __forceinline__ void preload(Pre& p, size_t rowoff) const {
#pragma unroll
        for (int bj = 0; bj < 2; ++bj) {
            if constexpr (RESBF) p[bj] = __builtin_bit_cast(f32x4, *(const u32x4*)((const bf16_t*)res + rowoff + bj * 128));
            else { p[2 * bj] = *(const f32x4*)((const float*)res + rowoff + bj * 128); p[2 * bj + 1] = *(const f32x4*)((const float*)res + rowoff + bj * 128 + 4); } }
    }
    __device__ __forceinline__ void operator()(const Acc& acc, const Unit& u, int wr, int wc, int fr, int fq) const {
        asm volatile("" : "+v"(fr), "+v"(fq));
        const int col0 = u.pn * 256 + wc * 32 + 8 * fq; const int r0 = u.pm * 256 + wr * 64 + fr;
        Pre cur, nxt; preload(cur, (size_t)r0 * DM + col0);
#pragma unroll
        for (int idx = 0; idx < 8; ++idx) { const int ai = idx >> 2, m = idx & 3, r = r0 + ai * 128 + m * 16; float ss = 0.f;
            if (idx < 7) preload(nxt, (size_t)(r0 + ((idx + 1) >> 2) * 128 + ((idx + 1) & 3) * 16) * DM + col0);
#pragma unroll
            for (int bj = 0; bj < 2; ++bj) { const size_t off = (size_t)r * DM + col0 + bj * 128; f32x4 x0, x1;
                if constexpr (RESBF) { const u32x4 rv = __builtin_bit_cast(u32x4, cur[bj]);
                    x0 = (f32x4){bf2f(rv.x & 0xffffu), bf2f(rv.x >> 16), bf2f(rv.y & 0xffffu), bf2f(rv.y >> 16)}; x1 = (f32x4){bf2f(rv.z & 0xffffu), bf2f(rv.z >> 16), bf2f(rv.w & 0xffffu), bf2f(rv.w >> 16)};
                } else { x0 = cur[2 * bj]; x1 = cur[2 * bj + 1]; }
                x0 = x0 + acc[ai][bj][m][0]; x1 = x1 + acc[ai][bj][m][1];
                ss += ((x0[0] * x0[0] + x0[1] * x0[1]) + (x0[2] * x0[2] + x0[3] * x0[3])) + ((x1[0] * x1[0] + x1[1] * x1[1]) + (x1[2] * x1[2] + x1[3] * x1[3]));
                u32x4 w; w.x = cvt_pk_bf16(x0[0], x0[1]); w.y = cvt_pk_bf16(x0[2], x0[3]); w.z = cvt_pk_bf16(x1[0], x1[1]); w.w = cvt_pk_bf16(x1[2], x1[3]);
                *(u32x4*)(xo + off) = w; }
            ss = xor_add<16>(ss); ss = xor_add<32>(ss);
            if (fq == 0) ssq[(size_t)r * 64 + u.pn * 4 + wc] = ss;
#pragma unroll
            for (int k = 0; k < (RESBF ? 2 : 4); ++k) cur[k] = nxt[k];
            asm volatile("" ::: "memory"); }
    }
};

struct Args { const float* in[17]; float* out; unsigned char* ws; int ph_lo, ph_hi; };
enum { I_X = 0, I_NORMW, I_WIN, I_LRE, I_LIM, I_BRE, I_BIM, I_CRE, I_CIM, I_D, I_LOGDT, I_WGLU, I_BGLU, I_SNW, I_RNW, I_WOUT, I_FNW };

typedef const __attribute__((address_space(4))) Args* ArgsP;
struct Frame {
    LAS unsigned char* lds; int wave, vcu, G, bid; unsigned char* ws;
};

__device__ __forceinline__ int fresh_tid(const Frame& F) { unsigned m_ = ~0u; asm volatile("" : "+s"(m_)); return F.wave * 64 + (int)__builtin_amdgcn_mbcnt_hi(m_, __builtin_amdgcn_mbcnt_lo(m_, 0u)); }
__device__ __forceinline__ void transpose_item(const float* W, int K, int N, bf16_t* WT, const float* ks0, const float* ks1, int ksplit, int remap, int item, int lane) {
    const int nblk = N / 64, kb = item / nblk, nb = item % nblk, k0 = 64 * kb, nq = lane & 15, kq = lane >> 4; int n0 = 64 * nb;
    const float* wp = W + (size_t)(k0 + 16 * kq) * N + n0 + 4 * nq;
    f32x4 v[16];
#pragma unroll
    for (int i = 0; i < 16; ++i) v[i] = *(const f32x4*)(wp + (size_t)i * N);
    if (ks0) { const float* ks = ((k0 < ksplit) ? ks0 + k0 : ks1 + (k0 - ksplit)) + 16 * kq;
#pragma unroll
        for (int i = 0; i < 4; ++i) { const f32x4 sc = *(const f32x4*)(ks + 4 * i);
#pragma unroll
            for (int j = 0; j < 4; ++j) v[4 * i + j] = v[4 * i + j] * sc[j]; } }
    if (remap) { if (n0 >= 10240) n0 -= 2048; else if (n0 >= 8192) n0 += 2048; }
#pragma unroll
    for (int c = 0; c < 4; ++c) { bf16_t* dst = WT + (size_t)(n0 + 4 * nq + c) * K + k0 + 16 * kq;
        u32x4 o0, o1;
        o0.x = pk2(v[0][c], v[1][c]); o0.y = pk2(v[2][c], v[3][c]); o0.z = pk2(v[4][c], v[5][c]); o0.w = pk2(v[6][c], v[7][c]);
        o1.x = pk2(v[8][c], v[9][c]); o1.y = pk2(v[10][c], v[11][c]); o1.z = pk2(v[12][c], v[13][c]); o1.w = pk2(v[14][c], v[15][c]);
        *(u32x4*)dst = o0; *(u32x4*)(dst + 8) = o1; }
}

__device__ __forceinline__ void ssm_mats_item(const Frame& F, ArgsP a, int l, int g) {
    const int lg = l * NG + g, tid = fresh_tid(F);
    LAS float* apr = (LAS float*)F.lds;
    LAS float* api = apr + 17 * 64;
    LAS float* bbr = api + 17 * 64;
    LAS float* bbi = bbr + 1024;
    LAS float* crs = bbi + 1024;
    LAS float* cis = crs + 1024;
    LAS float* crt = cis + 1024;
    LAS float* cit = crt + 1024;
    LAS float* Kt = cit + 1024;
    LAS float* lrs = Kt + 4096;
    LAS float* lis = lrs + 64;
    { const float b0r = a->in[I_BRE][(size_t)lg * 1024 + tid], b1r = a->in[I_BRE][(size_t)lg * 1024 + 512 + tid], b0i = a->in[I_BIM][(size_t)lg * 1024 + tid], b1i = a->in[I_BIM][(size_t)lg * 1024 + 512 + tid];
      const float c0r = a->in[I_CRE][(size_t)lg * 1024 + tid], c1r = a->in[I_CRE][(size_t)lg * 1024 + 512 + tid], c0i = a->in[I_CIM][(size_t)lg * 1024 + tid], c1i = a->in[I_CIM][(size_t)lg * 1024 + 512 + tid];
      const float lx = (tid < 64) ? a->in[I_LRE][lg * 64 + tid] : ((tid < 128) ? a->in[I_LIM][lg * 64 + tid - 64] : 0.f);
      bbr[tid] = b0r; bbr[512 + tid] = b1r; bbi[tid] = b0i; bbi[512 + tid] = b1i;
      crs[tid] = c0r; crs[512 + tid] = c1r; cis[tid] = c0i; cis[512 + tid] = c1i;
      { const int hp0 = tid >> 6, n0 = tid & 63; crt[n0 * 16 + hp0] = c0r; crt[n0 * 16 + hp0 + 8] = c1r; cit[n0 * 16 + hp0] = c0i; cit[n0 * 16 + hp0 + 8] = c1i; }
      if (tid < 128) lrs[tid] = lx; }
    const float dtf = expf(a->in[I_LOGDT][lg]);
    __syncthreads();
    for (int e = tid; e < 17 * 64; e += 512) { const int tau = e >> 6, n = e & 63; const float lr = lrs[n], li = lis[n];
        float c, s; cis_d((double)li * (double)dtf * tau, c, s); const float mag = expf(lr * dtf * (float)tau); apr[e] = mag * c; api[e] = mag * s; }
    __syncthreads();
#pragma unroll
    for (int k = 0; k < 2; ++k) { const int e = tid + 512 * k, n = e >> 4; const float lr = lrs[n], li = lis[n];
        const float nr = apr[64 + n] - 1.f, ni = api[64 + n], den = lr * lr + li * li, cor = (nr * lr + ni * li) / den, coi = (ni * lr - nr * li) / den;
        const float br = bbr[e], bi = bbi[e];
        bbr[e] = cor * br - coi * bi; bbi[e] = cor * bi + coi * br; }
    if (tid < 64) ((float2*)(F.ws + WS_A16))[lg * 64 + tid] = make_float2(apr[16 * 64 + tid], api[16 * 64 + tid]);
    __syncthreads();
    { const int tau = tid >> 5, hp = (tid >> 1) & 15, h0 = (tid & 1) * 8; float sum[8];
#pragma unroll
      for (int j = 0; j < 8; ++j) sum[j] = 0.f;
#pragma unroll 4
      for (int n = 0; n < 64; ++n) { const float cr = crt[n * 16 + hp], ci = cit[n * 16 + hp], ar = apr[tau * 64 + n], ai = api[tau * 64 + n], pr = cr * ar - ci * ai, pi = cr * ai + ci * ar;
          const f32x4 b0 = *(const LAS f32x4*)(bbr + n * 16 + h0), b1 = *(const LAS f32x4*)(bbr + n * 16 + h0 + 4), d0 = *(const LAS f32x4*)(bbi + n * 16 + h0), d1 = *(const LAS f32x4*)(bbi + n * 16 + h0 + 4);
#pragma unroll
          for (int j = 0; j < 4; ++j) { sum[j] += pr * b0[j] - pi * d0[j]; sum[4 + j] += pr * b1[j] - pi * d1[j]; } }
#pragma unroll
      for (int j = 0; j < 8; ++j) Kt[(tau << 8) + (hp << 4) + h0 + j] = sum[j]; }
    __syncthreads();
    bf16_t* bt2 = (bf16_t*)(F.ws + WS_BT2) + (size_t)lg * 256 * A2LD;
#pragma unroll 2
    for (int e = tid; e < 256 * A2LD / 8; e += 512) { const int row = e / 48, c0 = (e % 48) * 8, t = row >> 4, hp = row & 15; float v[8];
        if (c0 < 256) { const int j = c0 >> 4, h0 = c0 & 15;
#pragma unroll
            for (int i = 0; i < 8; ++i) v[i] = (t >= j) ? Kt[((t - j) << 8) + (hp << 4) + h0 + i] : 0.f;
        } else { const int nn = c0 - 256;
#pragma unroll
            for (int i = 0; i < 8; ++i) { const int n = (nn + i) & 63; const float cr = crs[hp * 64 + n], ci = cis[hp * 64 + n], ar = apr[(t + 1) * 64 + n], ai = api[(t + 1) * 64 + n];
                v[i] = (nn < 64) ? (cr * ar - ci * ai) : -(cr * ai + ci * ar); } }
        u32x4 w; w.x = pk2(v[0], v[1]); w.y = pk2(v[2], v[3]); w.z = pk2(v[4], v[5]); w.w = pk2(v[6], v[7]);
        *(u32x4*)(bt2 + (size_t)row * A2LD + c0) = w; }
    bf16_t* pm = (bf16_t*)(F.ws + WS_PM) + (size_t)lg * 256 * 256;
#pragma unroll 2
    for (int e = tid; e < 256 * 256 / 8; e += 512) { const int row = e >> 5, c0 = (e & 31) * 8; float v[8];
        if (row < 128) { const int n = row & 63, im = row >> 6, j = c0 >> 4, h0 = c0 & 15; const float ar = apr[(15 - j) * 64 + n], ai = api[(15 - j) * 64 + n];
#pragma unroll
            for (int i = 0; i < 8; ++i) { const float br = bbr[n * 16 + h0 + i], bi = bbi[n * 16 + h0 + i]; v[i] = im ? (ar * bi + ai * br) : (ar * br - ai * bi); }
        } else {
#pragma unroll
            for (int i = 0; i < 8; ++i) v[i] = 0.f; }
        u32x4 w; w.x = pk2(v[0], v[1]); w.y = pk2(v[2], v[3]); w.z = pk2(v[4], v[5]); w.w = pk2(v[6], v[7]);
        *(u32x4*)(pm + (size_t)row * 256 + c0) = w; }
    __syncthreads();
}

__device__ __forceinline__ void p0_prologue(const Frame& F, ArgsP a, int parts = 7) {
    const int tid0 = fresh_tid(F), lane0 = tid0 & 63;
    if (parts & 1) for (int it = F.vcu; it < DEPTH * NG; it += F.G) ssm_mats_item(F, a, it / NG, it % NG);
    if (parts & 2) { float2* rope = (float2*)(F.ws + WS_ROPE);
      for (int e = F.vcu * 512 + tid0; e < SEQ * 128; e += F.G * 512) { const int pos = e >> 7, i = e & 127;
          const double inv = (double)expf(-(float)(2 * i) * (9.210340371976184f / 256.0f)); float c, s; cis_d((double)pos * inv, c, s); rope[e] = make_float2(c, s); } }
    const int gw = F.vcu * 8 + F.wave, NGW = F.G * 8;
    if (parts & 2) for (int m = gw; m < MTOK; m += NGW) {
        const f32x4* xr = (const f32x4*)(a->in[I_X] + (size_t)m * DM) + lane0; float ss = 0.f; f32x4 v[16];
#pragma unroll
        for (int j = 0; j < 16; ++j) { v[j] = xr[64 * j]; ss += (v[j][0] * v[j][0] + v[j][1] * v[j][1]) + (v[j][2] * v[j][2] + v[j][3] * v[j][3]); }
        ss = wave_sum(ss);
        u32x2* o = (u32x2*)((bf16_t*)(F.ws + WS_XB) + (size_t)m * DM) + lane0;
#pragma unroll
        for (int j = 0; j < 16; ++j) { u32x2 w; w.x = pk2(v[j][0], v[j][1]); w.y = pk2(v[j][2], v[j][3]); o[64 * j] = w; }
        ((float*)(F.ws + WS_SSQX))[(size_t)m * 64 + lane0] = (lane0 == 0) ? ss : 0.f;
    }
    constexpr int I_IN = (DM / 64) * (NPROJ / 64), I_GLU = (DS / 64) * (DS / 64), I_OUT = (DM / 64) * (DM / 64), I_L = I_IN + I_GLU + I_OUT;
    if (parts & 4) for (int it = gw; it < DEPTH * I_L; it += NGW) {
        const int l = it / I_L; int r = it % I_L;
        if (r < I_IN) { transpose_item(a->in[I_WIN] + (size_t)l * DM * NPROJ, DM, NPROJ, (bf16_t*)(F.ws + WS_WTIN) + (size_t)l * NPROJ * DM, a->in[I_NORMW] + l * DM, a->in[I_NORMW] + l * DM, 1 << 30, 1, r, lane0); continue; } r -= I_IN;
        if (r < I_GLU) { transpose_item(a->in[I_WGLU] + (size_t)l * DS * DS, DS, DS, (bf16_t*)(F.ws + WS_WTGLU) + (size_t)l * DS * DS, nullptr, nullptr, 1 << 30, 0, r, lane0); continue; } r -= I_GLU;
        transpose_item(a->in[I_WOUT] + (size_t)l * DM * DM, DM, DM, (bf16_t*)(F.ws + WS_WTOUT) + (size_t)l * DM * DM, a->in[I_SNW] + l * DS, a->in[I_RNW] + l * DR, DS, 0, r, lane0);
    }
}

__device__ __forceinline__ void stash_rstd(const Frame& F, const float* slots, int nslot, int panel, float inv_dim) {
    const int tid = fresh_tid(F);
    __syncthreads();
    if (tid < 256) { const f32x4* p = (const f32x4*)(slots + (size_t)(panel * 256 + tid) * nslot); float s = 0.f;
        for (int j = 0; j < nslot / 4; ++j) { const f32x4 t = p[j]; s += (t[0] + t[1]) + (t[2] + t[3]); }
        ((LAS float*)(F.lds + STASH_OFF))[tid] = __builtin_amdgcn_rsqf(s * inv_dim + EPS); }
    __syncthreads();
}

__device__ __forceinline__ void p1_inproj(const Frame& F, int l) {
    const bf16_t* xb = (const bf16_t*)(F.ws + WS_XB); const bf16_t* wt = (const bf16_t*)(F.ws + WS_WTIN) + (size_t)l * NPROJ * DM;
    const LAS float* rs = (const LAS float*)(F.lds + STASH_OFF);
    { pg8::StaticOrder S; S.init(MTOK, 10240, F.G, F.bid); Unit u0; S.next(0, u0);
      stash_rstd(F, (const float*)(F.ws + WS_SSQX), 64, u0.pm, 1.f / DM);
      pg8::Gemm g{xb, wt, DM, DM, DM, -1};
      EpiInProj E{rs, (bf16_t*)(F.ws + WS_A2U), (bf16_t*)(F.ws + WS_GS), (bf16_t*)(F.ws + WS_Q), (bf16_t*)(F.ws + WS_K), (bf16_t*)(F.ws + WS_GR), (const float*)(F.ws + WS_ROPE)};
      pg8::gemm_phase<EpiInProj, pg8::StaticOrder, true, true>(F.lds, g, S, E, fresh_tid(F)); }
    { pg8::StaticOrder S; S.init(DR, MTOK, F.G, F.bid); Unit u0; S.next(0, u0);
      stash_rstd(F, (const float*)(F.ws + WS_SSQX), 64, u0.pn, 1.f / DM);
      pg8::Gemm g{wt + (size_t)10240 * DM, xb, DM, DM, DM, -1};
      EpiVT E{rs, (bf16_t*)(F.ws + WS_VT)};
      pg8::gemm_phase<EpiVT, pg8::StaticOrder, true, true>(F.lds, g, S, E, fresh_tid(F)); }
}

__device__ __forceinline__ void p2_ssm(const Frame& F, ArgsP a, int l) {
    for (int it = F.vcu; it < NG * 2; it += F.G) {
        const int g = it >> 1, bp = it & 1, lg = l * NG + g;
        bf16_t* a2g = (bf16_t*)(F.ws + WS_A2U) + (size_t)g * 512 * A2LD;
        { pg8::Gemm g1{a2g, (const bf16_t*)(F.ws + WS_PM) + (size_t)lg * 256 * 256, 256, A2LD, 256, -1}; pg8::OneUnit S{bp, 0}; EpiSloc E{};
          pg8::gemm_phase<EpiSloc, pg8::OneUnit, false, true>(F.lds, g1, S, E, fresh_tid(F)); }
        LDS_WAIT(); __syncthreads();
        int t2 = fresh_tid(F); asm volatile("" : "+v"(t2));
        if (t2 < 128) {
            const int bb = t2 >> 6, n = t2 & 63; const float2 a16 = ((const float2*)(F.ws + WS_A16))[lg * 64 + n];
            const LAS float* S = (const LAS float*)F.lds + (bb * 128) * SLD; bf16_t* dst = a2g + (size_t)(bp * 256 + bb * 128) * A2LD + 256 + n;
            float sr = 0.f, si = 0.f;
#pragma unroll 8
            for (int c = 0; c < 128; ++c) { dst[(size_t)c * A2LD] = (bf16_t)f2bf(sr); dst[(size_t)c * A2LD + 64] = (bf16_t)f2bf(si);
                const float lr = S[c * SLD + n], li = S[c * SLD + 64 + n]; const float nr = a16.x * sr - a16.y * si + lr, ni = a16.x * si + a16.y * sr + li; sr = nr; si = ni; }
        }
        VM_WAIT(); __syncthreads();
        if (t2 == 0) { __builtin_amdgcn_fence(__ATOMIC_ACQUIRE, "agent"); VM_WAIT(); }
        __syncthreads();
        { pg8::Gemm g2{a2g, (const bf16_t*)(F.ws + WS_BT2) + (size_t)lg * 256 * A2LD, A2LD, A2LD, A2LD, -1}; pg8::OneUnit S{bp, 0};
          EpiSsmOut E{a2g, a->in[I_D] + (size_t)l * DS + g * 16, (bf16_t*)(F.ws + WS_YG), g};
          pg8::gemm_phase<EpiSsmOut, pg8::OneUnit, false, true>(F.lds, g2, S, E, fresh_tid(F)); }
        __syncthreads();
    }
}


typedef float f32x16 __attribute__((ext_vector_type(16)));
constexpr int RT_K0 = 0, RT_V0 = 65536, RT_P = 131072, RT_RED = 147456, RT_OLD = 528;
#define RT_BAR() do { asm volatile("s_waitcnt lgkmcnt(0)" ::: "memory"); __builtin_amdgcn_s_barrier(); asm volatile("" ::: "memory"); } while (0)
__device__ __forceinline__ void p2_ret(const Frame& F) {
    int t_ = fresh_tid(F); asm volatile("" : "+v"(t_));
    const int tid = t_, lane = tid & 63, w = F.wave, wr = w & 3, wc = w >> 2, l31 = lane & 31, hh = lane >> 5;
    LAS unsigned char* lds = F.lds;
    const bf16_t* qg = (const bf16_t*)(F.ws + WS_Q); const bf16_t* kg = (const bf16_t*)(F.ws + WS_K); const bf16_t* vtg = (const bf16_t*)(F.ws + WS_VT);
    const bf16_t* grg = (const bf16_t*)(F.ws + WS_GR); bf16_t* ycat = (bf16_t*)(F.ws + WS_YCAT);
    const unsigned koff = (unsigned)((2 * w + hh) * 4096 + ((l31 ^ ((2 * w + hh) & 15)) << 4));
    const unsigned voff = (unsigned)((8 * w + (lane >> 3)) * 16384 + (((lane & 7) ^ (((lane >> 4) + 4 * w) & 7)) << 4));
    for (int it = F.vcu; it < BATCH * RH * 8; it += F.G) {
        const int bh = it >> 3, p = it & 7, b = bh >> 3, h = bh & 7;
        const float e = __builtin_amdgcn_exp2f((float)(-5 - h));
        const float lg2 = -(e * (1.f + e * (0.5f + e * (0.33333334f + e * (0.25f + e * (0.2f + e * 0.16666667f)))))) * 1.4426950408889634f;
        for (int uu = 0; uu < 2; ++uu) {
            const int qi = uu ? p : 15 - p, ntile = 2 * (qi + 1);
            const size_t tokq = (size_t)b * SEQ + qi * 128;
            bf16x8 qf[16];
            { const bf16_t* qp = qg + (tokq + wr * 32 + l31) * DR + h * 256 + 8 * hh;
#pragma unroll
              for (int s = 0; s < 16; ++s) qf[s] = *(const bf16x8*)(qp + 16 * s); }
            f32x16 oacc[4];
#pragma unroll
            for (int db = 0; db < 4; ++db)
#pragma unroll
                for (int r = 0; r < 16; ++r) oacc[db][r] = 0.f;
#define RT_DMA(kt_, bf_) do { const char* kb_ = (const char*)(kg + ((size_t)(b * SEQ + (kt_) * 64) * DR + h * 256)) + koff; const char* vb_ = (const char*)(vtg + ((size_t)(h * 256) * MTOK + b * SEQ + (kt_) * 64)) + voff; \
            _Pragma("unroll") for (int i_ = 0; i_ < 4; ++i_) __builtin_amdgcn_global_load_lds((const unsigned*)(kb_ + i_ * 65536), (LAS unsigned*)(lds + RT_K0 + (bf_) * 32768 + (w + 8 * i_) * 1024), 16, 0, 0); \
            _Pragma("unroll") for (int i_ = 0; i_ < 4; ++i_) __builtin_amdgcn_global_load_lds((const unsigned*)(vb_ + i_ * 1048576), (LAS unsigned*)(lds + RT_V0 + (bf_) * 32768 + (w + 8 * i_) * 1024), 16, 0, 0); } while (0)
            RT_DMA(0, 0);
            asm volatile("s_waitcnt vmcnt(0)" ::: "memory"); RT_BAR();
            for (int kt = 0; kt < ntile; ++kt) {
                const int bf = kt & 1;
                if (kt + 1 < ntile) RT_DMA(kt + 1, bf ^ 1);
                int lo_ = lane; asm volatile("" : "+v"(lo_));
                const int l31 = lo_ & 31, hh = lo_ >> 5, x15 = l31 & 15, m4 = ((l31 >> 1) & 7) << 4, lane = lo_;
                f32x16 st;
#pragma unroll
                for (int r = 0; r < 16; ++r) st[r] = 0.f;
                { const LAS unsigned char* kb = lds + RT_K0 + bf * 32768 + (32 * wc + l31) * 512;
#define RT_KRD(dst, s0) do { _Pragma("unroll") for (int j_ = 0; j_ < 4; ++j_) dst[j_] = *(const LAS bf16x8*)(kb + ((((2 * ((s0) + j_)) | hh) ^ x15) << 4)); } while (0)
#define RT_KMM(src, s0) do { _Pragma("unroll") for (int j_ = 0; j_ < 4; ++j_) st = __builtin_amdgcn_mfma_f32_32x32x16_bf16(src[j_], qf[(s0) + j_], st, 0, 0, 0); } while (0)
                  bf16x8 ka[4], kc[4];
                  RT_KRD(ka, 0); __builtin_amdgcn_sched_barrier(0);
                  RT_KRD(kc, 4); RT_KMM(ka, 0); __builtin_amdgcn_sched_barrier(0);
                  RT_KRD(ka, 8); RT_KMM(kc, 4); __builtin_amdgcn_sched_barrier(0);
                  RT_KRD(kc, 12); RT_KMM(ka, 8); __builtin_amdgcn_sched_barrier(0);
                  RT_KMM(kc, 12); __builtin_amdgcn_sched_barrier(0);
#undef RT_KRD
#undef RT_KMM
                }
                { const bool diag = kt >= 2 * qi;
                  unsigned pk[8];
                  if (!diag) { const float tf = __builtin_amdgcn_exp2f((float)(128 * (qi - (kt >> 1))) * lg2);
#pragma unroll
                      for (int i = 0; i < 8; ++i) pk[i] = cvt_pk_bf16(st[2 * i] * tf, st[2 * i + 1] * tf);
                  } else { const int lim = wr * 32 + l31 + (2 * qi - kt) * 64 - 32 * wc - 4 * hh;
#pragma unroll
                      for (int i = 0; i < 8; ++i) { const int r0 = 2 * i, r1 = 2 * i + 1, o0 = (r0 & 3) + 8 * (r0 >> 2), o1 = (r1 & 3) + 8 * (r1 >> 2);
                          pk[i] = cvt_pk_bf16((o0 <= lim) ? st[r0] : 0.f, (o1 <= lim) ? st[r1] : 0.f); } }
                  LAS unsigned char* pw = lds + RT_P + ((wr * 2 + wc) * 2) * 1024 + lane * 16;
                  *(LAS u32x4*)pw = (u32x4){pk[0], pk[1], pk[2], pk[3]}; *(LAS u32x4*)(pw + 1024) = (u32x4){pk[4], pk[5], pk[6], pk[7]}; }
                RT_BAR();
                { bf16x8 pf[2][2];
#pragma unroll
                  for (int kb2 = 0; kb2 < 2; ++kb2)
#pragma unroll
                      for (int s = 0; s < 2; ++s) pf[kb2][s] = *(const LAS bf16x8*)(lds + RT_P + ((wr * 2 + kb2) * 2 + s) * 1024 + lane * 16);
                  const LAS unsigned char* vb = lds + RT_V0 + bf * 32768 + (128 * wc + l31) * 128 + 8 * hh;
#define RT_VRD(dst, db) do { _Pragma("unroll") for (int j_ = 0; j_ < 4; ++j_) { const int v_ = 4 * (j_ >> 1) + 2 * (j_ & 1); \
                      const u32x2 lo_ = *(const LAS u32x2*)(vb + (db) * 4096 + ((v_ << 4) ^ m4)), hi_ = *(const LAS u32x2*)(vb + (db) * 4096 + (((v_ + 1) << 4) ^ m4)); \
                      dst[j_] = (u32x4){lo_.x, lo_.y, hi_.x, hi_.y}; } } while (0)
#define RT_VMM(src, db) do { _Pragma("unroll") for (int j_ = 0; j_ < 4; ++j_) oacc[db] = __builtin_amdgcn_mfma_f32_32x32x16_bf16(pf[j_ >> 1][j_ & 1], __builtin_bit_cast(bf16x8, src[j_]), oacc[db], 0, 0, 0); } while (0)
                  u32x4 va[4], vc[4];
                  RT_VRD(va, 0); __builtin_amdgcn_sched_barrier(0);
                  RT_VRD(vc, 1); RT_VMM(va, 0); __builtin_amdgcn_sched_barrier(0);
                  RT_VRD(va, 2); RT_VMM(vc, 1); __builtin_amdgcn_sched_barrier(0);
                  RT_VRD(vc, 3); RT_VMM(va, 2); __builtin_amdgcn_sched_barrier(0);
                  RT_VMM(vc, 3); __builtin_amdgcn_sched_barrier(0);
#undef RT_VRD
#undef RT_VMM
                }
                asm volatile("s_waitcnt vmcnt(0)" ::: "memory"); RT_BAR();
            }
            int le_ = tid; asm volatile("" : "+v"(le_));
            const int tide = le_, l31e = le_ & 31, hhe = (le_ >> 5) & 1;
            float ssr[16];
#pragma unroll
            for (int r = 0; r < 16; ++r) { float s2 = 0.f;
#pragma unroll
                for (int db = 0; db < 4; ++db) { const float o = oacc[db][r]; s2 += o * o; }
                s2 = xor_add<1>(s2); s2 = xor_add<2>(s2); s2 = xor_add<4>(s2); s2 = xor_add<8>(s2); s2 = xor_add<16>(s2); ssr[r] = s2; }
            if (l31e == 0) {
#pragma unroll
                for (int i = 0; i < 4; ++i) *(LAS f32x4*)(lds + RT_RED + w * 128 + hhe * 64 + i * 16) = (f32x4){ssr[4 * i], ssr[4 * i + 1], ssr[4 * i + 2], ssr[4 * i + 3]}; }
            RT_BAR();
#pragma unroll
            for (int i = 0; i < 4; ++i) { const f32x4 t = *(const LAS f32x4*)(lds + RT_RED + (w ^ 4) * 128 + hhe * 64 + i * 16);
#pragma unroll
                for (int j = 0; j < 4; ++j) ssr[4 * i + j] = __builtin_amdgcn_rsqf((ssr[4 * i + j] + t[j]) * (1.f / 256.f) + EPS); }
#pragma unroll
            for (int r = 0; r < 16; ++r) { LAS unsigned char* ow = lds + (wr * 32 + 4 * hhe + (r & 3) + 8 * (r >> 2)) * RT_OLD + (128 * wc + l31e) * 2;
#pragma unroll
                for (int db = 0; db < 4; ++db) *(LAS unsigned short*)(ow + db * 64) = (unsigned short)f2bf(oacc[db][r] * ssr[r]); }
            RT_BAR();
#pragma unroll
            for (int i = 0; i < 8; ++i) { const int idx = i * 512 + tide, row = idx >> 5, ch = idx & 31; const size_t tok = tokq + row;
                const u32x4 o = *(const LAS u32x4*)(lds + row * RT_OLD + ch * 16), gv = *(const u32x4*)(grg + tok * DR + h * 256 + ch * 8);
                u32x4 y;
                y.x = cvt_pk_bf16(bf2f(o.x & 0xffffu) * bf2f(gv.x & 0xffffu), bf2f(o.x >> 16) * bf2f(gv.x >> 16)); y.y = cvt_pk_bf16(bf2f(o.y & 0xffffu) * bf2f(gv.y & 0xffffu), bf2f(o.y >> 16) * bf2f(gv.y >> 16));
                y.z = cvt_pk_bf16(bf2f(o.z & 0xffffu) * bf2f(gv.z & 0xffffu), bf2f(o.z >> 16) * bf2f(gv.z >> 16)); y.w = cvt_pk_bf16(bf2f(o.w & 0xffffu) * bf2f(gv.w & 0xffffu), bf2f(o.w >> 16) * bf2f(gv.w >> 16));
                *(u32x4*)(ycat + tok * DM + DS + h * 256 + ch * 8) = y; }
            asm volatile("s_waitcnt vmcnt(0)" ::: "memory"); RT_BAR();
#undef RT_DMA
        }
    }
}

__device__ __forceinline__ void p3_glu(const Frame& F, ArgsP a, int l) {
    pg8::StaticOrder S; S.init(MTOK, DS, F.G, F.bid);
    pg8::Gemm g{(const bf16_t*)(F.ws + WS_YG), (const bf16_t*)(F.ws + WS_WTGLU) + (size_t)l * DS * DS, DS, DS, DS, -1};
    EpiGlu E{(const bf16_t*)(F.ws + WS_YG), (const bf16_t*)(F.ws + WS_GS), a->in[I_BGLU] + (size_t)l * DS, (bf16_t*)(F.ws + WS_YCAT), (float*)(F.ws + WS_SSQ2)};
    pg8::gemm_phase<EpiGlu, pg8::StaticOrder, true, true>(F.lds, g, S, E, fresh_tid(F));
}

__device__ __forceinline__ void p4_out(const Frame& F, ArgsP a, int l) {
    pg8::StaticOrder S; S.init(MTOK, DM, F.G, F.bid); Unit u0; S.next(0, u0);
    stash_rstd(F, (const float*)(F.ws + WS_SSQ2), 32, u0.pm, 1.f / DS);
    pg8::Gemm g{(const bf16_t*)(F.ws + WS_YCAT), (const bf16_t*)(F.ws + WS_WTOUT) + (size_t)l * DM * DM, DM, DM, DM, DS / 64};
    if (l == 0) { EpiOut<false> E{(const LAS float*)(F.lds + STASH_OFF), a->in[I_X], (bf16_t*)(F.ws + WS_XB), (float*)(F.ws + WS_SSQX)};
        pg8::gemm_phase<EpiOut<false>, pg8::StaticOrder, true, true>(F.lds, g, S, E, fresh_tid(F)); }
    else { EpiOut<true> E{(const LAS float*)(F.lds + STASH_OFF), (const void*)(F.ws + WS_XB), (bf16_t*)(F.ws + WS_XB), (float*)(F.ws + WS_SSQX)};
        pg8::gemm_phase<EpiOut<true>, pg8::StaticOrder, true, true>(F.lds, g, S, E, fresh_tid(F)); }
}

__device__ __forceinline__ void p5_final(const Frame& F, ArgsP a) {
    const int lane0 = fresh_tid(F) & 63;
    const int gw = F.vcu * 8 + F.wave, NGW = F.G * 8; const f32x4* fw = (const f32x4*)a->in[I_FNW];
    for (int m = gw; m < MTOK; m += NGW) {
        const float s = wave_sum(((const float*)(F.ws + WS_SSQX))[(size_t)m * 64 + lane0]); const float rstd = __builtin_amdgcn_rsqf(s * (1.f / DM) + EPS);
        const u32x4* xr = (const u32x4*)((const bf16_t*)(F.ws + WS_XB) + (size_t)m * DM) + lane0; f32x4* orow = (f32x4*)(a->out + (size_t)m * DM);
#pragma unroll
        for (int j = 0; j < 8; ++j) { const u32x4 v = xr[64 * j]; const int c4 = (64 * j + lane0) * 2;
            const f32x4 w0 = fw[c4], w1 = fw[c4 + 1];
            orow[c4] = (f32x4){bf2f(v.x & 0xffffu), bf2f(v.x >> 16), bf2f(v.y & 0xffffu), bf2f(v.y >> 16)} * rstd * w0;
            orow[c4 + 1] = (f32x4){bf2f(v.z & 0xffffu), bf2f(v.z >> 16), bf2f(v.w & 0xffffu), bf2f(v.w >> 16)} * rstd * w1; }
    }
}

constexpr int NPH = 2 + 4 * DEPTH;
__global__ void __launch_bounds__(512, 2) mk_fwd(Args args) {
    extern __shared__ __attribute__((aligned(16))) unsigned char lds_raw[];
    cg::grid_group grid = cg::this_grid();
    Frame F; F.lds = (LAS unsigned char*)lds_raw; F.G = gridDim.x;
    const int wave0 = __builtin_amdgcn_readfirstlane((int)threadIdx.x >> 6);
    for (int ph = args.ph_lo; ph < args.ph_hi; ++ph) {
        ArgsP ap = (ArgsP)__builtin_amdgcn_kernarg_segment_ptr(); asm volatile("" : "+s"(ap));
        { F.wave = wave0;
          int b_ = blockIdx.x; asm volatile("" : "+s"(b_)); F.bid = b_; F.vcu = (F.G % 8 == 0) ? (b_ % 8) * (F.G / 8) + b_ / 8 : b_;
          size_t z_ = 0; asm volatile("" : "+s"(z_)); F.ws = ap->ws + z_; }
#ifndef PHMASK
#define PHMASK 127
#endif
        if (ph == 0) { if (PHMASK & 1) p0_prologue(F, ap); }
        else if (ph == NPH - 1) { if (PHMASK & 32) p5_final(F, ap); }
        else { const int l = (ph - 1) >> 2, s = (ph - 1) & 3;
            if (s == 0) { if (PHMASK & 2) p1_inproj(F, l); }
            else if (s == 1) {
#if FAST_SSM
                if (PHMASK & 4) p2_ssm(F, ap, l);
#endif
#if FAST_RET
                if (PHMASK & 64) p2_ret(F);
#endif
            }
            else if (s == 2) { if (PHMASK & 8) p3_glu(F, ap, l); }
            else { if (PHMASK & 16) p4_out(F, ap, l); } }
#ifdef REPEAT_MASK
        __syncthreads();
        { const int s2 = (ph - 1) & 3, l2 = (ph - 1) >> 2;
          if (ph == 0) { if (REPEAT_MASK & 1) p0_prologue(F, ap); if (REPEAT_MASK >> 8) p0_prologue(F, ap, REPEAT_MASK >> 8); }
          else if (ph < NPH - 1) {
            if (s2 == 0 && (REPEAT_MASK & 2)) p1_inproj(F, l2);
            if (s2 == 1 && (REPEAT_MASK & 4)) p2_ssm(F, ap, l2);
            if (s2 == 1 && (REPEAT_MASK & 64)) p2_ret(F);
            if (s2 == 2 && (REPEAT_MASK & 8)) p3_glu(F, ap, l2);
            if (s2 == 3 && (REPEAT_MASK & 16)) p4_out(F, ap, l2); } }
#endif
        if (ph + 1 < args.ph_hi) grid.sync();
    }
}

__global__ void __launch_bounds__(64) naive_ssm(Args args, int l) {
    const int b = blockIdx.x >> 7, g = blockIdx.x & 127, lg = l * NG + g, n = threadIdx.x;
    const double dt = (double)expf(args.in[I_LOGDT][lg]);
    const float lr = args.in[I_LRE][lg * 64 + n], li = args.in[I_LIM][lg * 64 + n];
    float ac, as; cis_d((double)li * dt, ac, as); const float mag = expf(lr * (float)dt); const float ar = mag * ac, ai = mag * as;
    const float nr = ar - 1.f, ni = ai, den = lr * lr + li * li, cor = (nr * lr + ni * li) / den, coi = (ni * lr - nr * li) / den;
    float bbr[16], bbi[16], cr[16], ci[16];
#pragma unroll
    for (int h = 0; h < 16; ++h) { const float br = args.in[I_BRE][(size_t)(lg * 64 + n) * 16 + h], bi = args.in[I_BIM][(size_t)(lg * 64 + n) * 16 + h];
        bbr[h] = cor * br - coi * bi; bbi[h] = cor * bi + coi * br; cr[h] = args.in[I_CRE][(size_t)(lg * 16 + h) * 64 + n]; ci[h] = args.in[I_CIM][(size_t)(lg * 16 + h) * 64 + n]; }
    const float dsk = args.in[I_D][(size_t)l * DS + g * 16 + (n & 15)];
    const bf16_t* a2g = (const bf16_t*)(args.ws + WS_A2U) + (size_t)g * 512 * A2LD; bf16_t* yg = (bf16_t*)(args.ws + WS_YG);
    float sr = 0.f, si = 0.f;
    for (int t = 0; t < SEQ; ++t) {
        const u32x4* up = (const u32x4*)(a2g + (size_t)(b * 128 + (t >> 4)) * A2LD + (t & 15) * 16); const u32x4 u0 = up[0], u1 = up[1];
        float uv[16];
        uv[0] = bf2f(u0.x & 0xffffu); uv[1] = bf2f(u0.x >> 16); uv[2] = bf2f(u0.y & 0xffffu); uv[3] = bf2f(u0.y >> 16); uv[4] = bf2f(u0.z & 0xffffu); uv[5] = bf2f(u0.z >> 16); uv[6] = bf2f(u0.w & 0xffffu); uv[7] = bf2f(u0.w >> 16);
        uv[8] = bf2f(u1.x & 0xffffu); uv[9] = bf2f(u1.x >> 16); uv[10] = bf2f(u1.y & 0xffffu); uv[11] = bf2f(u1.y >> 16); uv[12] = bf2f(u1.z & 0xffffu); uv[13] = bf2f(u1.z >> 16); uv[14] = bf2f(u1.w & 0xffffu); uv[15] = bf2f(u1.w >> 16);
        float bur = 0.f, bui = 0.f;
#pragma unroll
        for (int h = 0; h < 16; ++h) { bur += bbr[h] * uv[h]; bui += bbi[h] * uv[h]; }
        const float nsr = ar * sr - ai * si + bur, nsi = ar * si + ai * sr + bui; sr = nsr; si = nsi;
        float y = 0.f, um = 0.f;
#pragma unroll
        for (int h = 0; h < 16; ++h) { const float p = wave_sum(cr[h] * sr - ci[h] * si); if (n == h) { y = p; um = uv[h]; } }
        if (n < 16) yg[(size_t)(b * SEQ + t) * DS + g * 16 + n] = (bf16_t)f2bf(gelu_tanh_f(y + dsk * um));
    }
}

constexpr int NR_KLD = 264;
__global__ void __launch_bounds__(256) naive_ret(Args args, int l) {
    extern __shared__ __attribute__((aligned(16))) unsigned char sm[];
    bf16_t* Qs = (bf16_t*)sm;
    bf16_t* Ks = Qs + 32 * 256;
    float* Ss = (float*)(Ks + 64 * NR_KLD);
    float* red = Ss + 32 * 64;
    const int qt = blockIdx.x & 63, h = (blockIdx.x >> 6) & 7, b = blockIdx.x >> 9, tid = threadIdx.x, lane = tid & 63, wv = tid >> 6;
    const bf16_t* q = (const bf16_t*)(args.ws + WS_Q); const bf16_t* k = (const bf16_t*)(args.ws + WS_K); const bf16_t* vt = (const bf16_t*)(args.ws + WS_VT); const bf16_t* gr = (const bf16_t*)(args.ws + WS_GR);
    const int tok0 = b * SEQ + qt * 32;
    for (int e = tid; e < 32 * 32; e += 256) { const int r = e >> 5, c = (e & 31) * 8; *(u32x4*)(Qs + r * 256 + c) = *(const u32x4*)(q + (size_t)(tok0 + r) * DR + h * 256 + c); }
    const float lg2 = log2f(1.f - exp2f(-5.f - (float)h));
    float o[32];
#pragma unroll
    for (int r = 0; r < 32; ++r) o[r] = 0.f;
    const int ntile = qt / 2 + 1;
    for (int kt = 0; kt < ntile; ++kt) {
        __syncthreads();
        for (int e = tid; e < 64 * 32; e += 256) { const int r = e >> 5, c = (e & 31) * 8; *(u32x4*)(Ks + r * NR_KLD + c) = *(const u32x4*)(k + (size_t)(b * SEQ + kt * 64 + r) * DR + h * 256 + c); }
        __syncthreads();
        { const int key = lane, rg = wv; float acc[8];
#pragma unroll
          for (int r = 0; r < 8; ++r) acc[r] = 0.f;
          for (int d = 0; d < 256; d += 8) { const u32x4 kv = *(const u32x4*)(Ks + key * NR_KLD + d);
              const float k0 = bf2f(kv.x & 0xffffu), k1 = bf2f(kv.x >> 16), k2 = bf2f(kv.y & 0xffffu), k3 = bf2f(kv.y >> 16), k4 = bf2f(kv.z & 0xffffu), k5 = bf2f(kv.z >> 16), k6 = bf2f(kv.w & 0xffffu), k7 = bf2f(kv.w >> 16);
#pragma unroll
              for (int r = 0; r < 8; ++r) { const u32x4 qv = *(const u32x4*)(Qs + (rg * 8 + r) * 256 + d);
                  acc[r] += bf2f(qv.x & 0xffffu) * k0 + bf2f(qv.x >> 16) * k1 + bf2f(qv.y & 0xffffu) * k2 + bf2f(qv.y >> 16) * k3 + bf2f(qv.z & 0xffffu) * k4 + bf2f(qv.z >> 16) * k5 + bf2f(qv.w & 0xffffu) * k6 + bf2f(qv.w >> 16) * k7; } }
#pragma unroll
          for (int r = 0; r < 8; ++r) { const int i = qt * 32 + rg * 8 + r, j = kt * 64 + key; Ss[(rg * 8 + r) * 64 + key] = (i >= j) ? acc[r] * exp2f((float)(128 * ((i >> 7) - (j >> 7))) * lg2) : 0.f; } }
        __syncthreads();
        { const bf16_t* vr = vt + (size_t)(h * 256 + tid) * MTOK + b * SEQ + kt * 64;
          for (int kk = 0; kk < 64; kk += 8) { const u32x4 vv = *(const u32x4*)(vr + kk);
              const float v0 = bf2f(vv.x & 0xffffu), v1 = bf2f(vv.x >> 16), v2 = bf2f(vv.y & 0xffffu), v3 = bf2f(vv.y >> 16), v4 = bf2f(vv.z & 0xffffu), v5 = bf2f(vv.z >> 16), v6 = bf2f(vv.w & 0xffffu), v7 = bf2f(vv.w >> 16);
#pragma unroll
              for (int r = 0; r < 32; ++r) { const f32x4 s0 = *(const f32x4*)(Ss + r * 64 + kk), s1 = *(const f32x4*)(Ss + r * 64 + kk + 4);
                  o[r] += s0[0] * v0 + s0[1] * v1 + s0[2] * v2 + s0[3] * v3 + s1[0] * v4 + s1[1] * v5 + s1[2] * v6 + s1[3] * v7; } } }
    }
    __syncthreads();
#pragma unroll
    for (int r = 0; r < 32; ++r) { const float p = wave_sum(o[r] * o[r]); if (lane == 0) red[r * 4 + wv] = p; }
    __syncthreads();
    bf16_t* ycat = (bf16_t*)(args.ws + WS_YCAT);
#pragma unroll
    for (int r = 0; r < 32; ++r) { const float ss = (red[r * 4] + red[r * 4 + 1]) + (red[r * 4 + 2] + red[r * 4 + 3]); const float rstd = __builtin_amdgcn_rsqf(ss * (1.f / 256.f) + EPS);
        const size_t tok = (size_t)(tok0 + r); ycat[tok * DM + DS + h * 256 + tid] = (bf16_t)f2bf(o[r] * rstd * bf2f(gr[tok * DR + h * 256 + tid])); }
}

extern "C" void kernel_launch(void* const* d_in, const int* in_sizes, int n_in, void* d_out, int out_size, void* d_ws, size_t ws_size, hipStream_t stream) {
    static int grid = 0;
    if (grid == 0) {
        if (n_in != 17 || in_sizes[0] != MTOK * DM || out_size != MTOK * DM || ws_size < WS_END) { fprintf(stderr, "kernel_launch: unexpected problem (n_in %d, x %d, out %d, ws %zu)\n", n_in, n_in > 0 ? in_sizes[0] : -1, out_size, ws_size); grid = -1; return; }
        int dev = 0, cus = 0, per_cu = 0;
        hipGetDevice(&dev); hipDeviceGetAttribute(&cus, hipDeviceAttributeMultiprocessorCount, dev);
        if (hipFuncSetAttribute((const void*)mk_fwd, hipFuncAttributeMaxDynamicSharedMemorySize, LDS_BYTES) != hipSuccess) { fprintf(stderr, "kernel_launch: hipFuncSetAttribute failed\n"); grid = -1; return; }
        hipFuncSetAttribute((const void*)naive_ret, hipFuncAttributeMaxDynamicSharedMemorySize, 65536);
        hipOccupancyMaxActiveBlocksPerMultiprocessor(&per_cu, (const void*)mk_fwd, 512, LDS_BYTES);
        (void)hipGetLastError();
        if (per_cu < 1) fprintf(stderr, "kernel_launch: occupancy query says %d blocks per CU\n", per_cu);
        grid = cus;
        if (grid != 256) fprintf(stderr, "kernel_launch: %d CUs (phase balance assumes 256)\n", grid);
        for (int c = 0; c < grid; ++c) { pg8::StaticOrder S; Unit u0, u;
            S.init(MTOK, 10240, grid, c); S.next(0, u0); for (int i = 1; S.next(i, u); ++i) if (u.pm != u0.pm) { fprintf(stderr, "kernel_launch: in-proj unit order breaks the one-panel-per-workgroup assumption\n"); grid = -1; return; }
            S.init(DR, MTOK, grid, c); S.next(0, u0); for (int i = 1; S.next(i, u); ++i) if (u.pn != u0.pn) { fprintf(stderr, "kernel_launch: V^T unit order breaks the assumption\n"); grid = -1; return; }
            S.init(MTOK, DM, grid, c); S.next(0, u0); for (int i = 1; S.next(i, u); ++i) if (u.pm != u0.pm) { fprintf(stderr, "kernel_launch: out-proj unit order breaks the assumption\n"); grid = -1; return; } }
    }
    if (grid < 0) return;
    Args a{};
    for (int i = 0; i < 17; ++i) a.in[i] = (const float*)d_in[i];
    a.out = (float*)d_out; a.ws = (unsigned char*)d_ws;
    auto launch = [&](int lo, int hi) { a.ph_lo = lo; a.ph_hi = hi; void* kargs[] = {&a};
        hipError_t e = hipLaunchCooperativeKernel((const void*)mk_fwd, dim3(grid), dim3(512), kargs, LDS_BYTES, stream);
        if (e != hipSuccess) fprintf(stderr, "kernel_launch: cooperative launch [%d,%d) failed: %s\n", lo, hi, hipGetErrorString(e)); };
#if FAST_SSM && FAST_RET && ONE_LAUNCH
    launch(0, NPH);
#else
    launch(0, 1);
    for (int l = 0; l < DEPTH; ++l) {
        launch(1 + 4 * l, 2 + 4 * l);
        launch(2 + 4 * l, 3 + 4 * l);
#if !FAST_SSM
        hipLaunchKernelGGL(naive_ssm, dim3(BATCH * NG), dim3(64), 0, stream, a, l);
#endif
#if !FAST_RET
        hipLaunchKernelGGL(naive_ret, dim3(BATCH * RH * 64), dim3(256), 32 * 256 * 2 + 64 * NR_KLD * 2 + 32 * 64 * 4 + 32 * 4 * 4, stream, a, l);
#endif
        launch(3 + 4 * l, 4 + 4 * l);
        launch(4 + 4 * l, 5 + 4 * l);
    }
    launch(NPH - 1, NPH);
#endif
}
```

```cpp
#include <hip/hip_runtime.h>
#include <cstdio>
#include <cstdint>

#ifndef FAST_SSM
#define FAST_SSM 1
#endif
#ifndef FAST_RET
#define FAST_RET 1
#endif

#ifndef ONE_LAUNCH
#define ONE_LAUNCH 1
#endif

#define LAS __attribute__((address_space(3)))
typedef unsigned short bf16_t;
typedef short bf16x8 __attribute__((ext_vector_type(8)));
typedef float f32x4 __attribute__((ext_vector_type(4)));
typedef float f32x2 __attribute__((ext_vector_type(2)));
typedef unsigned u32x4 __attribute__((ext_vector_type(4)));
typedef unsigned u32x2 __attribute__((ext_vector_type(2)));

constexpr int BATCH = 4, SEQ = 2048, DM = 4096, DEPTH = 2, DS = 2048, DR = 2048, NG = 128, SG = 16, NST = 64, RH = 8, RD = 256;
constexpr int NPROJ = 12288, MTOK = BATCH * SEQ;
constexpr float EPS = 1e-6f;
constexpr int TCH = 16;
constexpr int A2LD = 384;

constexpr size_t MiB = 1u << 20;
constexpr size_t WS_CTL = 0;
constexpr size_t WS_WTIN = 16 * MiB;
constexpr size_t WS_WTGLU = 208 * MiB;
constexpr size_t WS_WTOUT = 224 * MiB;
constexpr size_t WS_BT2 = 288 * MiB;
constexpr size_t WS_PM = 336 * MiB;
constexpr size_t WS_A16 = 368 * MiB;
constexpr size_t WS_ROPE = 369 * MiB;
constexpr size_t WS_SSQX = 371 * MiB;
constexpr size_t WS_SSQ2 = 373 * MiB;
constexpr size_t WS_XB = 384 * MiB;
constexpr size_t WS_X1 = 448 * MiB;
constexpr size_t WS_A2U = 576 * MiB;
constexpr size_t WS_GS = 624 * MiB, WS_Q = 656 * MiB, WS_K = 688 * MiB, WS_VT = 720 * MiB, WS_GR = 752 * MiB, WS_YG = 784 * MiB;
constexpr size_t WS_YCAT = 816 * MiB;
constexpr size_t WS_END = 880 * MiB;

constexpr int RING_BYTES = 131072;
constexpr int STASH_OFF = 155648;
constexpr int BAR_ST_OFF = 157696;
constexpr int LDS_BYTES = 163840 - 4096;

__device__ __forceinline__ unsigned f2bf(float f) { unsigned u = __builtin_bit_cast(unsigned, f); return (u + 0x7fffu + ((u >> 16) & 1u)) >> 16; }
__device__ __forceinline__ unsigned pk2(float lo, float hi) { return f2bf(lo) | (f2bf(hi) << 16); }
__device__ __forceinline__ float bf2f(unsigned v) { return __builtin_bit_cast(float, v << 16); }
__device__ __forceinline__ unsigned cvt_pk_bf16(float lo, float hi) { unsigned r; asm volatile("v_cvt_pk_bf16_f32 %0, %1, %2" : "=v"(r) : "v"(lo), "v"(hi)); return r; }
__device__ __forceinline__ float silu_f(float x) { return x * __builtin_amdgcn_rcpf(1.f + __expf(-x)); }
__device__ __forceinline__ float sigmoid_f(float x) { return __builtin_amdgcn_rcpf(1.f + __expf(-x)); }
__device__ __forceinline__ float gelu_tanh_f(float x) {
    const float z = 0.7978845608028654f * (x + 0.044715f * x * x * x);
    const float th = 1.f - 2.f * __builtin_amdgcn_rcpf(1.f + __expf(2.f * z));
    return 0.5f * x * (1.f + th);
}
template <int X> __device__ __forceinline__ float xor_add(float v) {
    if constexpr (X == 32) { const unsigned u = __builtin_bit_cast(unsigned, v); auto r = __builtin_amdgcn_permlane32_swap(u, u, false, false);
        return __builtin_bit_cast(float, (unsigned)r[0]) + __builtin_bit_cast(float, (unsigned)r[1]); }
    else return v + __builtin_bit_cast(float, __builtin_amdgcn_ds_swizzle(__builtin_bit_cast(int, v), (X << 10) | 0x1f));
}
__device__ __forceinline__ float wave_sum(float v) {
    v = xor_add<1>(v); v = xor_add<2>(v); v = xor_add<4>(v); v = xor_add<8>(v); v = xor_add<16>(v); v = xor_add<32>(v);
    return v;
}
__device__ __forceinline__ void cis_d(double ph, float& c, float& s) {
    const double rv = ph * 0.15915494309189535;
    const float r = (float)(rv - __builtin_rint(rv));
    c = __builtin_amdgcn_cosf(r); s = __builtin_amdgcn_sinf(r);
}
#define LDS_WAIT() asm volatile("s_waitcnt lgkmcnt(0)" ::: "memory")
#define VM_WAIT() asm volatile("s_waitcnt vmcnt(0)" ::: "memory")

namespace pg8 {
constexpr int BM = 256, BK = 64, HALF = 128, HTB = HALF * BK * 2, STAGE_BYTES = 8 * HTB, NXCD = 8, WGM = 8;
__host__ __device__ __forceinline__ int lds_byte(int r, int c) { const int st = (r >> 4) * 2 + (c >> 5), rr = r & 15, cc = c & 31, ob = rr * 64 + cc * 2; return st * 1024 + (ob ^ (((ob >> 9) & 1) << 5)); }
__host__ __device__ __forceinline__ void stage_rc(int b, int& R, int& C) { const int st = b / 1024, sb = b % 1024, swz = sb ^ (((sb >> 9) & 1) << 5); R = (st >> 1) * 16 + swz / 64; C = (st & 1) * 32 + (swz % 64) / 2; }
__host__ __device__ __forceinline__ int perm32(int rho) { const int n = rho >> 4, i = rho & 15; return 8 * (i >> 2) + 4 * n + (i & 3); }

struct Unit { int pm, pn; };
struct Gemm { const bf16_t* A; const bf16_t* Bt; int K, lda, ldb, kmid; };

struct StaticOrder {
    int nM, nN, nwg, G, c;
    __host__ __device__ void init(int M, int N, int G_, int c_) { nM = M / BM; nN = N / BM; nwg = nM * nN; G = G_; c = c_; }
    __host__ __device__ bool next(int i, Unit& u) const {
        const long L = (long)i * G + c; if (L >= nwg) return false;
        int wgid = (int)L; { const int q = nwg / NXCD, r = nwg % NXCD, xcd = wgid % NXCD, off = wgid / NXCD; wgid = (xcd < r ? xcd * (q + 1) : r * (q + 1) + (xcd - r) * q) + off; }
        const int nig = WGM * nN, gid = wgid / nig, fm = gid * WGM, gsz = (nM - fm) < WGM ? (nM - fm) : WGM;
        u.pm = fm + ((wgid % nig) % gsz); u.pn = (wgid % nig) / gsz; return true;
    }
};
struct OneUnit {
    int pm, pn;
    __device__ __forceinline__ bool next(int i, Unit& u) const { if (i) return false; u.pm = pm; u.pn = pn; return true; }
};

template <class Epi, class Sched, bool ALIGN_EPI, bool SP2>
__device__ __forceinline__ void gemm_phase(LAS unsigned char* lds, const Gemm g, const Sched& S, const Epi& E, int tid_in) {
    int tid_ = tid_in; asm volatile("" : "+v"(tid_));
    const int tid = tid_, wid = __builtin_amdgcn_readfirstlane(tid >> 6), lane = tid & 63, wr = wid >> 2, wc = wid & 3, fr = lane & 15, fq = lane >> 4;
    const int K = g.K, nt = K / BK;
    unsigned voffA[2], voffB[2];
#pragma unroll
    for (int i = 0; i < 2; ++i) { int R, C; stage_rc(tid * 16 + i * 8192, R, C); const int Rb = Epi::PERM ? ((R & ~31) + perm32(R & 31)) : R;
        voffA[i] = (unsigned)(R * g.lda + C) * 2u; voffB[i] = (unsigned)(Rb * g.ldb + C) * 2u; }
    const size_t kstep = (size_t)(BK * 2);
    const size_t hstepA = (size_t)HALF * g.lda * 2, hstepB = (size_t)HALF * g.ldb * 2;
    const size_t tstepA = 2 * hstepA, tstepB = 2 * hstepB;
    const unsigned ldsw = (unsigned)wid * 1024u;
    const int aoff = lds_byte(wr * 64 + fr, fq * 8), boff = lds_byte(wc * 32 + fr, fq * 8);
#define PG8_SA(b, h) (((b) * 2 + (h)) * HTB)
#define PG8_SB(b, h) ((4 + (b) * 2 + (h)) * HTB)
#define PG8_STAGE(bufoff, gbase, voff) do { _Pragma("unroll") for (int _i = 0; _i < 2; ++_i) \
        __builtin_amdgcn_global_load_lds((const unsigned*)((const char*)(gbase) + (voff)[_i]), (LAS unsigned*)(lds + (bufoff) + ldsw + _i * 8192), 16, 0, 0); } while (0)
#define PG8_LDA(dst, b, h) do { _Pragma("unroll") for (int m = 0; m < 4; ++m) _Pragma("unroll") for (int k = 0; k < 2; ++k) dst[m][k] = *(const LAS bf16x8*)(lds + PG8_SA(b, h) + aoff + m * 2048 + k * 1024); } while (0)
#define PG8_LDB(dst, b, h) do { _Pragma("unroll") for (int n = 0; n < 2; ++n) _Pragma("unroll") for (int k = 0; k < 2; ++k) dst[n][k] = *(const LAS bf16x8*)(lds + PG8_SB(b, h) + boff + n * 2048 + k * 1024); } while (0)
#define PG8_MMA(ai, bj, At, Bt) do { __builtin_amdgcn_s_setprio(1); _Pragma("unroll") for (int m = 0; m < 4; ++m) _Pragma("unroll") for (int n = 0; n < 2; ++n) _Pragma("unroll") for (int k = 0; k < 2; ++k) \
        acc[ai][bj][m][n] = __builtin_amdgcn_mfma_f32_16x16x32_bf16(Bt[n][k], At[m][k], acc[ai][bj][m][n], 0, 0, 0); __builtin_amdgcn_s_setprio(0); } while (0)
#define PG8_WAIT_V(n) asm volatile("s_waitcnt vmcnt(" #n ")" ::: "memory")
#define PG8_WAIT_L(n) asm volatile("s_waitcnt lgkmcnt(" #n ")" ::: "memory")
#define PG8_BAR __builtin_amdgcn_s_barrier()
#define PG8_SCHED __builtin_amdgcn_sched_barrier(0)
    Unit cur, nxt; int ui = 0;
    if (!S.next(0, cur)) return;
    f32x4 acc[2][2][4][2];
#pragma unroll
    for (int a = 0; a < 2; ++a)
#pragma unroll
        for (int b = 0; b < 2; ++b)
#pragma unroll
            for (int m = 0; m < 4; ++m)
#pragma unroll
                for (int n = 0; n < 2; ++n) acc[a][b][m][n] = (f32x4){0.f, 0.f, 0.f, 0.f};
    bf16x8 At[4][2], B0[2][2], B1[2][2];
    const char* cA = (const char*)g.A + (size_t)cur.pm * tstepA; const char* cB = (const char*)g.Bt + (size_t)cur.pn * tstepB;
    if constexpr (SP2) {
        PG8_STAGE(PG8_SB(0, 0), cB, voffB); PG8_STAGE(PG8_SB(0, 1), cB + hstepB, voffB); PG8_STAGE(PG8_SA(0, 0), cA, voffA); PG8_STAGE(PG8_SA(0, 1), cA + hstepA, voffA);
        if (wr == 1) PG8_BAR;
        PG8_WAIT_V(2); PG8_BAR;
        PG8_STAGE(PG8_SB(1, 0), cB + kstep, voffB); PG8_STAGE(PG8_SA(1, 0), cA + kstep, voffA); PG8_STAGE(PG8_SB(1, 1), cB + hstepB + kstep, voffB);
        PG8_WAIT_V(6); PG8_BAR;
    } else {
        PG8_STAGE(PG8_SB(0, 0), cB, voffB); PG8_STAGE(PG8_SA(0, 0), cA, voffA); PG8_STAGE(PG8_SB(0, 1), cB + hstepB, voffB); PG8_STAGE(PG8_SA(0, 1), cA + hstepA, voffA);
        if (wr == 1) PG8_BAR;
        PG8_WAIT_V(4); PG8_BAR;
        PG8_STAGE(PG8_SB(1, 0), cB + kstep, voffB); PG8_STAGE(PG8_SA(1, 0), cA + kstep, voffA); PG8_STAGE(PG8_SB(1, 1), cB + hstepB + kstep, voffB);
        PG8_WAIT_V(6); PG8_BAR;
    }
    for (;;) {
        const bool has_next = S.next(ui + 1, nxt);
        const char* nA = has_next ? (const char*)g.A + (size_t)nxt.pm * tstepA : cA; const char* nB = has_next ? (const char*)g.Bt + (size_t)nxt.pn * tstepB : cB;
        for (int t = 0; t < nt; t += 2) {
            const bool last = (t == nt - 2);
            const char* a1 = cA + (size_t)(t + 1) * kstep;
            const char* a2 = last ? nA : cA + (size_t)(t + 2) * kstep; const char* b2 = last ? nB : cB + (size_t)(t + 2) * kstep;
            const char* a3 = a2 + kstep; const char* b3 = b2 + kstep;
            if constexpr (Epi::MIDK) { if (t == g.kmid) E.midk(acc, wr, fr); }
            if constexpr (SP2) {
            PG8_LDB(B0, 0, 0); PG8_LDB(B1, 0, 1); PG8_SCHED; PG8_LDA(At, 0, 0); PG8_STAGE(PG8_SA(1, 1), a1 + hstepA, voffA);
            PG8_WAIT_V(8); PG8_WAIT_L(0); PG8_BAR; PG8_MMA(0, 0, At, B0); PG8_MMA(0, 1, At, B1); PG8_BAR; PG8_SCHED;
            PG8_LDA(At, 0, 1); PG8_STAGE(PG8_SB(0, 0), b2, voffB); PG8_STAGE(PG8_SB(0, 1), b2 + hstepB, voffB); PG8_STAGE(PG8_SA(0, 0), a2, voffA);
            PG8_WAIT_V(8); PG8_WAIT_L(0); PG8_BAR; PG8_MMA(1, 0, At, B0); PG8_MMA(1, 1, At, B1); PG8_BAR; PG8_SCHED;
            PG8_LDB(B0, 1, 0); PG8_LDB(B1, 1, 1); PG8_SCHED; PG8_LDA(At, 1, 0); PG8_STAGE(PG8_SA(0, 1), a2 + hstepA, voffA);
            PG8_WAIT_V(8); PG8_WAIT_L(0); PG8_BAR; PG8_MMA(0, 0, At, B0); PG8_MMA(0, 1, At, B1); PG8_BAR; PG8_SCHED;
            PG8_LDA(At, 1, 1); PG8_STAGE(PG8_SB(1, 0), b3, voffB); PG8_STAGE(PG8_SB(1, 1), b3 + hstepB, voffB); PG8_STAGE(PG8_SA(1, 0), a3, voffA);
            PG8_WAIT_V(8); PG8_WAIT_L(0); PG8_BAR; PG8_MMA(1, 0, At, B0); PG8_MMA(1, 1, At, B1); PG8_BAR; PG8_SCHED;
            } else {
            PG8_LDB(B0, 0, 0); PG8_SCHED; PG8_LDA(At, 0, 0); PG8_STAGE(PG8_SA(1, 1), a1 + hstepA, voffA);
            PG8_WAIT_L(8); PG8_BAR; PG8_WAIT_L(0); PG8_MMA(0, 0, At, B0); PG8_BAR; PG8_SCHED;
            PG8_LDB(B1, 0, 1); PG8_STAGE(PG8_SB(0, 0), b2, voffB);
            PG8_BAR; PG8_WAIT_L(0); PG8_MMA(0, 1, At, B1); PG8_BAR;
            PG8_LDA(At, 0, 1); PG8_STAGE(PG8_SA(0, 0), a2, voffA);
            PG8_BAR; PG8_WAIT_L(0); PG8_MMA(1, 0, At, B0); PG8_BAR; PG8_SCHED;
            PG8_STAGE(PG8_SB(0, 1), b2 + hstepB, voffB);
            PG8_WAIT_V(6); PG8_BAR; PG8_MMA(1, 1, At, B1); PG8_BAR;
            PG8_LDB(B0, 1, 0); PG8_SCHED; PG8_LDA(At, 1, 0); PG8_STAGE(PG8_SA(0, 1), a2 + hstepA, voffA);
            PG8_WAIT_L(8); PG8_BAR; PG8_WAIT_L(0); PG8_MMA(0, 0, At, B0); PG8_BAR; PG8_SCHED;
            PG8_LDB(B1, 1, 1); PG8_STAGE(PG8_SB(1, 0), b3, voffB);
            PG8_BAR; PG8_WAIT_L(0); PG8_MMA(0, 1, At, B1); PG8_BAR;
            PG8_LDA(At, 1, 1); PG8_STAGE(PG8_SA(1, 0), a3, voffA);
            PG8_BAR; PG8_WAIT_L(0); PG8_MMA(1, 0, At, B0); PG8_BAR; PG8_SCHED;
            PG8_STAGE(PG8_SB(1, 1), b3 + hstepB, voffB);
            PG8_WAIT_V(6); PG8_BAR; PG8_MMA(1, 1, At, B1); PG8_BAR;
            }
        }
        if constexpr (ALIGN_EPI) { if (wr == 0) PG8_BAR; }
        if constexpr (!Epi::AFTER_DRAIN) { E(acc, cur, wr, wc, fr, fq); }
        if (!has_next) break;
#pragma unroll
        for (int a = 0; a < 2; ++a)
#pragma unroll
            for (int b = 0; b < 2; ++b)
#pragma unroll
                for (int m = 0; m < 4; ++m)
#pragma unroll
                    for (int n = 0; n < 2; ++n) acc[a][b][m][n] = (f32x4){0.f, 0.f, 0.f, 0.f};
        cur = nxt; cA = nA; cB = nB; ++ui;
        if constexpr (ALIGN_EPI) { if (wr == 1) PG8_BAR; }
    }
    PG8_WAIT_V(0);
    if constexpr (!ALIGN_EPI) { if (wr == 0) PG8_BAR; }
    PG8_BAR;
    if constexpr (Epi::AFTER_DRAIN) { E.fused(acc, cur, wr, wc, fr, fq, lds); }
#undef PG8_SA
#undef PG8_SB
#undef PG8_STAGE
#undef PG8_LDA
#undef PG8_LDB
#undef PG8_MMA
#undef PG8_WAIT_V
#undef PG8_WAIT_L
#undef PG8_BAR
#undef PG8_SCHED
}
}
using pg8::Unit;
typedef f32x4 Acc[2][2][4][2];

struct EpiInProj {
    static constexpr bool PERM = true, AFTER_DRAIN = false, MIDK = false;
    const LAS float* rs; bf16_t *a2u, *gs, *q, *k, *gr; const float* rope;
    __device__ __forceinline__ void operator()(const Acc& acc, const Unit& u, int wr, int wc, int fr, int fq) const {
        asm volatile("" : "+v"(fr), "+v"(fq));
        const int type = u.pn >> 3, colt = (u.pn & 7) << 8, c8 = wc * 32 + 8 * fq, lr0 = wr * 64 + fr;
        const bool rot = (type == 2 || type == 3);
        const float eh = __builtin_amdgcn_exp2f((float)(-5 - (u.pn & 7)));
        const float lg2h = -(eh * (1.f + eh * (0.5f + eh * (0.33333334f + eh * (0.25f + eh * (0.2f + eh * 0.16666667f)))))) * 1.4426950408889634f;
        f32x4 cur[4], nxt[4];
        if (rot) { const f32x4* cs = (const f32x4*)(rope + ((size_t)((u.pm * 256 + lr0) & 2047) * 128 + c8) * 2);
#pragma unroll
            for (int j = 0; j < 4; ++j) cur[j] = cs[j]; }
#pragma unroll
        for (int idx = 0; idx < 8; ++idx) { const int ai = idx >> 2, m = idx & 3;
                const int lr = lr0 + ai * 128 + m * 16, r = u.pm * 256 + lr; const float s = rs[lr];
                if (rot && idx < 7) { const f32x4* cs = (const f32x4*)(rope + ((size_t)((u.pm * 256 + lr0 + ((idx + 1) >> 2) * 128 + ((idx + 1) & 3) * 16) & 2047) * 128 + c8) * 2);
#pragma unroll
                    for (int j = 0; j < 4; ++j) nxt[j] = cs[j]; }
                f32x4 v[2][2];
#pragma unroll
                for (int bj = 0; bj < 2; ++bj)
#pragma unroll
                    for (int n = 0; n < 2; ++n) v[bj][n] = acc[ai][bj][m][n] * s;
                if (type == 0) {
#pragma unroll
                    for (int bj = 0; bj < 2; ++bj) { const int col = colt + bj * 128 + c8;
                        u32x4 w; w.x = cvt_pk_bf16(v[bj][0][0], v[bj][0][1]); w.y = cvt_pk_bf16(v[bj][0][2], v[bj][0][3]); w.z = cvt_pk_bf16(v[bj][1][0], v[bj][1][1]); w.w = cvt_pk_bf16(v[bj][1][2], v[bj][1][3]);
                        *(u32x4*)(a2u + ((size_t)((col >> 4) * 512 + (r >> 4)) * A2LD + (r & 15) * 16 + (col & 15))) = w; }
                } else if (type == 1 || type == 4) {
                    bf16_t* dst = (type == 1 ? gs : gr) + (size_t)r * 2048 + colt + c8;
#pragma unroll
                    for (int bj = 0; bj < 2; ++bj) {
                        u32x4 w; w.x = cvt_pk_bf16(silu_f(v[bj][0][0]), silu_f(v[bj][0][1])); w.y = cvt_pk_bf16(silu_f(v[bj][0][2]), silu_f(v[bj][0][3]));
                        w.z = cvt_pk_bf16(silu_f(v[bj][1][0]), silu_f(v[bj][1][1])); w.w = cvt_pk_bf16(silu_f(v[bj][1][2]), silu_f(v[bj][1][3]));
                        *(u32x4*)(dst + bj * 128) = w; }
                } else {
                    const float sc = (type == 3) ? 0.0625f * __builtin_amdgcn_exp2f(-(float)(r & 127) * lg2h) : __builtin_amdgcn_exp2f((float)(r & 127) * lg2h);
                    float o1[8], o2[8];
#pragma unroll
                    for (int jj = 0; jj < 4; ++jj) { const f32x4 t = cur[jj];
                        const float a0 = v[0][jj >> 1][(jj & 1) * 2], b0 = v[1][jj >> 1][(jj & 1) * 2], a1 = v[0][jj >> 1][(jj & 1) * 2 + 1], b1 = v[1][jj >> 1][(jj & 1) * 2 + 1];
                        o1[2 * jj] = (a0 * t[0] - b0 * t[1]) * sc; o2[2 * jj] = (b0 * t[0] + a0 * t[1]) * sc;
                        o1[2 * jj + 1] = (a1 * t[2] - b1 * t[3]) * sc; o2[2 * jj + 1] = (b1 * t[2] + a1 * t[3]) * sc; }
                    bf16_t* dst = (type == 2 ? q : k) + (size_t)r * 2048 + colt + c8;
                    u32x4 w; w.x = cvt_pk_bf16(o1[0], o1[1]); w.y = cvt_pk_bf16(o1[2], o1[3]); w.z = cvt_pk_bf16(o1[4], o1[5]); w.w = cvt_pk_bf16(o1[6], o1[7]);
                    *(u32x4*)dst = w;
                    w.x = cvt_pk_bf16(o2[0], o2[1]); w.y = cvt_pk_bf16(o2[2], o2[3]); w.z = cvt_pk_bf16(o2[4], o2[5]); w.w = cvt_pk_bf16(o2[6], o2[7]);
                    *(u32x4*)(dst + 128) = w;
#pragma unroll
                    for (int j = 0; j < 4; ++j) cur[j] = nxt[j];
                }
                asm volatile("" ::: "memory");
            }
    }
};
struct EpiVT {
    static constexpr bool PERM = true, AFTER_DRAIN = false, MIDK = false;
    const LAS float* rs; bf16_t* vt;
    __device__ __forceinline__ void operator()(const Acc& acc, const Unit& u, int wr, int wc, int fr, int fq) const {
        asm volatile("" : "+v"(fr), "+v"(fq));
        f32x4 sv[2][2];
#pragma unroll
        for (int bj = 0; bj < 2; ++bj)
#pragma unroll
            for (int n = 0; n < 2; ++n) sv[bj][n] = *(const LAS f32x4*)(rs + bj * 128 + wc * 32 + 8 * fq + 4 * n);
#pragma unroll
        for (int ai = 0; ai < 2; ++ai)
#pragma unroll
            for (int m = 0; m < 4; ++m) { bf16_t* dst = vt + (size_t)(u.pm * 256 + wr * 64 + fr + ai * 128 + m * 16) * MTOK + u.pn * 256 + wc * 32 + 8 * fq;
#pragma unroll
                for (int bj = 0; bj < 2; ++bj) { const f32x4 a = acc[ai][bj][m][0] * sv[bj][0], b = acc[ai][bj][m][1] * sv[bj][1];
                    u32x4 w; w.x = cvt_pk_bf16(a[0], a[1]); w.y = cvt_pk_bf16(a[2], a[3]); w.z = cvt_pk_bf16(b[0], b[1]); w.w = cvt_pk_bf16(b[2], b[3]);
                    *(u32x4*)(dst + bj * 128) = w; } }
    }
};
constexpr int SLD = 132;
struct EpiSloc {
    static constexpr bool PERM = false, AFTER_DRAIN = true, MIDK = false;
    __device__ __forceinline__ void fused(const Acc& acc, const Unit&, int wr, int wc, int fr, int fq, LAS unsigned char* lds) const {
        asm volatile("" : "+v"(fr), "+v"(fq));
        LAS float* S = (LAS float*)lds;
#pragma unroll
        for (int ai = 0; ai < 2; ++ai)
#pragma unroll
            for (int m = 0; m < 4; ++m)
#pragma unroll
                for (int n = 0; n < 2; ++n) *(LAS f32x4*)(S + (ai * 128 + wr * 64 + m * 16 + fr) * SLD + wc * 32 + n * 16 + 4 * fq) = acc[ai][0][m][n];
    }
};
struct EpiSsmOut {
    static constexpr bool PERM = true, AFTER_DRAIN = false, MIDK = false;
    const bf16_t* a2g; const float* dsk; bf16_t* yg; int g;
    __device__ __forceinline__ void operator()(const Acc& acc, const Unit& u, int wr, int wc, int fr, int fq) const {
        asm volatile("" : "+v"(fr), "+v"(fq));
        const int h0 = 8 * (fq & 1), row0 = u.pm * 256 + wr * 64 + fr, colb = wc * 32 + 8 * fq;
        const f32x4 d0 = *(const f32x4*)(dsk + h0), d1 = *(const f32x4*)(dsk + h0 + 4);
        u32x4 cur[2], nxt[2];
        cur[0] = *(const u32x4*)(a2g + (size_t)row0 * A2LD + colb); cur[1] = *(const u32x4*)(a2g + (size_t)row0 * A2LD + colb + 128);
#pragma unroll
        for (int idx = 0; idx < 8; ++idx) { const int ai = idx >> 2, m = idx & 3, row = row0 + ai * 128 + m * 16;
            if (idx < 7) { const size_t ro = (size_t)(row0 + ((idx + 1) >> 2) * 128 + ((idx + 1) & 3) * 16) * A2LD + colb; nxt[0] = *(const u32x4*)(a2g + ro); nxt[1] = *(const u32x4*)(a2g + ro + 128); }
#pragma unroll
            for (int bj = 0; bj < 2; ++bj) { const int col = bj * 128 + colb, tl = col >> 4;
                const u32x4 uu = cur[bj];
                const f32x4 a = acc[ai][bj][m][0], b = acc[ai][bj][m][1];
                float y[8];
                y[0] = a[0] + d0[0] * bf2f(uu.x & 0xffffu); y[1] = a[1] + d0[1] * bf2f(uu.x >> 16); y[2] = a[2] + d0[2] * bf2f(uu.y & 0xffffu); y[3] = a[3] + d0[3] * bf2f(uu.y >> 16);
                y[4] = b[0] + d1[0] * bf2f(uu.z & 0xffffu); y[5] = b[1] + d1[1] * bf2f(uu.z >> 16); y[6] = b[2] + d1[2] * bf2f(uu.w & 0xffffu); y[7] = b[3] + d1[3] * bf2f(uu.w >> 16);
#pragma unroll
                for (int j = 0; j < 8; ++j) y[j] = gelu_tanh_f(y[j]);
                u32x4 w; w.x = cvt_pk_bf16(y[0], y[1]); w.y = cvt_pk_bf16(y[2], y[3]); w.z = cvt_pk_bf16(y[4], y[5]); w.w = cvt_pk_bf16(y[6], y[7]);
                *(u32x4*)(yg + (size_t)(row * 16 + tl) * DS + g * 16 + h0) = w; }
            cur[0] = nxt[0]; cur[1] = nxt[1];
            asm volatile("" ::: "memory"); }
    }
};
struct EpiGlu {
    static constexpr bool PERM = true, AFTER_DRAIN = false, MIDK = false;
    const bf16_t* yg; const bf16_t* gs; const float* bias; bf16_t* ycat; float* ssq2;
    __device__ __forceinline__ void preload(u32x4 (&p)[4], size_t rowoff) const {
#pragma unroll
        for (int bj = 0; bj < 2; ++bj) { p[2 * bj] = *(const u32x4*)(yg + rowoff + bj * 128); p[2 * bj + 1] = *(const u32x4*)(gs + rowoff + bj * 128); }
    }
    __device__ __forceinline__ void operator()(const Acc& acc, const Unit& u, int wr, int wc, int fr, int fq) const {
        asm volatile("" : "+v"(fr), "+v"(fq));
        const int col0 = u.pn * 256 + wc * 32 + 8 * fq, r0 = u.pm * 256 + wr * 64 + fr;
        f32x4 bv[2][2];
#pragma unroll
        for (int bj = 0; bj < 2; ++bj)
#pragma unroll
            for (int n = 0; n < 2; ++n) bv[bj][n] = *(const f32x4*)(bias + col0 + bj * 128 + 4 * n);
        u32x4 cur[4], nxt[4]; preload(cur, (size_t)r0 * DS + col0);
#pragma unroll
        for (int idx = 0; idx < 8; ++idx) { const int ai = idx >> 2, m = idx & 3, r = r0 + ai * 128 + m * 16; float ss = 0.f;
            if (idx < 7) preload(nxt, (size_t)(r0 + ((idx + 1) >> 2) * 128 + ((idx + 1) & 3) * 16) * DS + col0);
#pragma unroll
            for (int bj = 0; bj < 2; ++bj) { const u32x4 yy = cur[2 * bj], gg = cur[2 * bj + 1];
                const f32x4 a = acc[ai][bj][m][0] + bv[bj][0], b = acc[ai][bj][m][1] + bv[bj][1];
                float z[8];
                z[0] = bf2f(yy.x & 0xffffu) * sigmoid_f(a[0]); z[1] = bf2f(yy.x >> 16) * sigmoid_f(a[1]); z[2] = bf2f(yy.y & 0xffffu) * sigmoid_f(a[2]); z[3] = bf2f(yy.y >> 16) * sigmoid_f(a[3]);
                z[4] = bf2f(yy.z & 0xffffu) * sigmoid_f(b[0]); z[5] = bf2f(yy.z >> 16) * sigmoid_f(b[1]); z[6] = bf2f(yy.w & 0xffffu) * sigmoid_f(b[2]); z[7] = bf2f(yy.w >> 16) * sigmoid_f(b[3]);
#pragma unroll
                for (int j = 0; j < 8; ++j) ss += z[j] * z[j];
                z[0] *= bf2f(gg.x & 0xffffu); z[1] *= bf2f(gg.x >> 16); z[2] *= bf2f(gg.y & 0xffffu); z[3] *= bf2f(gg.y >> 16);
                z[4] *= bf2f(gg.z & 0xffffu); z[5] *= bf2f(gg.z >> 16); z[6] *= bf2f(gg.w & 0xffffu); z[7] *= bf2f(gg.w >> 16);
                u32x4 w; w.x = cvt_pk_bf16(z[0], z[1]); w.y = cvt_pk_bf16(z[2], z[3]); w.z = cvt_pk_bf16(z[4], z[5]); w.w = cvt_pk_bf16(z[6], z[7]);
                *(u32x4*)(ycat + (size_t)r * DM + col0 + bj * 128) = w; }
            ss = xor_add<16>(ss); ss = xor_add<32>(ss);
            if (fq == 0) ssq2[(size_t)r * 32 + u.pn * 4 + wc] = ss;
#pragma unroll
            for (int k = 0; k < 4; ++k) cur[k] = nxt[k];
            asm volatile("" ::: "memory"); }
    }
};
template <bool RESBF> struct EpiOut {
    static constexpr bool PERM = true, AFTER_DRAIN = false, MIDK = true;
    const LAS float* rs2; const void* res; bf16_t* xo; float* ssq;
    __device__ __forceinline__ void midk(Acc& acc, int wr, int fr) const {
        asm volatile("" : "+v"(fr));
#pragma unroll
        for (int ai = 0; ai < 2; ++ai)
#pragma unroll
            for (int m = 0; m < 4; ++m) { const float s = rs2[ai * 128 + wr * 64 + m * 16 + fr];
#pragma unroll
                for (int bj = 0; bj < 2; ++bj)
#pragma unroll
                    for (int n = 0; n < 2; ++n) acc[ai][bj][m][n] *= s; }
    }
    typedef f32x4 Pre[RESBF ? 2 : 4];
    __device__ __forceinline__ void preload(Pre& p, size_t rowoff) const {
#pragma unroll
        for (int bj = 0; bj < 2; ++bj) {
            if constexpr (RESBF) p[bj] = __builtin_bit_cast(f32x4, *(const u32x4*)((const bf16_t*)res + rowoff + bj * 128));
            else { p[2 * bj] = *(const f32x4*)((const float*)res + rowoff + bj * 128); p[2 * bj + 1] = *(const f32x4*)((const float*)res + rowoff + bj * 128 + 4); } }
    }
    __device__ __forceinline__ void operator()(const Acc& acc, const Unit& u, int wr, int wc, int fr, int fq) const {
        asm volatile("" : "+v"(fr), "+v"(fq));
        const int col0 = u.pn * 256 + wc * 32 + 8 * fq; const int r0 = u.pm * 256 + wr * 64 + fr;
        Pre cur, nxt; preload(cur, (size_t)r0 * DM + col0);
#pragma unroll
        for (int idx = 0; idx < 8; ++idx) { const int ai = idx >> 2, m = idx & 3, r = r0 + ai * 128 + m * 16; float ss = 0.f;
            if (idx < 7) preload(nxt, (size_t)(r0 + ((idx + 1) >> 2) * 128 + ((idx + 1) & 3) * 16) * DM + col0);
#pragma unroll
            for (int bj = 0; bj < 2; ++bj) { const size_t off = (size_t)r * DM + col0 + bj * 128; f32x4 x0, x1;
                if constexpr (RESBF) { const u32x4 rv = __builtin_bit_cast(u32x4, cur[bj]);
                    x0 = (f32x4){bf2f(rv.x & 0xffffu), bf2f(rv.x >> 16), bf2f(rv.y & 0xffffu), bf2f(rv.y >> 16)}; x1 = (f32x4){bf2f(rv.z & 0xffffu), bf2f(rv.z >> 16), bf2f(rv.w & 0xffffu), bf2f(rv.w >> 16)};
                } else { x0 = cur[2 * bj]; x1 = cur[2 * bj + 1]; }
                x0 = x0 + acc[ai][bj][m][0]; x1 = x1 + acc[ai][bj][m][1];
                ss += ((x0[0] * x0[0] + x0[1] * x0[1]) + (x0[2] * x0[2] + x0[3] * x0[3])) + ((x1[0] * x1[0] + x1[1] * x1[1]) + (x1[2] * x1[2] + x1[3] * x1[3]));
                u32x4 w; w.x = cvt_pk_bf16(x0[0], x0[1]); w.y = cvt_pk_bf16(x0[2], x0[3]); w.z = cvt_pk_bf16(x1[0], x1[1]); w.w = cvt_pk_bf16(x1[2], x1[3]);
                *(u32x4*)(xo + off) = w; }
            ss = xor_add<16>(ss); ss = xor_add<32>(ss);
            if (fq == 0) ssq[(size_t)r * 64 + u.pn * 4 + wc] = ss;
#pragma unroll
            for (int k = 0; k < (RESBF ? 2 : 4); ++k) cur[k] = nxt[k];
            asm volatile("" ::: "memory"); }
    }
};

struct Args { const float* in[17]; float* out; unsigned char* ws; int ph_lo, ph_hi; };
enum { I_X = 0, I_NORMW, I_WIN, I_LRE, I_LIM, I_BRE, I_BIM, I_CRE, I_CIM, I_D, I_LOGDT, I_WGLU, I_BGLU, I_SNW, I_RNW, I_WOUT, I_FNW };

typedef const __attribute__((address_space(4))) Args* ArgsP;
struct Frame {
    LAS unsigned char* lds; int wave, vcu, G, bid; unsigned char* ws;
};

__device__ __forceinline__ int fresh_tid(const Frame& F) { unsigned m_ = ~0u; asm volatile("" : "+s"(m_)); return F.wave * 64 + (int)__builtin_amdgcn_mbcnt_hi(m_, __builtin_amdgcn_mbcnt_lo(m_, 0u)); }
__device__ __forceinline__ void transpose_item(const float* W, int K, int N, bf16_t* WT, const float* ks0, const float* ks1, int ksplit, int remap, int item, int lane) {
    const int nblk = N / 64, kb = item / nblk, nb = item % nblk, k0 = 64 * kb, nq = lane & 15, kq = lane >> 4; int n0 = 64 * nb;
    const float* wp = W + (size_t)(k0 + 16 * kq) * N + n0 + 4 * nq;
    f32x4 v[16];
#pragma unroll
    for (int i = 0; i < 16; ++i) v[i] = *(const f32x4*)(wp + (size_t)i * N);
    if (ks0) { const float* ks = ((k0 < ksplit) ? ks0 + k0 : ks1 + (k0 - ksplit)) + 16 * kq;
#pragma unroll
        for (int i = 0; i < 4; ++i) { const f32x4 sc = *(const f32x4*)(ks + 4 * i);
#pragma unroll
            for (int j = 0; j < 4; ++j) v[4 * i + j] = v[4 * i + j] * sc[j]; } }
    if (remap) { if (n0 >= 10240) n0 -= 2048; else if (n0 >= 8192) n0 += 2048; }
#pragma unroll
    for (int c = 0; c < 4; ++c) { bf16_t* dst = WT + (size_t)(n0 + 4 * nq + c) * K + k0 + 16 * kq;
        u32x4 o0, o1;
        o0.x = pk2(v[0][c], v[1][c]); o0.y = pk2(v[2][c], v[3][c]); o0.z = pk2(v[4][c], v[5][c]); o0.w = pk2(v[6][c], v[7][c]);
        o1.x = pk2(v[8][c], v[9][c]); o1.y = pk2(v[10][c], v[11][c]); o1.z = pk2(v[12][c], v[13][c]); o1.w = pk2(v[14][c], v[15][c]);
        *(u32x4*)dst = o0; *(u32x4*)(dst + 8) = o1; }
}

__device__ __forceinline__ void ssm_mats_item(const Frame& F, ArgsP a, int l, int g) {
    const int lg = l * NG + g, tid = fresh_tid(F);
    LAS float* apr = (LAS float*)F.lds;
    LAS float* api = apr + 17 * 64;
    LAS float* bbr = api + 17 * 64;
    LAS float* bbi = bbr + 1024;
    LAS float* crs = bbi + 1024;
    LAS float* cis = crs + 1024;
    LAS float* crt = cis + 1024;
    LAS float* cit = crt + 1024;
    LAS float* Kt = cit + 1024;
    LAS float* lrs = Kt + 4096;
    LAS float* lis = lrs + 64;
    { const float b0r = a->in[I_BRE][(size_t)lg * 1024 + tid], b1r = a->in[I_BRE][(size_t)lg * 1024 + 512 + tid], b0i = a->in[I_BIM][(size_t)lg * 1024 + tid], b1i = a->in[I_BIM][(size_t)lg * 1024 + 512 + tid];
      const float c0r = a->in[I_CRE][(size_t)lg * 1024 + tid], c1r = a->in[I_CRE][(size_t)lg * 1024 + 512 + tid], c0i = a->in[I_CIM][(size_t)lg * 1024 + tid], c1i = a->in[I_CIM][(size_t)lg * 1024 + 512 + tid];
      const float lx = (tid < 64) ? a->in[I_LRE][lg * 64 + tid] : ((tid < 128) ? a->in[I_LIM][lg * 64 + tid - 64] : 0.f);
      bbr[tid] = b0r; bbr[512 + tid] = b1r; bbi[tid] = b0i; bbi[512 + tid] = b1i;
      crs[tid] = c0r; crs[512 + tid] = c1r; cis[tid] = c0i; cis[512 + tid] = c1i;
      { const int hp0 = tid >> 6, n0 = tid & 63; crt[n0 * 16 + hp0] = c0r; crt[n0 * 16 + hp0 + 8] = c1r; cit[n0 * 16 + hp0] = c0i; cit[n0 * 16 + hp0 + 8] = c1i; }
      if (tid < 128) lrs[tid] = lx; }
    const float dtf = expf(a->in[I_LOGDT][lg]);
    __syncthreads();
    for (int e = tid; e < 17 * 64; e += 512) { const int tau = e >> 6, n = e & 63; const float lr = lrs[n], li = lis[n];
        float c, s; cis_d((double)li * (double)dtf * tau, c, s); const float mag = expf(lr * dtf * (float)tau); apr[e] = mag * c; api[e] = mag * s; }
    __syncthreads();
#pragma unroll
    for (int k = 0; k < 2; ++k) { const int e = tid + 512 * k, n = e >> 4; const float lr = lrs[n], li = lis[n];
        const float nr = apr[64 + n] - 1.f, ni = api[64 + n], den = lr * lr + li * li, cor = (nr * lr + ni * li) / den, coi = (ni * lr - nr * li) / den;
        const float br = bbr[e], bi = bbi[e];
        bbr[e] = cor * br - coi * bi; bbi[e] = cor * bi + coi * br; }
    if (tid < 64) ((float2*)(F.ws + WS_A16))[lg * 64 + tid] = make_float2(apr[16 * 64 + tid], api[16 * 64 + tid]);
    __syncthreads();
    { const int tau = tid >> 5, hp = (tid >> 1) & 15, h0 = (tid & 1) * 8; float sum[8];
#pragma unroll
      for (int j = 0; j < 8; ++j) sum[j] = 0.f;
#pragma unroll 4
      for (int n = 0; n < 64; ++n) { const float cr = crt[n * 16 + hp], ci = cit[n * 16 + hp], ar = apr[tau * 64 + n], ai = api[tau * 64 + n], pr = cr * ar - ci * ai, pi = cr * ai + ci * ar;
          const f32x4 b0 = *(const LAS f32x4*)(bbr + n * 16 + h0), b1 = *(const LAS f32x4*)(bbr + n * 16 + h0 + 4), d0 = *(const LAS f32x4*)(bbi + n * 16 + h0), d1 = *(const LAS f32x4*)(bbi + n * 16 + h0 + 4);
#pragma unroll
          for (int j = 0; j < 4; ++j) { sum[j] += pr * b0[j] - pi * d0[j]; sum[4 + j] += pr * b1[j] - pi * d1[j]; } }
#pragma unroll
      for (int j = 0; j < 8; ++j) Kt[(tau << 8) + (hp << 4) + h0 + j] = sum[j]; }
    __syncthreads();
    bf16_t* bt2 = (bf16_t*)(F.ws + WS_BT2) + (size_t)lg * 256 * A2LD;
#pragma unroll 2
    for (int e = tid; e < 256 * A2LD / 8; e += 512) { const int row = e / 48, c0 = (e % 48) * 8, t = row >> 4, hp = row & 15; float v[8];
        if (c0 < 256) { const int j = c0 >> 4, h0 = c0 & 15;
#pragma unroll
            for (int i = 0; i < 8; ++i) v[i] = (t >= j) ? Kt[((t - j) << 8) + (hp << 4) + h0 + i] : 0.f;
        } else { const int nn = c0 - 256;
#pragma unroll
            for (int i = 0; i < 8; ++i) { const int n = (nn + i) & 63; const float cr = crs[hp * 64 + n], ci = cis[hp * 64 + n], ar = apr[(t + 1) * 64 + n], ai = api[(t + 1) * 64 + n];
                v[i] = (nn < 64) ? (cr * ar - ci * ai) : -(cr * ai + ci * ar); } }
        u32x4 w; w.x = pk2(v[0], v[1]); w.y = pk2(v[2], v[3]); w.z = pk2(v[4], v[5]); w.w = pk2(v[6], v[7]);
        *(u32x4*)(bt2 + (size_t)row * A2LD + c0) = w; }
    bf16_t* pm = (bf16_t*)(F.ws + WS_PM) + (size_t)lg * 256 * 256;
#pragma unroll 2
    for (int e = tid; e < 256 * 256 / 8; e += 512) { const int row = e >> 5, c0 = (e & 31) * 8; float v[8];
        if (row < 128) { const int n = row & 63, im = row >> 6, j = c0 >> 4, h0 = c0 & 15; const float ar = apr[(15 - j) * 64 + n], ai = api[(15 - j) * 64 + n];
#pragma unroll
            for (int i = 0; i < 8; ++i) { const float br = bbr[n * 16 + h0 + i], bi = bbi[n * 16 + h0 + i]; v[i] = im ? (ar * bi + ai * br) : (ar * br - ai * bi); }
        } else {
#pragma unroll
            for (int i = 0; i < 8; ++i) v[i] = 0.f; }
        u32x4 w; w.x = pk2(v[0], v[1]); w.y = pk2(v[2], v[3]); w.z = pk2(v[4], v[5]); w.w = pk2(v[6], v[7]);
        *(u32x4*)(pm + (size_t)row * 256 + c0) = w; }
    __syncthreads();
}

__device__ __forceinline__ void p0_prologue(const Frame& F, ArgsP a, int parts = 7) {
    const int tid0 = fresh_tid(F), lane0 = tid0 & 63;
    if (parts & 1) for (int it = F.vcu; it < DEPTH * NG; it += F.G) ssm_mats_item(F, a, it / NG, it % NG);
    if (parts & 2) { float2* rope = (float2*)(F.ws + WS_ROPE);
      for (int e = F.vcu * 512 + tid0; e < SEQ * 128; e += F.G * 512) { const int pos = e >> 7, i = e & 127;
          const double inv = (double)expf(-(float)(2 * i) * (9.210340371976184f / 256.0f)); float c, s; cis_d((double)pos * inv, c, s); rope[e] = make_float2(c, s); } }
    const int gw = F.vcu * 8 + F.wave, NGW = F.G * 8;
    if (parts & 2) for (int m = gw; m < MTOK; m += NGW) {
        const f32x4* xr = (const f32x4*)(a->in[I_X] + (size_t)m * DM) + lane0; float ss = 0.f; f32x4 v[16];
#pragma unroll
        for (int j = 0; j < 16; ++j) { v[j] = xr[64 * j]; ss += (v[j][0] * v[j][0] + v[j][1] * v[j][1]) + (v[j][2] * v[j][2] + v[j][3] * v[j][3]); }
        ss = wave_sum(ss);
        u32x2* o = (u32x2*)((bf16_t*)(F.ws + WS_XB) + (size_t)m * DM) + lane0;
#pragma unroll
        for (int j = 0; j < 16; ++j) { u32x2 w; w.x = pk2(v[j][0], v[j][1]); w.y = pk2(v[j][2], v[j][3]); o[64 * j] = w; }
        ((float*)(F.ws + WS_SSQX))[(size_t)m * 64 + lane0] = (lane0 == 0) ? ss : 0.f;
    }
    constexpr int I_IN = (DM / 64) * (NPROJ / 64), I_GLU = (DS / 64) * (DS / 64), I_OUT = (DM / 64) * (DM / 64), I_L = I_IN + I_GLU + I_OUT;
    if (parts & 4) for (int it = gw; it < DEPTH * I_L; it += NGW) {
        const int l = it / I_L; int r = it % I_L;
        if (r < I_IN) { transpose_item(a->in[I_WIN] + (size_t)l * DM * NPROJ, DM, NPROJ, (bf16_t*)(F.ws + WS_WTIN) + (size_t)l * NPROJ * DM, a->in[I_NORMW] + l * DM, a->in[I_NORMW] + l * DM, 1 << 30, 1, r, lane0); continue; } r -= I_IN;
        if (r < I_GLU) { transpose_item(a->in[I_WGLU] + (size_t)l * DS * DS, DS, DS, (bf16_t*)(F.ws + WS_WTGLU) + (size_t)l * DS * DS, nullptr, nullptr, 1 << 30, 0, r, lane0); continue; } r -= I_GLU;
        transpose_item(a->in[I_WOUT] + (size_t)l * DM * DM, DM, DM, (bf16_t*)(F.ws + WS_WTOUT) + (size_t)l * DM * DM, a->in[I_SNW] + l * DS, a->in[I_RNW] + l * DR, DS, 0, r, lane0);
    }
}

__device__ __forceinline__ void stash_rstd(const Frame& F, const float* slots, int nslot, int panel, float inv_dim) {
    const int tid = fresh_tid(F);
    __syncthreads();
    if (tid < 256) { const f32x4* p = (const f32x4*)(slots + (size_t)(panel * 256 + tid) * nslot); float s = 0.f;
        for (int j = 0; j < nslot / 4; ++j) { const f32x4 t = p[j]; s += (t[0] + t[1]) + (t[2] + t[3]); }
        ((LAS float*)(F.lds + STASH_OFF))[tid] = __builtin_amdgcn_rsqf(s * inv_dim + EPS); }
    __syncthreads();
}

__device__ __forceinline__ void p1_inproj(const Frame& F, int l) {
    const bf16_t* xb = (const bf16_t*)(F.ws + WS_XB); const bf16_t* wt = (const bf16_t*)(F.ws + WS_WTIN) + (size_t)l * NPROJ * DM;
    const LAS float* rs = (const LAS float*)(F.lds + STASH_OFF);
    { pg8::StaticOrder S; S.init(MTOK, 10240, F.G, F.bid); Unit u0; S.next(0, u0);
      stash_rstd(F, (const float*)(F.ws + WS_SSQX), 64, u0.pm, 1.f / DM);
      pg8::Gemm g{xb, wt, DM, DM, DM, -1};
      EpiInProj E{rs, (bf16_t*)(F.ws + WS_A2U), (bf16_t*)(F.ws + WS_GS), (bf16_t*)(F.ws + WS_Q), (bf16_t*)(F.ws + WS_K), (bf16_t*)(F.ws + WS_GR), (const float*)(F.ws + WS_ROPE)};
      pg8::gemm_phase<EpiInProj, pg8::StaticOrder, true, true>(F.lds, g, S, E, fresh_tid(F)); }
    { pg8::StaticOrder S; S.init(DR, MTOK, F.G, F.bid); Unit u0; S.next(0, u0);
      stash_rstd(F, (const float*)(F.ws + WS_SSQX), 64, u0.pn, 1.f / DM);
      pg8::Gemm g{wt + (size_t)10240 * DM, xb, DM, DM, DM, -1};
      EpiVT E{rs, (bf16_t*)(F.ws + WS_VT)};
      pg8::gemm_phase<EpiVT, pg8::StaticOrder, true, true>(F.lds, g, S, E, fresh_tid(F)); }
}

__device__ __forceinline__ void p2_ssm(const Frame& F, ArgsP a, int l) {
    for (int it = F.vcu; it < NG * 2; it += F.G) {
        const int g = it >> 1, bp = it & 1, lg = l * NG + g;
        bf16_t* a2g = (bf16_t*)(F.ws + WS_A2U) + (size_t)g * 512 * A2LD;
        { pg8::Gemm g1{a2g, (const bf16_t*)(F.ws + WS_PM) + (size_t)lg * 256 * 256, 256, A2LD, 256, -1}; pg8::OneUnit S{bp, 0}; EpiSloc E{};
          pg8::gemm_phase<EpiSloc, pg8::OneUnit, false, true>(F.lds, g1, S, E, fresh_tid(F)); }
        LDS_WAIT(); __syncthreads();
        int t2 = fresh_tid(F); asm volatile("" : "+v"(t2));
        if (t2 < 128) {
            const int bb = t2 >> 6, n = t2 & 63; const float2 a16 = ((const float2*)(F.ws + WS_A16))[lg * 64 + n];
            const LAS float* S = (const LAS float*)F.lds + (bb * 128) * SLD; bf16_t* dst = a2g + (size_t)(bp * 256 + bb * 128) * A2LD + 256 + n;
            float sr = 0.f, si = 0.f;
#pragma unroll 8
            for (int c = 0; c < 128; ++c) { dst[(size_t)c * A2LD] = (bf16_t)f2bf(sr); dst[(size_t)c * A2LD + 64] = (bf16_t)f2bf(si);
                const float lr = S[c * SLD + n], li = S[c * SLD + 64 + n]; const float nr = a16.x * sr - a16.y * si + lr, ni = a16.x * si + a16.y * sr + li; sr = nr; si = ni; }
        }
        VM_WAIT(); __syncthreads();
        if (t2 == 0) { __builtin_amdgcn_fence(__ATOMIC_ACQUIRE, "agent"); VM_WAIT(); }
        __syncthreads();
        { pg8::Gemm g2{a2g, (const bf16_t*)(F.ws + WS_BT2) + (size_t)lg * 256 * A2LD, A2LD, A2LD, A2LD, -1}; pg8::OneUnit S{bp, 0};
          EpiSsmOut E{a2g, a->in[I_D] + (size_t)l * DS + g * 16, (bf16_t*)(F.ws + WS_YG), g};
          pg8::gemm_phase<EpiSsmOut, pg8::OneUnit, false, true>(F.lds, g2, S, E, fresh_tid(F)); }
        __syncthreads();
    }
}


typedef float f32x16 __attribute__((ext_vector_type(16)));
constexpr int RT_K0 = 0, RT_V0 = 65536, RT_P = 131072, RT_RED = 147456, RT_OLD = 528;
#define RT_BAR() do { asm volatile("s_waitcnt lgkmcnt(0)" ::: "memory"); __builtin_amdgcn_s_barrier(); asm volatile("" ::: "memory"); } while (0)
__device__ __forceinline__ void p2_ret(const Frame& F) {
    int t_ = fresh_tid(F); asm volatile("" : "+v"(t_));
    const int tid = t_, lane = tid & 63, w = F.wave, wr = w & 3, wc = w >> 2, l31 = lane & 31, hh = lane >> 5;
    LAS unsigned char* lds = F.lds;
    const bf16_t* qg = (const bf16_t*)(F.ws + WS_Q); const bf16_t* kg = (const bf16_t*)(F.ws + WS_K); const bf16_t* vtg = (const bf16_t*)(F.ws + WS_VT);
    const bf16_t* grg = (const bf16_t*)(F.ws + WS_GR); bf16_t* ycat = (bf16_t*)(F.ws + WS_YCAT);
    const unsigned koff = (unsigned)((2 * w + hh) * 4096 + ((l31 ^ ((2 * w + hh) & 15)) << 4));
    const unsigned voff = (unsigned)((8 * w + (lane >> 3)) * 16384 + (((lane & 7) ^ (((lane >> 4) + 4 * w) & 7)) << 4));
    for (int it = F.vcu; it < BATCH * RH * 8; it += F.G) {
        const int bh = it >> 3, p = it & 7, b = bh >> 3, h = bh & 7;
        const float e = __builtin_amdgcn_exp2f((float)(-5 - h));
        const float lg2 = -(e * (1.f + e * (0.5f + e * (0.33333334f + e * (0.25f + e * (0.2f + e * 0.16666667f)))))) * 1.4426950408889634f;
        for (int uu = 0; uu < 2; ++uu) {
            const int qi = uu ? p : 15 - p, ntile = 2 * (qi + 1);
            const size_t tokq = (size_t)b * SEQ + qi * 128;
            bf16x8 qf[16];
            { const bf16_t* qp = qg + (tokq + wr * 32 + l31) * DR + h * 256 + 8 * hh;
#pragma unroll
              for (int s = 0; s < 16; ++s) qf[s] = *(const bf16x8*)(qp + 16 * s); }
            f32x16 oacc[4];
#pragma unroll
            for (int db = 0; db < 4; ++db)
#pragma unroll
                for (int r = 0; r < 16; ++r) oacc[db][r] = 0.f;
#define RT_DMA(kt_, bf_) do { const char* kb_ = (const char*)(kg + ((size_t)(b * SEQ + (kt_) * 64) * DR + h * 256)) + koff; const char* vb_ = (const char*)(vtg + ((size_t)(h * 256) * MTOK + b * SEQ + (kt_) * 64)) + voff; \
            _Pragma("unroll") for (int i_ = 0; i_ < 4; ++i_) __builtin_amdgcn_global_load_lds((const unsigned*)(kb_ + i_ * 65536), (LAS unsigned*)(lds + RT_K0 + (bf_) * 32768 + (w + 8 * i_) * 1024), 16, 0, 0); \
            _Pragma("unroll") for (int i_ = 0; i_ < 4; ++i_) __builtin_amdgcn_global_load_lds((const unsigned*)(vb_ + i_ * 1048576), (LAS unsigned*)(lds + RT_V0 + (bf_) * 32768 + (w + 8 * i_) * 1024), 16, 0, 0); } while (0)
            RT_DMA(0, 0);
            asm volatile("s_waitcnt vmcnt(0)" ::: "memory"); RT_BAR();
            for (int kt = 0; kt < ntile; ++kt) {
                const int bf = kt & 1;
                if (kt + 1 < ntile) RT_DMA(kt + 1, bf ^ 1);
                int lo_ = lane; asm volatile("" : "+v"(lo_));
                const int l31 = lo_ & 31, hh = lo_ >> 5, x15 = l31 & 15, m4 = ((l31 >> 1) & 7) << 4, lane = lo_;
                f32x16 st;
#pragma unroll
                for (int r = 0; r < 16; ++r) st[r] = 0.f;
                { const LAS unsigned char* kb = lds + RT_K0 + bf * 32768 + (32 * wc + l31) * 512;
#define RT_KRD(dst, s0) do { _Pragma("unroll") for (int j_ = 0; j_ < 4; ++j_) dst[j_] = *(const LAS bf16x8*)(kb + ((((2 * ((s0) + j_)) | hh) ^ x15) << 4)); } while (0)
#define RT_KMM(src, s0) do { _Pragma("unroll") for (int j_ = 0; j_ < 4; ++j_) st = __builtin_amdgcn_mfma_f32_32x32x16_bf16(src[j_], qf[(s0) + j_], st, 0, 0, 0); } while (0)
                  bf16x8 ka[4], kc[4];
                  RT_KRD(ka, 0); __builtin_amdgcn_sched_barrier(0);
                  RT_KRD(kc, 4); RT_KMM(ka, 0); __builtin_amdgcn_sched_barrier(0);
                  RT_KRD(ka, 8); RT_KMM(kc, 4); __builtin_amdgcn_sched_barrier(0);
                  RT_KRD(kc, 12); RT_KMM(ka, 8); __builtin_amdgcn_sched_barrier(0);
                  RT_KMM(kc, 12); __builtin_amdgcn_sched_barrier(0);
#undef RT_KRD
#undef RT_KMM
                }
                { const bool diag = kt >= 2 * qi;
                  unsigned pk[8];
                  if (!diag) { const float tf = __builtin_amdgcn_exp2f((float)(128 * (qi - (kt >> 1))) * lg2);
#pragma unroll
                      for (int i = 0; i < 8; ++i) pk[i] = cvt_pk_bf16(st[2 * i] * tf, st[2 * i + 1] * tf);
                  } else { const int lim = wr * 32 + l31 + (2 * qi - kt) * 64 - 32 * wc - 4 * hh;
#pragma unroll
                      for (int i = 0; i < 8; ++i) { const int r0 = 2 * i, r1 = 2 * i + 1, o0 = (r0 & 3) + 8 * (r0 >> 2), o1 = (r1 & 3) + 8 * (r1 >> 2);
                          pk[i] = cvt_pk_bf16((o0 <= lim) ? st[r0] : 0.f, (o1 <= lim) ? st[r1] : 0.f); } }
                  LAS unsigned char* pw = lds + RT_P + ((wr * 2 + wc) * 2) * 1024 + lane * 16;
                  *(LAS u32x4*)pw = (u32x4){pk[0], pk[1], pk[2], pk[3]}; *(LAS u32x4*)(pw + 1024) = (u32x4){pk[4], pk[5], pk[6], pk[7]}; }
                RT_BAR();
                { bf16x8 pf[2][2];
#pragma unroll
                  for (int kb2 = 0; kb2 < 2; ++kb2)
#pragma unroll
                      for (int s = 0; s < 2; ++s) pf[kb2][s] = *(const LAS bf16x8*)(lds + RT_P + ((wr * 2 + kb2) * 2 + s) * 1024 + lane * 16);
                  const LAS unsigned char* vb = lds + RT_V0 + bf * 32768 + (128 * wc + l31) * 128 + 8 * hh;
#define RT_VRD(dst, db) do { _Pragma("unroll") for (int j_ = 0; j_ < 4; ++j_) { const int v_ = 4 * (j_ >> 1) + 2 * (j_ & 1); \
                      const u32x2 lo_ = *(const LAS u32x2*)(vb + (db) * 4096 + ((v_ << 4) ^ m4)), hi_ = *(const LAS u32x2*)(vb + (db) * 4096 + (((v_ + 1) << 4) ^ m4)); \
                      dst[j_] = (u32x4){lo_.x, lo_.y, hi_.x, hi_.y}; } } while (0)
#define RT_VMM(src, db) do { _Pragma("unroll") for (int j_ = 0; j_ < 4; ++j_) oacc[db] = __builtin_amdgcn_mfma_f32_32x32x16_bf16(pf[j_ >> 1][j_ & 1], __builtin_bit_cast(bf16x8, src[j_]), oacc[db], 0, 0, 0); } while (0)
                  u32x4 va[4], vc[4];
                  RT_VRD(va, 0); __builtin_amdgcn_sched_barrier(0);
                  RT_VRD(vc, 1); RT_VMM(va, 0); __builtin_amdgcn_sched_barrier(0);
                  RT_VRD(va, 2); RT_VMM(vc, 1); __builtin_amdgcn_sched_barrier(0);
                  RT_VRD(vc, 3); RT_VMM(va, 2); __builtin_amdgcn_sched_barrier(0);
                  RT_VMM(vc, 3); __builtin_amdgcn_sched_barrier(0);
#undef RT_VRD
#undef RT_VMM
                }
                asm volatile("s_waitcnt vmcnt(0)" ::: "memory"); RT_BAR();
            }
            int le_ = tid; asm volatile("" : "+v"(le_));
            const int tide = le_, l31e = le_ & 31, hhe = (le_ >> 5) & 1;
            float ssr[16];
#pragma unroll
            for (int r = 0; r < 16; ++r) { float s2 = 0.f;
#pragma unroll
                for (int db = 0; db < 4; ++db) { const float o = oacc[db][r]; s2 += o * o; }
                s2 = xor_add<1>(s2); s2 = xor_add<2>(s2); s2 = xor_add<4>(s2); s2 = xor_add<8>(s2); s2 = xor_add<16>(s2); ssr[r] = s2; }
            if (l31e == 0) {
#pragma unroll
                for (int i = 0; i < 4; ++i) *(LAS f32x4*)(lds + RT_RED + w * 128 + hhe * 64 + i * 16) = (f32x4){ssr[4 * i], ssr[4 * i + 1], ssr[4 * i + 2], ssr[4 * i + 3]}; }
            RT_BAR();
#pragma unroll
            for (int i = 0; i < 4; ++i) { const f32x4 t = *(const LAS f32x4*)(lds + RT_RED + (w ^ 4) * 128 + hhe * 64 + i * 16);
#pragma unroll
                for (int j = 0; j < 4; ++j) ssr[4 * i + j] = __builtin_amdgcn_rsqf((ssr[4 * i + j] + t[j]) * (1.f / 256.f) + EPS); }
#pragma unroll
            for (int r = 0; r < 16; ++r) { LAS unsigned char* ow = lds + (wr * 32 + 4 * hhe + (r & 3) + 8 * (r >> 2)) * RT_OLD + (128 * wc + l31e) * 2;
#pragma unroll
                for (int db = 0; db < 4; ++db) *(LAS unsigned short*)(ow + db * 64) = (unsigned short)f2bf(oacc[db][r] * ssr[r]); }
            RT_BAR();
#pragma unroll
            for (int i = 0; i < 8; ++i) { const int idx = i * 512 + tide, row = idx >> 5, ch = idx & 31; const size_t tok = tokq + row;
                const u32x4 o = *(const LAS u32x4*)(lds + row * RT_OLD + ch * 16), gv = *(const u32x4*)(grg + tok * DR + h * 256 + ch * 8);
                u32x4 y;
                y.x = cvt_pk_bf16(bf2f(o.x & 0xffffu) * bf2f(gv.x & 0xffffu), bf2f(o.x >> 16) * bf2f(gv.x >> 16)); y.y = cvt_pk_bf16(bf2f(o.y & 0xffffu) * bf2f(gv.y & 0xffffu), bf2f(o.y >> 16) * bf2f(gv.y >> 16));
                y.z = cvt_pk_bf16(bf2f(o.z & 0xffffu) * bf2f(gv.z & 0xffffu), bf2f(o.z >> 16) * bf2f(gv.z >> 16)); y.w = cvt_pk_bf16(bf2f(o.w & 0xffffu) * bf2f(gv.w & 0xffffu), bf2f(o.w >> 16) * bf2f(gv.w >> 16));
                *(u32x4*)(ycat + tok * DM + DS + h * 256 + ch * 8) = y; }
            asm volatile("s_waitcnt vmcnt(0)" ::: "memory"); RT_BAR();
#undef RT_DMA
        }
    }
}

__device__ __forceinline__ void p3_glu(const Frame& F, ArgsP a, int l) {
    pg8::StaticOrder S; S.init(MTOK, DS, F.G, F.bid);
    pg8::Gemm g{(const bf16_t*)(F.ws + WS_YG), (const bf16_t*)(F.ws + WS_WTGLU) + (size_t)l * DS * DS, DS, DS, DS, -1};
    EpiGlu E{(const bf16_t*)(F.ws + WS_YG), (const bf16_t*)(F.ws + WS_GS), a->in[I_BGLU] + (size_t)l * DS, (bf16_t*)(F.ws + WS_YCAT), (float*)(F.ws + WS_SSQ2)};
    pg8::gemm_phase<EpiGlu, pg8::StaticOrder, true, true>(F.lds, g, S, E, fresh_tid(F));
}

__device__ __forceinline__ void p4_out(const Frame& F, ArgsP a, int l) {
    pg8::StaticOrder S; S.init(MTOK, DM, F.G, F.bid); Unit u0; S.next(0, u0);
    stash_rstd(F, (const float*)(F.ws + WS_SSQ2), 32, u0.pm, 1.f / DS);
    pg8::Gemm g{(const bf16_t*)(F.ws + WS_YCAT), (const bf16_t*)(F.ws + WS_WTOUT) + (size_t)l * DM * DM, DM, DM, DM, DS / 64};
    if (l == 0) { EpiOut<false> E{(const LAS float*)(F.lds + STASH_OFF), a->in[I_X], (bf16_t*)(F.ws + WS_XB), (float*)(F.ws + WS_SSQX)};
        pg8::gemm_phase<EpiOut<false>, pg8::StaticOrder, true, true>(F.lds, g, S, E, fresh_tid(F)); }
    else { EpiOut<true> E{(const LAS float*)(F.lds + STASH_OFF), (const void*)(F.ws + WS_XB), (bf16_t*)(F.ws + WS_XB), (float*)(F.ws + WS_SSQX)};
        pg8::gemm_phase<EpiOut<true>, pg8::StaticOrder, true, true>(F.lds, g, S, E, fresh_tid(F)); }
}

__device__ __forceinline__ void p5_final(const Frame& F, ArgsP a) {
    const int lane0 = fresh_tid(F) & 63;
    const int gw = F.vcu * 8 + F.wave, NGW = F.G * 8; const f32x4* fw = (const f32x4*)a->in[I_FNW];
    for (int m = gw; m < MTOK; m += NGW) {
        const float s = wave_sum(((const float*)(F.ws + WS_SSQX))[(size_t)m * 64 + lane0]); const float rstd = __builtin_amdgcn_rsqf(s * (1.f / DM) + EPS);
        const u32x4* xr = (const u32x4*)((const bf16_t*)(F.ws + WS_XB) + (size_t)m * DM) + lane0; f32x4* orow = (f32x4*)(a->out + (size_t)m * DM);
#pragma unroll
        for (int j = 0; j < 8; ++j) { const u32x4 v = xr[64 * j]; const int c4 = (64 * j + lane0) * 2;
            const f32x4 w0 = fw[c4], w1 = fw[c4 + 1];
            orow[c4] = (f32x4){bf2f(v.x & 0xffffu), bf2f(v.x >> 16), bf2f(v.y & 0xffffu), bf2f(v.y >> 16)} * rstd * w0;
            orow[c4 + 1] = (f32x4){bf2f(v.z & 0xffffu), bf2f(v.z >> 16), bf2f(v.w & 0xffffu), bf2f(v.w >> 16)} * rstd * w1; }
    }
}


#define XB_TMO      128
#define XB_XCNT(j)  (256  + 64 * (j))
#define XB_XSUB(j)  (1280 + 64 * (j))
#define XB_XGEN(j)  (2304 + 64 * (j))
#define XB_TOP      3328
#define XB_TOPGEN   3392
#define XCD_BAR_WORDS 3456
#define XB_SPIN_CAP (1u << 18)
__device__ __forceinline__ unsigned xb_ld(unsigned* p)              { return __hip_atomic_load(p, __ATOMIC_RELAXED, __HIP_MEMORY_SCOPE_AGENT); }
__device__ __forceinline__ unsigned xb_add(unsigned* p, unsigned v) { return __hip_atomic_fetch_add(p, v, __ATOMIC_RELAXED, __HIP_MEMORY_SCOPE_AGENT); }
__device__ __forceinline__ unsigned xb_xcc_id() { return (unsigned)__builtin_amdgcn_s_getreg((3 << 11) | 20) & 0xFu; }
#define XB_SPIN(cond, bar) do { unsigned _sp = 0; while (cond) { __builtin_amdgcn_s_sleep(1); \
    if ((++_sp & 255u) == 0u) { if (xb_ld(&(bar)[XB_TMO])) break; if (_sp > XB_SPIN_CAP) { atomicAdd(&(bar)[XB_TMO], 1u); break; } } } } while (0)
struct XcdBarrier { unsigned* bar; unsigned x; volatile LAS unsigned* st; };
__device__ __forceinline__ XcdBarrier xcd_barrier_post(unsigned* bar, volatile LAS unsigned* st, bool leader) {
    XcdBarrier b; b.bar = bar; b.x = xb_xcc_id(); b.st = st;
    if (leader) (void)xb_add(&bar[XB_XCNT(b.x)], 1u);
    return b;
}
__device__ __forceinline__ void xcd_barrier_complete(unsigned* bar, unsigned x, unsigned& nloc, unsigned& nx) {
    const unsigned G = gridDim.x * gridDim.y * gridDim.z;
    unsigned sum, cnt, mine, sp = 0u;
    for (;;) {
        sum = 0u; cnt = 0u; mine = 0u;
#pragma unroll
        for (unsigned j = 0; j < 16; ++j) { const unsigned c = xb_ld(&bar[XB_XCNT(j)]); sum += c; cnt += (c > 0u) ? 1u : 0u; mine = (j == x) ? c : mine; }
        if (sum == G) break;
        __builtin_amdgcn_s_sleep(1);
        if ((++sp & 255u) == 0u) { if (xb_ld(&bar[XB_TMO])) break; if (sp > XB_SPIN_CAP) { atomicAdd(&bar[XB_TMO], 1u); break; } }
    }
    nloc = mine > 0u ? mine : 1u; nx = cnt > 0u ? cnt : 1u;
}
__device__ __forceinline__ void xcd_barrier(const XcdBarrier& b, bool leader) {
    asm volatile("s_waitcnt vmcnt(0)" ::: "memory");
    __syncthreads();
    if (leader) {
        unsigned* bar = b.bar;
        __builtin_amdgcn_s_waitcnt(0);
        unsigned nloc = b.st[0], nx = b.st[1];
        if (nloc == 0u) { xcd_barrier_complete(bar, b.x, nloc, nx); b.st[0] = nloc; b.st[1] = nx; }
        const unsigned old = xb_add(&bar[XB_XSUB(b.x)], 1u);
        const unsigned gen = old / nloc;
        if (old + 1u == (gen + 1u) * nloc) {
            __builtin_amdgcn_fence(__ATOMIC_RELEASE, "agent");
            asm volatile("s_waitcnt vmcnt(0)" ::: "memory");
            const unsigned og = xb_add(&bar[XB_TOP], 1u);
            const unsigned tg = og / nx;
            if (og + 1u == (tg + 1u) * nx) xb_add(&bar[XB_TOPGEN], 1u);
            else XB_SPIN(xb_ld(&bar[XB_TOPGEN]) == tg, bar);
            __builtin_amdgcn_fence(__ATOMIC_ACQUIRE, "agent");
            xb_add(&bar[XB_XGEN(b.x)], 1u);
            asm volatile("s_waitcnt vmcnt(0)" ::: "memory");
        } else {
            XB_SPIN(xb_ld(&bar[XB_XGEN(b.x)]) == gen, bar);
            __builtin_amdgcn_fence(__ATOMIC_ACQUIRE, "agent");
            asm volatile("s_waitcnt vmcnt(0)" ::: "memory");
        }
    }
    __syncthreads();
}

constexpr int NPH = 2 + 4 * DEPTH;
__global__ void __launch_bounds__(512, 2) mk_fwd(Args args) {
    extern __shared__ __attribute__((aligned(16))) unsigned char lds_raw[];
    Frame F; F.lds = (LAS unsigned char*)lds_raw; F.G = gridDim.x;
    volatile LAS unsigned* bst = (volatile LAS unsigned*)(F.lds + BAR_ST_OFF);
    if (threadIdx.x < 2) bst[threadIdx.x] = 0u;
    __syncthreads();
    const XcdBarrier gbar = xcd_barrier_post((unsigned*)(args.ws + WS_CTL), bst, threadIdx.x == 0);
    const int wave0 = __builtin_amdgcn_readfirstlane((int)threadIdx.x >> 6);
    for (int ph = args.ph_lo; ph < args.ph_hi; ++ph) {
        ArgsP ap = (ArgsP)__builtin_amdgcn_kernarg_segment_ptr(); asm volatile("" : "+s"(ap));
        { F.wave = wave0;
          int b_ = blockIdx.x; asm volatile("" : "+s"(b_)); F.bid = b_; F.vcu = (F.G % 8 == 0) ? (b_ % 8) * (F.G / 8) + b_ / 8 : b_;
          size_t z_ = 0; asm volatile("" : "+s"(z_)); F.ws = ap->ws + z_; }
#ifndef PHMASK
#define PHMASK 127
#endif
        if (ph == 0) { if (PHMASK & 1) p0_prologue(F, ap); }
        else if (ph == NPH - 1) { if (PHMASK & 32) p5_final(F, ap); }
        else { const int l = (ph - 1) >> 2, s = (ph - 1) & 3;
            if (s == 0) { if (PHMASK & 2) p1_inproj(F, l); }
            else if (s == 1) {
#if FAST_SSM
                if (PHMASK & 4) p2_ssm(F, ap, l);
#endif
#if FAST_RET
                if (PHMASK & 64) p2_ret(F);
#endif
            }
            else if (s == 2) { if (PHMASK & 8) p3_glu(F, ap, l); }
            else { if (PHMASK & 16) p4_out(F, ap, l); } }
#ifdef REPEAT_MASK
        __syncthreads();
        { const int s2 = (ph - 1) & 3, l2 = (ph - 1) >> 2;
          if (ph == 0) { if (REPEAT_MASK & 1) p0_prologue(F, ap); if (REPEAT_MASK >> 8) p0_prologue(F, ap, REPEAT_MASK >> 8); }
          else if (ph < NPH - 1) {
            if (s2 == 0 && (REPEAT_MASK & 2)) p1_inproj(F, l2);
            if (s2 == 1 && (REPEAT_MASK & 4)) p2_ssm(F, ap, l2);
            if (s2 == 1 && (REPEAT_MASK & 64)) p2_ret(F);
            if (s2 == 2 && (REPEAT_MASK & 8)) p3_glu(F, ap, l2);
            if (s2 == 3 && (REPEAT_MASK & 16)) p4_out(F, ap, l2); } }
#endif
        if (ph + 1 < args.ph_hi) xcd_barrier(gbar, fresh_tid(F) == 0);
    }
}

__global__ void __launch_bounds__(64) naive_ssm(Args args, int l) {
    const int b = blockIdx.x >> 7, g = blockIdx.x & 127, lg = l * NG + g, n = threadIdx.x;
    const double dt = (double)expf(args.in[I_LOGDT][lg]);
    const float lr = args.in[I_LRE][lg * 64 + n], li = args.in[I_LIM][lg * 64 + n];
    float ac, as; cis_d((double)li * dt, ac, as); const float mag = expf(lr * (float)dt); const float ar = mag * ac, ai = mag * as;
    const float nr = ar - 1.f, ni = ai, den = lr * lr + li * li, cor = (nr * lr + ni * li) / den, coi = (ni * lr - nr * li) / den;
    float bbr[16], bbi[16], cr[16], ci[16];
#pragma unroll
    for (int h = 0; h < 16; ++h) { const float br = args.in[I_BRE][(size_t)(lg * 64 + n) * 16 + h], bi = args.in[I_BIM][(size_t)(lg * 64 + n) * 16 + h];
        bbr[h] = cor * br - coi * bi; bbi[h] = cor * bi + coi * br; cr[h] = args.in[I_CRE][(size_t)(lg * 16 + h) * 64 + n]; ci[h] = args.in[I_CIM][(size_t)(lg * 16 + h) * 64 + n]; }
    const float dsk = args.in[I_D][(size_t)l * DS + g * 16 + (n & 15)];
    const bf16_t* a2g = (const bf16_t*)(args.ws + WS_A2U) + (size_t)g * 512 * A2LD; bf16_t* yg = (bf16_t*)(args.ws + WS_YG);
    float sr = 0.f, si = 0.f;
    for (int t = 0; t < SEQ; ++t) {
        const u32x4* up = (const u32x4*)(a2g + (size_t)(b * 128 + (t >> 4)) * A2LD + (t & 15) * 16); const u32x4 u0 = up[0], u1 = up[1];
        float uv[16];
        uv[0] = bf2f(u0.x & 0xffffu); uv[1] = bf2f(u0.x >> 16); uv[2] = bf2f(u0.y & 0xffffu); uv[3] = bf2f(u0.y >> 16); uv[4] = bf2f(u0.z & 0xffffu); uv[5] = bf2f(u0.z >> 16); uv[6] = bf2f(u0.w & 0xffffu); uv[7] = bf2f(u0.w >> 16);
        uv[8] = bf2f(u1.x & 0xffffu); uv[9] = bf2f(u1.x >> 16); uv[10] = bf2f(u1.y & 0xffffu); uv[11] = bf2f(u1.y >> 16); uv[12] = bf2f(u1.z & 0xffffu); uv[13] = bf2f(u1.z >> 16); uv[14] = bf2f(u1.w & 0xffffu); uv[15] = bf2f(u1.w >> 16);
        float bur = 0.f, bui = 0.f;
#pragma unroll
        for (int h = 0; h < 16; ++h) { bur += bbr[h] * uv[h]; bui += bbi[h] * uv[h]; }
        const float nsr = ar * sr - ai * si + bur, nsi = ar * si + ai * sr + bui; sr = nsr; si = nsi;
        float y = 0.f, um = 0.f;
#pragma unroll
        for (int h = 0; h < 16; ++h) { const float p = wave_sum(cr[h] * sr - ci[h] * si); if (n == h) { y = p; um = uv[h]; } }
        if (n < 16) yg[(size_t)(b * SEQ + t) * DS + g * 16 + n] = (bf16_t)f2bf(gelu_tanh_f(y + dsk * um));
    }
}

constexpr int NR_KLD = 264;
__global__ void __launch_bounds__(256) naive_ret(Args args, int l) {
    extern __shared__ __attribute__((aligned(16))) unsigned char sm[];
    bf16_t* Qs = (bf16_t*)sm;
    bf16_t* Ks = Qs + 32 * 256;
    float* Ss = (float*)(Ks + 64 * NR_KLD);
    float* red = Ss + 32 * 64;
    const int qt = blockIdx.x & 63, h = (blockIdx.x >> 6) & 7, b = blockIdx.x >> 9, tid = threadIdx.x, lane = tid & 63, wv = tid >> 6;
    const bf16_t* q = (const bf16_t*)(args.ws + WS_Q); const bf16_t* k = (const bf16_t*)(args.ws + WS_K); const bf16_t* vt = (const bf16_t*)(args.ws + WS_VT); const bf16_t* gr = (const bf16_t*)(args.ws + WS_GR);
    const int tok0 = b * SEQ + qt * 32;
    for (int e = tid; e < 32 * 32; e += 256) { const int r = e >> 5, c = (e & 31) * 8; *(u32x4*)(Qs + r * 256 + c) = *(const u32x4*)(q + (size_t)(tok0 + r) * DR + h * 256 + c); }
    const float lg2 = log2f(1.f - exp2f(-5.f - (float)h));
    float o[32];
#pragma unroll
    for (int r = 0; r < 32; ++r) o[r] = 0.f;
    const int ntile = qt / 2 + 1;
    for (int kt = 0; kt < ntile; ++kt) {
        __syncthreads();
        for (int e = tid; e < 64 * 32; e += 256) { const int r = e >> 5, c = (e & 31) * 8; *(u32x4*)(Ks + r * NR_KLD + c) = *(const u32x4*)(k + (size_t)(b * SEQ + kt * 64 + r) * DR + h * 256 + c); }
        __syncthreads();
        { const int key = lane, rg = wv; float acc[8];
#pragma unroll
          for (int r = 0; r < 8; ++r) acc[r] = 0.f;
          for (int d = 0; d < 256; d += 8) { const u32x4 kv = *(const u32x4*)(Ks + key * NR_KLD + d);
              const float k0 = bf2f(kv.x & 0xffffu), k1 = bf2f(kv.x >> 16), k2 = bf2f(kv.y & 0xffffu), k3 = bf2f(kv.y >> 16), k4 = bf2f(kv.z & 0xffffu), k5 = bf2f(kv.z >> 16), k6 = bf2f(kv.w & 0xffffu), k7 = bf2f(kv.w >> 16);
#pragma unroll
              for (int r = 0; r < 8; ++r) { const u32x4 qv = *(const u32x4*)(Qs + (rg * 8 + r) * 256 + d);
                  acc[r] += bf2f(qv.x & 0xffffu) * k0 + bf2f(qv.x >> 16) * k1 + bf2f(qv.y & 0xffffu) * k2 + bf2f(qv.y >> 16) * k3 + bf2f(qv.z & 0xffffu) * k4 + bf2f(qv.z >> 16) * k5 + bf2f(qv.w & 0xffffu) * k6 + bf2f(qv.w >> 16) * k7; } }
#pragma unroll
          for (int r = 0; r < 8; ++r) { const int i = qt * 32 + rg * 8 + r, j = kt * 64 + key; Ss[(rg * 8 + r) * 64 + key] = (i >= j) ? acc[r] * exp2f((float)(128 * ((i >> 7) - (j >> 7))) * lg2) : 0.f; } }
        __syncthreads();
        { const bf16_t* vr = vt + (size_t)(h * 256 + tid) * MTOK + b * SEQ + kt * 64;
          for (int kk = 0; kk < 64; kk += 8) { const u32x4 vv = *(const u32x4*)(vr + kk);
              const float v0 = bf2f(vv.x & 0xffffu), v1 = bf2f(vv.x >> 16), v2 = bf2f(vv.y & 0xffffu), v3 = bf2f(vv.y >> 16), v4 = bf2f(vv.z & 0xffffu), v5 = bf2f(vv.z >> 16), v6 = bf2f(vv.w & 0xffffu), v7 = bf2f(vv.w >> 16);
#pragma unroll
              for (int r = 0; r < 32; ++r) { const f32x4 s0 = *(const f32x4*)(Ss + r * 64 + kk), s1 = *(const f32x4*)(Ss + r * 64 + kk + 4);
                  o[r] += s0[0] * v0 + s0[1] * v1 + s0[2] * v2 + s0[3] * v3 + s1[0] * v4 + s1[1] * v5 + s1[2] * v6 + s1[3] * v7; } } }
    }
    __syncthreads();
#pragma unroll
    for (int r = 0; r < 32; ++r) { const float p = wave_sum(o[r] * o[r]); if (lane == 0) red[r * 4 + wv] = p; }
    __syncthreads();
    bf16_t* ycat = (bf16_t*)(args.ws + WS_YCAT);
#pragma unroll
    for (int r = 0; r < 32; ++r) { const float ss = (red[r * 4] + red[r * 4 + 1]) + (red[r * 4 + 2] + red[r * 4 + 3]); const float rstd = __builtin_amdgcn_rsqf(ss * (1.f / 256.f) + EPS);
        const size_t tok = (size_t)(tok0 + r); ycat[tok * DM + DS + h * 256 + tid] = (bf16_t)f2bf(o[r] * rstd * bf2f(gr[tok * DR + h * 256 + tid])); }
}

extern "C" void kernel_launch(void* const* d_in, const int* in_sizes, int n_in, void* d_out, int out_size, void* d_ws, size_t ws_size, hipStream_t stream) {
    static int grid = 0;
    if (grid == 0) {
        if (n_in != 17 || in_sizes[0] != MTOK * DM || out_size != MTOK * DM || ws_size < WS_END) { fprintf(stderr, "kernel_launch: unexpected problem (n_in %d, x %d, out %d, ws %zu)\n", n_in, n_in > 0 ? in_sizes[0] : -1, out_size, ws_size); grid = -1; return; }
        int dev = 0, cus = 0, per_cu = 0;
        hipGetDevice(&dev); hipDeviceGetAttribute(&cus, hipDeviceAttributeMultiprocessorCount, dev);
        if (hipFuncSetAttribute((const void*)mk_fwd, hipFuncAttributeMaxDynamicSharedMemorySize, LDS_BYTES) != hipSuccess) { fprintf(stderr, "kernel_launch: hipFuncSetAttribute failed\n"); grid = -1; return; }
        hipFuncSetAttribute((const void*)naive_ret, hipFuncAttributeMaxDynamicSharedMemorySize, 65536);
        hipOccupancyMaxActiveBlocksPerMultiprocessor(&per_cu, (const void*)mk_fwd, 512, LDS_BYTES);
        (void)hipGetLastError();
        if (per_cu < 1) fprintf(stderr, "kernel_launch: occupancy query says %d blocks per CU\n", per_cu);
        grid = cus;
        if (grid != 256) fprintf(stderr, "kernel_launch: %d CUs (phase balance assumes 256)\n", grid);
        for (int c = 0; c < grid; ++c) { pg8::StaticOrder S; Unit u0, u;
            S.init(MTOK, 10240, grid, c); S.next(0, u0); for (int i = 1; S.next(i, u); ++i) if (u.pm != u0.pm) { fprintf(stderr, "kernel_launch: in-proj unit order breaks the one-panel-per-workgroup assumption\n"); grid = -1; return; }
            S.init(DR, MTOK, grid, c); S.next(0, u0); for (int i = 1; S.next(i, u); ++i) if (u.pn != u0.pn) { fprintf(stderr, "kernel_launch: V^T unit order breaks the assumption\n"); grid = -1; return; }
            S.init(MTOK, DM, grid, c); S.next(0, u0); for (int i = 1; S.next(i, u); ++i) if (u.pm != u0.pm) { fprintf(stderr, "kernel_launch: out-proj unit order breaks the assumption\n"); grid = -1; return; } }
    }
    if (grid < 0) return;
    Args a{};
    for (int i = 0; i < 17; ++i) a.in[i] = (const float*)d_in[i];
    a.out = (float*)d_out; a.ws = (unsigned char*)d_ws;
    if (hipMemsetAsync((char*)d_ws + WS_CTL, 0, 16384, stream) != hipSuccess) { fprintf(stderr, "kernel_launch: hipMemsetAsync of the barrier words failed\n"); return; }
    auto launch = [&](int lo, int hi) { a.ph_lo = lo; a.ph_hi = hi;
        hipLaunchKernelGGL(mk_fwd, dim3(grid), dim3(512), LDS_BYTES, stream, a);
        const hipError_t e = hipPeekAtLastError();
        if (e != hipSuccess) fprintf(stderr, "kernel_launch: launch [%d,%d) failed: %s\n", lo, hi, hipGetErrorString(e)); };
#if FAST_SSM && FAST_RET && ONE_LAUNCH
    launch(0, NPH);
#else
    launch(0, 1);
    for (int l = 0; l < DEPTH; ++l) {
        launch(1 + 4 * l, 2 + 4 * l);
        launch(2 + 4 * l, 3 + 4 * l);
#if !FAST_SSM
        hipLaunchKernelGGL(naive_ssm, dim3(BATCH * NG), dim3(64), 0, stream, a, l);
#endif
#if !FAST_RET
        hipLaunchKernelGGL(naive_ret, dim3(BATCH * RH * 64), dim3(256), 32 * 256 * 2 + 64 * NR_KLD * 2 + 32 * 64 * 4 + 32 * 4 * 4, stream, a, l);
#endif
        launch(3 + 4 * l, 4 + 4 * l);
        launch(4 + 4 * l, 5 + 4 * l);
    }
    launch(NPH - 1, NPH);
#endif
}
```

```cpp
#include <hip/hip_runtime.h>
#include <cstdio>
#include <cstdint>

#ifndef FAST_SSM
#define FAST_SSM 1
#endif
#ifndef FAST_RET
#define FAST_RET 1
#endif

#ifndef ONE_LAUNCH
#define ONE_LAUNCH 1
#endif

#define LAS __attribute__((address_space(3)))
typedef unsigned short bf16_t;
typedef short bf16x8 __attribute__((ext_vector_type(8)));
typedef float f32x4 __attribute__((ext_vector_type(4)));
typedef float f32x2 __attribute__((ext_vector_type(2)));
typedef unsigned u32x4 __attribute__((ext_vector_type(4)));
typedef unsigned u32x2 __attribute__((ext_vector_type(2)));

constexpr int BATCH = 4, SEQ = 2048, DM = 4096, DEPTH = 2, DS = 2048, DR = 2048, NG = 128, SG = 16, NST = 64, RH = 8, RD = 256;
constexpr int NPROJ = 12288, MTOK = BATCH * SEQ;
constexpr float EPS = 1e-6f;
constexpr int TCH = 16;
constexpr int A2LD = 384;

constexpr size_t MiB = 1u << 20;
constexpr size_t WS_CTL = 0;
constexpr size_t WS_WTIN = 16 * MiB;
constexpr size_t WS_WTGLU = 208 * MiB;
constexpr size_t WS_WTOUT = 224 * MiB;
constexpr size_t WS_BT2 = 288 * MiB;
constexpr size_t WS_PM = 336 * MiB;
constexpr size_t WS_A16 = 368 * MiB;
constexpr size_t WS_ROPE = 369 * MiB;
constexpr size_t WS_SSQX = 371 * MiB;
constexpr size_t WS_SSQ2 = 373 * MiB;
constexpr size_t WS_XB = 384 * MiB;
constexpr size_t WS_X1 = 448 * MiB;
constexpr size_t WS_A2U = 576 * MiB;
constexpr size_t WS_GS = 624 * MiB, WS_Q = 656 * MiB, WS_K = 688 * MiB, WS_VT = 720 * MiB, WS_GR = 752 * MiB, WS_YG = 784 * MiB;
constexpr size_t WS_YCAT = 816 * MiB;
constexpr size_t WS_END = 880 * MiB;

constexpr int RING_BYTES = 131072;
constexpr int STASH_OFF = 155648;
constexpr int BAR_ST_OFF = 157696;
constexpr int LDS_BYTES = 163840 - 4096;

__device__ __forceinline__ unsigned f2bf(float f) { unsigned u = __builtin_bit_cast(unsigned, f); return (u + 0x7fffu + ((u >> 16) & 1u)) >> 16; }
__device__ __forceinline__ unsigned pk2(float lo, float hi) { return f2bf(lo) | (f2bf(hi) << 16); }
__device__ __forceinline__ float bf2f(unsigned v) { return __builtin_bit_cast(float, v << 16); }
__device__ __forceinline__ unsigned cvt_pk_bf16(float lo, float hi) { unsigned r; asm volatile("v_cvt_pk_bf16_f32 %0, %1, %2" : "=v"(r) : "v"(lo), "v"(hi)); return r; }
__device__ __forceinline__ float silu_f(float x) { return x * __builtin_amdgcn_rcpf(1.f + __expf(-x)); }
__device__ __forceinline__ float sigmoid_f(float x) { return __builtin_amdgcn_rcpf(1.f + __expf(-x)); }
__device__ __forceinline__ float gelu_tanh_f(float x) {
    const float z = 0.7978845608028654f * (x + 0.044715f * x * x * x);
    const float th = 1.f - 2.f * __builtin_amdgcn_rcpf(1.f + __expf(2.f * z));
    return 0.5f * x * (1.f + th);
}
template <int X> __device__ __forceinline__ float xor_add(float v) {
    if constexpr (X == 32) { const unsigned u = __builtin_bit_cast(unsigned, v); auto r = __builtin_amdgcn_permlane32_swap(u, u, false, false);
        return __builtin_bit_cast(float, (unsigned)r[0]) + __builtin_bit_cast(float, (unsigned)r[1]); }
    else return v + __builtin_bit_cast(float, __builtin_amdgcn_ds_swizzle(__builtin_bit_cast(int, v), (X << 10) | 0x1f));
}
__device__ __forceinline__ float wave_sum(float v) {
    v = xor_add<1>(v); v = xor_add<2>(v); v = xor_add<4>(v); v = xor_add<8>(v); v = xor_add<16>(v); v = xor_add<32>(v);
    return v;
}
__device__ __forceinline__ void cis_d(double ph, float& c, float& s) {
    const double rv = ph * 0.15915494309189535;
    const float r = (float)(rv - __builtin_rint(rv));
    c = __builtin_amdgcn_cosf(r); s = __builtin_amdgcn_sinf(r);
}
#define LDS_WAIT() asm volatile("s_waitcnt lgkmcnt(0)" ::: "memory")
#define VM_WAIT() asm volatile("s_waitcnt vmcnt(0)" ::: "memory")

namespace pg8 {
constexpr int BM = 256, BK = 64, HALF = 128, HTB = HALF * BK * 2, STAGE_BYTES = 8 * HTB, NXCD = 8, WGM = 8;
__host__ __device__ __forceinline__ int lds_byte(int r, int c) { const int st = (r >> 4) * 2 + (c >> 5), rr = r & 15, cc = c & 31, ob = rr * 64 + cc * 2; return st * 1024 + (ob ^ (((ob >> 9) & 1) << 5)); }
__host__ __device__ __forceinline__ void stage_rc(int b, int& R, int& C) { const int st = b / 1024, sb = b % 1024, swz = sb ^ (((sb >> 9) & 1) << 5); R = (st >> 1) * 16 + swz / 64; C = (st & 1) * 32 + (swz % 64) / 2; }
__host__ __device__ __forceinline__ int perm32(int rho) { const int n = rho >> 4, i = rho & 15; return 8 * (i >> 2) + 4 * n + (i & 3); }

struct Unit { int pm, pn; };
struct Gemm { const bf16_t* A; const bf16_t* Bt; int K, lda, ldb, kmid; };

struct StaticOrder {
    int nM, nN, nwg, G, c;
    __host__ __device__ void init(int M, int N, int G_, int c_) { nM = M / BM; nN = N / BM; nwg = nM * nN; G = G_; c = c_; }
    __host__ __device__ bool next(int i, Unit& u) const {
        const long L = (long)i * G + c; if (L >= nwg) return false;
        int wgid = (int)L; { const int q = nwg / NXCD, r = nwg % NXCD, xcd = wgid % NXCD, off = wgid / NXCD; wgid = (xcd < r ? xcd * (q + 1) : r * (q + 1) + (xcd - r) * q) + off; }
        const int nig = WGM * nN, gid = wgid / nig, fm = gid * WGM, gsz = (nM - fm) < WGM ? (nM - fm) : WGM;
        u.pm = fm + ((wgid % nig) % gsz); u.pn = (wgid % nig) / gsz; return true;
    }
};
struct OneUnit {
    int pm, pn;
    __device__ __forceinline__ bool next(int i, Unit& u) const { if (i) return false; u.pm = pm; u.pn = pn; return true; }
};

template <class Epi, class Sched, bool ALIGN_EPI, bool SP2>
__device__ __forceinline__ void gemm_phase(LAS unsigned char* lds, const Gemm g, const Sched& S, const Epi& E, int tid_in) {
    int tid_ = tid_in; asm volatile("" : "+v"(tid_));
    const int tid = tid_, wid = __builtin_amdgcn_readfirstlane(tid >> 6), lane = tid & 63, wr = wid >> 2, wc = wid & 3, fr = lane & 15, fq = lane >> 4;
    const int K = g.K, nt = K / BK;
    unsigned voffA[2], voffB[2];
#pragma unroll
    for (int i = 0; i < 2; ++i) { int R, C; stage_rc(tid * 16 + i * 8192, R, C); const int Rb = Epi::PERM ? ((R & ~31) + perm32(R & 31)) : R;
        voffA[i] = (unsigned)(R * g.lda + C) * 2u; voffB[i] = (unsigned)(Rb * g.ldb + C) * 2u; }
    const size_t kstep = (size_t)(BK * 2);
    const size_t hstepA = (size_t)HALF * g.lda * 2, hstepB = (size_t)HALF * g.ldb * 2;
    const size_t tstepA = 2 * hstepA, tstepB = 2 * hstepB;
    const unsigned ldsw = (unsigned)wid * 1024u;
    const int aoff = lds_byte(wr * 64 + fr, fq * 8), boff = lds_byte(wc * 32 + fr, fq * 8);
#define PG8_SA(b, h) (((b) * 2 + (h)) * HTB)
#define PG8_SB(b, h) ((4 + (b) * 2 + (h)) * HTB)
#define PG8_STAGE(bufoff, gbase, voff) do { _Pragma("unroll") for (int _i = 0; _i < 2; ++_i) \
        __builtin_amdgcn_global_load_lds((const unsigned*)((const char*)(gbase) + (voff)[_i]), (LAS unsigned*)(lds + (bufoff) + ldsw + _i * 8192), 16, 0, 0); } while (0)
#define PG8_LDA(dst, b, h) do { _Pragma("unroll") for (int m = 0; m < 4; ++m) _Pragma("unroll") for (int k = 0; k < 2; ++k) dst[m][k] = *(const LAS bf16x8*)(lds + PG8_SA(b, h) + aoff + m * 2048 + k * 1024); } while (0)
#define PG8_LDB(dst, b, h) do { _Pragma("unroll") for (int n = 0; n < 2; ++n) _Pragma("unroll") for (int k = 0; k < 2; ++k) dst[n][k] = *(const LAS bf16x8*)(lds + PG8_SB(b, h) + boff + n * 2048 + k * 1024); } while (0)
#define PG8_MMA(ai, bj, At, Bt) do { __builtin_amdgcn_s_setprio(1); _Pragma("unroll") for (int m = 0; m < 4; ++m) _Pragma("unroll") for (int n = 0; n < 2; ++n) _Pragma("unroll") for (int k = 0; k < 2; ++k) \
        acc[ai][bj][m][n] = __builtin_amdgcn_mfma_f32_16x16x32_bf16(Bt[n][k], At[m][k], acc[ai][bj][m][n], 0, 0, 0); __builtin_amdgcn_s_setprio(0); } while (0)
#define PG8_WAIT_V(n) asm volatile("s_waitcnt vmcnt(" #n ")" ::: "memory")
#define PG8_WAIT_L(n) asm volatile("s_waitcnt lgkmcnt(" #n ")" ::: "memory")
#define PG8_BAR __builtin_amdgcn_s_barrier()
#define PG8_SCHED __builtin_amdgcn_sched_barrier(0)
    Unit cur, nxt; int ui = 0;
    if (!S.next(0, cur)) return;
    f32x4 acc[2][2][4][2];
#pragma unroll
    for (int a = 0; a < 2; ++a)
#pragma unroll
        for (int b = 0; b < 2; ++b)
#pragma unroll
            for (int m = 0; m < 4; ++m)
#pragma unroll
                for (int n = 0; n < 2; ++n) acc[a][b][m][n] = (f32x4){0.f, 0.f, 0.f, 0.f};
    bf16x8 At[4][2], B0[2][2], B1[2][2];
    const char* cA = (const char*)g.A + (size_t)cur.pm * tstepA; const char* cB = (const char*)g.Bt + (size_t)cur.pn * tstepB;
    if constexpr (SP2) {
        PG8_STAGE(PG8_SB(0, 0), cB, voffB); PG8_STAGE(PG8_SB(0, 1), cB + hstepB, voffB); PG8_STAGE(PG8_SA(0, 0), cA, voffA); PG8_STAGE(PG8_SA(0, 1), cA + hstepA, voffA);
        if (wr == 1) PG8_BAR;
        PG8_WAIT_V(2); PG8_BAR;
        PG8_STAGE(PG8_SB(1, 0), cB + kstep, voffB); PG8_STAGE(PG8_SA(1, 0), cA + kstep, voffA); PG8_STAGE(PG8_SB(1, 1), cB + hstepB + kstep, voffB);
        PG8_WAIT_V(6); PG8_BAR;
    } else {
        PG8_STAGE(PG8_SB(0, 0), cB, voffB); PG8_STAGE(PG8_SA(0, 0), cA, voffA); PG8_STAGE(PG8_SB(0, 1), cB + hstepB, voffB); PG8_STAGE(PG8_SA(0, 1), cA + hstepA, voffA);
        if (wr == 1) PG8_BAR;
        PG8_WAIT_V(4); PG8_BAR;
        PG8_STAGE(PG8_SB(1, 0), cB + kstep, voffB); PG8_STAGE(PG8_SA(1, 0), cA + kstep, voffA); PG8_STAGE(PG8_SB(1, 1), cB + hstepB + kstep, voffB);
        PG8_WAIT_V(6); PG8_BAR;
    }
    for (;;) {
        const bool has_next = S.next(ui + 1, nxt);
        const char* nA = has_next ? (const char*)g.A + (size_t)nxt.pm * tstepA : cA; const char* nB = has_next ? (const char*)g.Bt + (size_t)nxt.pn * tstepB : cB;
        for (int t = 0; t < nt; t += 2) {
            const bool last = (t == nt - 2);
            const char* a1 = cA + (size_t)(t + 1) * kstep;
            const char* a2 = last ? nA : cA + (size_t)(t + 2) * kstep; const char* b2 = last ? nB : cB + (size_t)(t + 2) * kstep;
            const char* a3 = a2 + kstep; const char* b3 = b2 + kstep;
            if constexpr (Epi::MIDK) { if (t == g.kmid) E.midk(acc, wr, fr); }
            if constexpr (SP2) {
            PG8_LDB(B0, 0, 0); PG8_LDB(B1, 0, 1); PG8_SCHED; PG8_LDA(At, 0, 0); PG8_STAGE(PG8_SA(1, 1), a1 + hstepA, voffA);
            PG8_WAIT_V(8); PG8_WAIT_L(0); PG8_BAR; PG8_MMA(0, 0, At, B0); PG8_MMA(0, 1, At, B1); PG8_BAR; PG8_SCHED;
            PG8_LDA(At, 0, 1); PG8_STAGE(PG8_SB(0, 0), b2, voffB); PG8_STAGE(PG8_SB(0, 1), b2 + hstepB, voffB); PG8_STAGE(PG8_SA(0, 0), a2, voffA);
            PG8_WAIT_V(8); PG8_WAIT_L(0); PG8_BAR; PG8_MMA(1, 0, At, B0); PG8_MMA(1, 1, At, B1); PG8_BAR; PG8_SCHED;
            PG8_LDB(B0, 1, 0); PG8_LDB(B1, 1, 1); PG8_SCHED; PG8_LDA(At, 1, 0); PG8_STAGE(PG8_SA(0, 1), a2 + hstepA, voffA);
            PG8_WAIT_V(8); PG8_WAIT_L(0); PG8_BAR; PG8_MMA(0, 0, At, B0); PG8_MMA(0, 1, At, B1); PG8_BAR; PG8_SCHED;
            PG8_LDA(At, 1, 1); PG8_STAGE(PG8_SB(1, 0), b3, voffB); PG8_STAGE(PG8_SB(1, 1), b3 + hstepB, voffB); PG8_STAGE(PG8_SA(1, 0), a3, voffA);
            PG8_WAIT_V(8); PG8_WAIT_L(0); PG8_BAR; PG8_MMA(1, 0, At, B0); PG8_MMA(1, 1, At, B1); PG8_BAR; PG8_SCHED;
            } else {
            PG8_LDB(B0, 0, 0); PG8_SCHED; PG8_LDA(At, 0, 0); PG8_STAGE(PG8_SA(1, 1), a1 + hstepA, voffA);
            PG8_WAIT_L(8); PG8_BAR; PG8_WAIT_L(0); PG8_MMA(0, 0, At, B0); PG8_BAR; PG8_SCHED;
            PG8_LDB(B1, 0, 1); PG8_STAGE(PG8_SB(0, 0), b2, voffB);
            PG8_BAR; PG8_WAIT_L(0); PG8_MMA(0, 1, At, B1); PG8_BAR;
            PG8_LDA(At, 0, 1); PG8_STAGE(PG8_SA(0, 0), a2, voffA);
            PG8_BAR; PG8_WAIT_L(0); PG8_MMA(1, 0, At, B0); PG8_BAR; PG8_SCHED;
            PG8_STAGE(PG8_SB(0, 1), b2 + hstepB, voffB);
            PG8_WAIT_V(6); PG8_BAR; PG8_MMA(1, 1, At, B1); PG8_BAR;
            PG8_LDB(B0, 1, 0); PG8_SCHED; PG8_LDA(At, 1, 0); PG8_STAGE(PG8_SA(0, 1), a2 + hstepA, voffA);
            PG8_WAIT_L(8); PG8_BAR; PG8_WAIT_L(0); PG8_MMA(0, 0, At, B0); PG8_BAR; PG8_SCHED;
            PG8_LDB(B1, 1, 1); PG8_STAGE(PG8_SB(1, 0), b3, voffB);
            PG8_BAR; PG8_WAIT_L(0); PG8_MMA(0, 1, At, B1); PG8_BAR;
            PG8_LDA(At, 1, 1); PG8_STAGE(PG8_SA(1, 0), a3, voffA);
            PG8_BAR; PG8_WAIT_L(0); PG8_MMA(1, 0, At, B0); PG8_BAR; PG8_SCHED;
            PG8_STAGE(PG8_SB(1, 1), b3 + hstepB, voffB);
            PG8_WAIT_V(6); PG8_BAR; PG8_MMA(1, 1, At, B1); PG8_BAR;
            }
        }
        if constexpr (ALIGN_EPI) { if (wr == 0) PG8_BAR; }
        if constexpr (!Epi::AFTER_DRAIN) { E(acc, cur, wr, wc, fr, fq); }
        if (!has_next) break;
#pragma unroll
        for (int a = 0; a < 2; ++a)
#pragma unroll
            for (int b = 0; b < 2; ++b)
#pragma unroll
                for (int m = 0; m < 4; ++m)
#pragma unroll
                    for (int n = 0; n < 2; ++n) acc[a][b][m][n] = (f32x4){0.f, 0.f, 0.f, 0.f};
        cur = nxt; cA = nA; cB = nB; ++ui;
        if constexpr (ALIGN_EPI) { if (wr == 1) PG8_BAR; }
    }
    PG8_WAIT_V(0);
    if constexpr (!ALIGN_EPI) { if (wr == 0) PG8_BAR; }
    PG8_BAR;
    if constexpr (Epi::AFTER_DRAIN) { E.fused(acc, cur, wr, wc, fr, fq, lds); }
#undef PG8_SA
#undef PG8_SB
#undef PG8_STAGE
#undef PG8_LDA
#undef PG8_LDB
#undef PG8_MMA
#undef PG8_WAIT_V
#undef PG8_WAIT_L
#undef PG8_BAR
#undef PG8_SCHED
}
}
using pg8::Unit;
typedef f32x4 Acc[2][2][4][2];

struct EpiInProj {
    static constexpr bool PERM = true, AFTER_DRAIN = false, MIDK = false;
    const LAS float* rs; bf16_t *a2u, *gs, *q, *k, *gr; const float* rope;
    __device__ __forceinline__ void operator()(const Acc& acc, const Unit& u, int wr, int wc, int fr, int fq) const {
        asm volatile("" : "+v"(fr), "+v"(fq));
        const int type = u.pn >> 3, colt = (u.pn & 7) << 8, c8 = wc * 32 + 8 * fq, lr0 = wr * 64 + fr;
        const bool rot = (type == 2 || type == 3);
        const float eh = __builtin_amdgcn_exp2f((float)(-5 - (u.pn & 7)));
        const float lg2h = -(eh * (1.f + eh * (0.5f + eh * (0.33333334f + eh * (0.25f + eh * (0.2f + eh * 0.16666667f)))))) * 1.4426950408889634f;
        f32x4 cur[4], nxt[4];
        if (rot) { const f32x4* cs = (const f32x4*)(rope + ((size_t)((u.pm * 256 + lr0) & 2047) * 128 + c8) * 2);
#pragma unroll
            for (int j = 0; j < 4; ++j) cur[j] = cs[j]; }
#pragma unroll
        for (int idx = 0; idx < 8; ++idx) { const int ai = idx >> 2, m = idx & 3;
                const int lr = lr0 + ai * 128 + m * 16, r = u.pm * 256 + lr; const float s = rs[lr];
                if (rot && idx < 7) { const f32x4* cs = (const f32x4*)(rope + ((size_t)((u.pm * 256 + lr0 + ((idx + 1) >> 2) * 128 + ((idx + 1) & 3) * 16) & 2047) * 128 + c8) * 2);
#pragma unroll
                    for (int j = 0; j < 4; ++j) nxt[j] = cs[j]; }
                f32x4 v[2][2];
#pragma unroll
                for (int bj = 0; bj < 2; ++bj)
#pragma unroll
                    for (int n = 0; n < 2; ++n) v[bj][n] = acc[ai][bj][m][n] * s;
                if (type == 0) {
#pragma unroll
                    for (int bj = 0; bj < 2; ++bj) { const int col = colt + bj * 128 + c8;
                        u32x4 w; w.x = cvt_pk_bf16(v[bj][0][0], v[bj][0][1]); w.y = cvt_pk_bf16(v[bj][0][2], v[bj][0][3]); w.z = cvt_pk_bf16(v[bj][1][0], v[bj][1][1]); w.w = cvt_pk_bf16(v[bj][1][2], v[bj][1][3]);
                        *(u32x4*)(a2u + ((size_t)((col >> 4) * 512 + (r >> 4)) * A2LD + (r & 15) * 16 + (col & 15))) = w; }
                } else if (type == 1 || type == 4) {
                    bf16_t* dst = (type == 1 ? gs : gr) + (size_t)r * 2048 + colt + c8;
#pragma unroll
                    for (int bj = 0; bj < 2; ++bj) {
                        u32x4 w; w.x = cvt_pk_bf16(silu_f(v[bj][0][0]), silu_f(v[bj][0][1])); w.y = cvt_pk_bf16(silu_f(v[bj][0][2]), silu_f(v[bj][0][3]));
                        w.z = cvt_pk_bf16(silu_f(v[bj][1][0]), silu_f(v[bj][1][1])); w.w = cvt_pk_bf16(silu_f(v[bj][1][2]), silu_f(v[bj][1][3]));
                        *(u32x4*)(dst + bj * 128) = w; }
                } else {
                    const float sc = (type == 3) ? 0.0625f * __builtin_amdgcn_exp2f(-(float)(r & 127) * lg2h) : __builtin_amdgcn_exp2f((float)(r & 127) * lg2h);
                    float o1[8], o2[8];
#pragma unroll
                    for (int jj = 0; jj < 4; ++jj) { const f32x4 t = cur[jj];
                        const float a0 = v[0][jj >> 1][(jj & 1) * 2], b0 = v[1][jj >> 1][(jj & 1) * 2], a1 = v[0][jj >> 1][(jj & 1) * 2 + 1], b1 = v[1][jj >> 1][(jj & 1) * 2 + 1];
                        o1[2 * jj] = (a0 * t[0] - b0 * t[1]) * sc; o2[2 * jj] = (b0 * t[0] + a0 * t[1]) * sc;
                        o1[2 * jj + 1] = (a1 * t[2] - b1 * t[3]) * sc; o2[2 * jj + 1] = (b1 * t[2] + a1 * t[3]) * sc; }
                    bf16_t* dst = (type == 2 ? q : k) + (size_t)r * 2048 + colt + c8;
                    u32x4 w; w.x = cvt_pk_bf16(o1[0], o1[1]); w.y = cvt_pk_bf16(o1[2], o1[3]); w.z = cvt_pk_bf16(o1[4], o1[5]); w.w = cvt_pk_bf16(o1[6], o1[7]);
                    *(u32x4*)dst = w;
                    w.x = cvt_pk_bf16(o2[0], o2[1]); w.y = cvt_pk_bf16(o2[2], o2[3]); w.z = cvt_pk_bf16(o2[4], o2[5]); w.w = cvt_pk_bf16(o2[6], o2[7]);
                    *(u32x4*)(dst + 128) = w;
#pragma unroll
                    for (int j = 0; j < 4; ++j) cur[j] = nxt[j];
                }
                asm volatile("" ::: "memory");
            }
    }
};
struct EpiVT {
    static constexpr bool PERM = true, AFTER_DRAIN = false, MIDK = false;
    const LAS float* rs; bf16_t* vt;
    __device__ __forceinline__ void operator()(const Acc& acc, const Unit& u, int wr, int wc, int fr, int fq) const {
        asm volatile("" : "+v"(fr), "+v"(fq));
        f32x4 sv[2][2];
#pragma unroll
        for (int bj = 0; bj < 2; ++bj)
#pragma unroll
            for (int n = 0; n < 2; ++n) sv[bj][n] = *(const LAS f32x4*)(rs + bj * 128 + wc * 32 + 8 * fq + 4 * n);
#pragma unroll
        for (int ai = 0; ai < 2; ++ai)
#pragma unroll
            for (int m = 0; m < 4; ++m) { bf16_t* dst = vt + (size_t)(u.pm * 256 + wr * 64 + fr + ai * 128 + m * 16) * MTOK + u.pn * 256 + wc * 32 + 8 * fq;
#pragma unroll
                for (int bj = 0; bj < 2; ++bj) { const f32x4 a = acc[ai][bj][m][0] * sv[bj][0], b = acc[ai][bj][m][1] * sv[bj][1];
                    u32x4 w; w.x = cvt_pk_bf16(a[0], a[1]); w.y = cvt_pk_bf16(a[2], a[3]); w.z = cvt_pk_bf16(b[0], b[1]); w.w = cvt_pk_bf16(b[2], b[3]);
                    *(u32x4*)(dst + bj * 128) = w; } }
    }
};
constexpr int SLD = 132;
struct EpiSloc {
    static constexpr bool PERM = false, AFTER_DRAIN = true, MIDK = false;
    __device__ __forceinline__ void fused(const Acc& acc, const Unit&, int wr, int wc, int fr, int fq, LAS unsigned char* lds) const {
        asm volatile("" : "+v"(fr), "+v"(fq));
        LAS float* S = (LAS float*)lds;
#pragma unroll
        for (int ai = 0; ai < 2; ++ai)
#pragma unroll
            for (int m = 0; m < 4; ++m)
#pragma unroll
                for (int n = 0; n < 2; ++n) *(LAS f32x4*)(S + (ai * 128 + wr * 64 + m * 16 + fr) * SLD + wc * 32 + n * 16 + 4 * fq) = acc[ai][0][m][n];
    }
};
struct EpiSsmOut {
    static constexpr bool PERM = true, AFTER_DRAIN = false, MIDK = false;
    const bf16_t* a2g; const float* dsk; bf16_t* yg; int g;
    __device__ __forceinline__ void operator()(const Acc& acc, const Unit& u, int wr, int wc, int fr, int fq) const {
        asm volatile("" : "+v"(fr), "+v"(fq));
        const int h0 = 8 * (fq & 1), row0 = u.pm * 256 + wr * 64 + fr, colb = wc * 32 + 8 * fq;
        const f32x4 d0 = *(const f32x4*)(dsk + h0), d1 = *(const f32x4*)(dsk + h0 + 4);
        u32x4 cur[2], nxt[2];
        cur[0] = *(const u32x4*)(a2g + (size_t)row0 * A2LD + colb); cur[1] = *(const u32x4*)(a2g + (size_t)row0 * A2LD + colb + 128);
#pragma unroll
        for (int idx = 0; idx < 8; ++idx) { const int ai = idx >> 2, m = idx & 3, row = row0 + ai * 128 + m * 16;
            if (idx < 7) { const size_t ro = (size_t)(row0 + ((idx + 1) >> 2) * 128 + ((idx + 1) & 3) * 16) * A2LD + colb; nxt[0] = *(const u32x4*)(a2g + ro); nxt[1] = *(const u32x4*)(a2g + ro + 128); }
#pragma unroll
            for (int bj = 0; bj < 2; ++bj) { const int col = bj * 128 + colb, tl = col >> 4;
                const u32x4 uu = cur[bj];
                const f32x4 a = acc[ai][bj][m][0], b = acc[ai][bj][m][1];
                float y[8];
                y[0] = a[0] + d0[0] * bf2f(uu.x & 0xffffu); y[1] = a[1] + d0[1] * bf2f(uu.x >> 16); y[2] = a[2] + d0[2] * bf2f(uu.y & 0xffffu); y[3] = a[3] + d0[3] * bf2f(uu.y >> 16);
                y[4] = b[0] + d1[0] * bf2f(uu.z & 0xffffu); y[5] = b[1] + d1[1] * bf2f(uu.z >> 16); y[6] = b[2] + d1[2] * bf2f(uu.w & 0xffffu); y[7] = b[3] + d1[3] * bf2f(uu.w >> 16);
#pragma unroll
                for (int j = 0; j < 8; ++j) y[j] = gelu_tanh_f(y[j]);
                u32x4 w; w.x = cvt_pk_bf16(y[0], y[1]); w.y = cvt_pk_bf16(y[2], y[3]); w.z = cvt_pk_bf16(y[4], y[5]); w.w = cvt_pk_bf16(y[6], y[7]);
                *(u32x4*)(yg + (size_t)(row * 16 + tl) * DS + g * 16 + h0) = w; }
            cur[0] = nxt[0]; cur[1] = nxt[1];
            asm volatile("" ::: "memory"); }
    }
};
struct EpiGlu {
    static constexpr bool PERM = true, AFTER_DRAIN = false, MIDK = false;
    const bf16_t* yg; const bf16_t* gs; const float* bias; bf16_t* ycat; float* ssq2;
    __device__ __forceinline__ void preload(u32x4 (&p)[4], size_t rowoff) const {
#pragma unroll
        for (int bj = 0; bj < 2; ++bj) { p[2 * bj] = *(const u32x4*)(yg + rowoff + bj * 128); p[2 * bj + 1] = *(const u32x4*)(gs + rowoff + bj * 128); }
    }
    __device__ __forceinline__ void operator()(const Acc& acc, const Unit& u, int wr, int wc, int fr, int fq) const {
        asm volatile("" : "+v"(fr), "+v"(fq));
        const int col0 = u.pn * 256 + wc * 32 + 8 * fq, r0 = u.pm * 256 + wr * 64 + fr;
        f32x4 bv[2][2];
#pragma unroll
        for (int bj = 0; bj < 2; ++bj)
#pragma unroll
            for (int n = 0; n < 2; ++n) bv[bj][n] = *(const f32x4*)(bias + col0 + bj * 128 + 4 * n);
        u32x4 cur[4], nxt[4]; preload(cur, (size_t)r0 * DS + col0);
#pragma unroll
        for (int idx = 0; idx < 8; ++idx) { const int ai = idx >> 2, m = idx & 3, r = r0 + ai * 128 + m * 16; float ss = 0.f;
            if (idx < 7) preload(nxt, (size_t)(r0 + ((idx + 1) >> 2) * 128 + ((idx + 1) & 3) * 16) * DS + col0);
#pragma unroll
            for (int bj = 0; bj < 2; ++bj) { const u32x4 yy = cur[2 * bj], gg = cur[2 * bj + 1];
                const f32x4 a = acc[ai][bj][m][0] + bv[bj][0], b = acc[ai][bj][m][1] + bv[bj][1];
                float z[8];
                z[0] = bf2f(yy.x & 0xffffu) * sigmoid_f(a[0]); z[1] = bf2f(yy.x >> 16) * sigmoid_f(a[1]); z[2] = bf2f(yy.y & 0xffffu) * sigmoid_f(a[2]); z[3] = bf2f(yy.y >> 16) * sigmoid_f(a[3]);
                z[4] = bf2f(yy.z & 0xffffu) * sigmoid_f(b[0]); z[5] = bf2f(yy.z >> 16) * sigmoid_f(b[1]); z[6] = bf2f(yy.w & 0xffffu) * sigmoid_f(b[2]); z[7] = bf2f(yy.w >> 16) * sigmoid_f(b[3]);
#pragma unroll
                for (int j = 0; j < 8; ++j) ss += z[j] * z[j];
                z[0] *= bf2f(gg.x & 0xffffu); z[1] *= bf2f(gg.x >> 16); z[2] *= bf2f(gg.y & 0xffffu); z[3] *= bf2f(gg.y >> 16);
                z[4] *= bf2f(gg.z & 0xffffu); z[5] *= bf2f(gg.z >> 16); z[6] *= bf2f(gg.w & 0xffffu); z[7] *= bf2f(gg.w >> 16);
                u32x4 w; w.x = cvt_pk_bf16(z[0], z[1]); w.y = cvt_pk_bf16(z[2], z[3]); w.z = cvt_pk_bf16(z[4], z[5]); w.w = cvt_pk_bf16(z[6], z[7]);
                *(u32x4*)(ycat + (size_t)r * DM + col0 + bj * 128) = w; }
            ss = xor_add<16>(ss); ss = xor_add<32>(ss);
            if (fq == 0) ssq2[(size_t)r * 32 + u.pn * 4 + wc] = ss;
#pragma unroll
            for (int k = 0; k < 4; ++k) cur[k] = nxt[k];
            asm volatile("" ::: "memory"); }
    }
};
template <bool RESBF> struct EpiOut {
    static constexpr bool PERM = true, AFTER_DRAIN = false, MIDK = true;
    const LAS float* rs2; const void* res; bf16_t* xo; float* ssq;
    __device__ __forceinline__ void midk(Acc& acc, int wr, int fr) const {
        asm volatile("" : "+v"(fr));
#pragma unroll
        for (int ai = 0; ai < 2; ++ai)
#pragma unroll
            for (int m = 0; m < 4; ++m) { const float s = rs2[ai * 128 + wr * 64 + m * 16 + fr];
#pragma unroll
                for (int bj = 0; bj < 2; ++bj)
#pragma unroll
                    for (int n = 0; n < 2; ++n) acc[ai][bj][m][n] *= s; }
    }
    typedef f32x4 Pre[RESBF ? 2 : 4];
    __device__ __forceinline__ void preload(Pre& p, size_t rowoff) const {
#pragma unroll
        for (int bj = 0; bj < 2; ++bj) {
            if constexpr (RESBF) p[bj] = __builtin_bit_cast(f32x4, *(const u32x4*)((const bf16_t*)res + rowoff + bj * 128));
            else { p[2 * bj] = *(const f32x4*)((const float*)res + rowoff + bj * 128); p[2 * bj + 1] = *(const f32x4*)((const float*)res + rowoff + bj * 128 + 4); } }
    }
    __device__ __forceinline__ void operator()(const Acc& acc, const Unit& u, int wr, int wc, int fr, int fq) const {
        asm volatile("" : "+v"(fr), "+v"(fq));
        const int col0 = u.pn * 256 + wc * 32 + 8 * fq; const int r0 = u.pm * 256 + wr * 64 + fr;
        Pre cur, nxt; preload(cur, (size_t)r0 * DM + col0);
#pragma unroll
        for (int idx = 0; idx < 8; ++idx) { const int ai = idx >> 2, m = idx & 3, r = r0 + ai * 128 + m * 16; float ss = 0.f;
            if (idx < 7) preload(nxt, (size_t)(r0 + ((idx + 1) >> 2) * 128 + ((idx + 1) & 3) * 16) * DM + col0);
#pragma unroll
            for (int bj = 0; bj < 2; ++bj) { const size_t off = (size_t)r * DM + col0 + bj * 128; f32x4 x0, x1;
                if constexpr (RESBF) { const u32x4 rv = __builtin_bit_cast(u32x4, cur[bj]);
                    x0 = (f32x4){bf2f(rv.x & 0xffffu), bf2f(rv.x >> 16), bf2f(rv.y & 0xffffu), bf2f(rv.y >> 16)}; x1 = (f32x4){bf2f(rv.z & 0xffffu), bf2f(rv.z >> 16), bf2f(rv.w & 0xffffu), bf2f(rv.w >> 16)};
                } else { x0 = cur[2 * bj]; x1 = cur[2 * bj + 1]; }
                x0 = x0 + acc[ai][bj][m][0]; x1 = x1 + acc[ai][bj][m][1];
                ss += ((x0[0] * x0[0] + x0[1] * x0[1]) + (x0[2] * x0[2] + x0[3] * x0[3])) + ((x1[0] * x1[0] + x1[1] * x1[1]) + (x1[2] * x1[2] + x1[3] * x1[3]));
                u32x4 w; w.x = cvt_pk_bf16(x0[0], x0[1]); w.y = cvt_pk_bf16(x0[2], x0[3]); w.z = cvt_pk_bf16(x1[0], x1[1]); w.w = cvt_pk_bf16(x1[2], x1[3]);
                *(u32x4*)(xo + off) = w; }
            ss = xor_add<16>(ss); ss = xor_add<32>(ss);
            if (fq == 0) ssq[(size_t)r * 64 + u.pn * 4 + wc] = ss;
#pragma unroll
            for (int k = 0; k < (RESBF ? 2 : 4); ++k) cur[k] = nxt[k];
            asm volatile("" ::: "memory"); }
    }
};

struct Args { const float* in[17]; float* out; unsigned char* ws; int ph_lo, ph_hi; };
enum { I_X = 0, I_NORMW, I_WIN, I_LRE, I_LIM, I_BRE, I_BIM, I_CRE, I_CIM, I_D, I_LOGDT, I_WGLU, I_BGLU, I_SNW, I_RNW, I_WOUT, I_FNW };

typedef const __attribute__((address_space(4))) Args* ArgsP;
struct Frame {
    LAS unsigned char* lds; int wave, vcu, G, bid; unsigned char* ws;
};

__device__ __forceinline__ int fresh_tid(const Frame& F) { unsigned m_ = ~0u; asm volatile("" : "+s"(m_)); return F.wave * 64 + (int)__builtin_amdgcn_mbcnt_hi(m_, __builtin_amdgcn_mbcnt_lo(m_, 0u)); }
__device__ __forceinline__ void transpose_item(const float* W, int K, int N, bf16_t* WT, const float* ks0, const float* ks1, int ksplit, int remap, int item, int lane) {
    const int nblk = N / 64, kb = item / nblk, nb = item % nblk, k0 = 64 * kb, nq = lane & 15, kq = lane >> 4; int n0 = 64 * nb;
    const float* wp = W + (size_t)(k0 + 16 * kq) * N + n0 + 4 * nq;
    f32x4 v[16];
#pragma unroll
    for (int i = 0; i < 16; ++i) v[i] = *(const f32x4*)(wp + (size_t)i * N);
    if (ks0) { const float* ks = ((k0 < ksplit) ? ks0 + k0 : ks1 + (k0 - ksplit)) + 16 * kq;
#pragma unroll
        for (int i = 0; i < 4; ++i) { const f32x4 sc = *(const f32x4*)(ks + 4 * i);
#pragma unroll
            for (int j = 0; j < 4; ++j) v[4 * i + j] = v[4 * i + j] * sc[j]; } }
    if (remap) { if (n0 >= 10240) n0 -= 2048; else if (n0 >= 8192) n0 += 2048; }
#pragma unroll
    for (int c = 0; c < 4; ++c) { bf16_t* dst = WT + (size_t)(n0 + 4 * nq + c) * K + k0 + 16 * kq;
        u32x4 o0, o1;
        o0.x = pk2(v[0][c], v[1][c]); o0.y = pk2(v[2][c], v[3][c]); o0.z = pk2(v[4][c], v[5][c]); o0.w = pk2(v[6][c], v[7][c]);
        o1.x = pk2(v[8][c], v[9][c]); o1.y = pk2(v[10][c], v[11][c]); o1.z = pk2(v[12][c], v[13][c]); o1.w = pk2(v[14][c], v[15][c]);
        *(u32x4*)dst = o0; *(u32x4*)(dst + 8) = o1; }
}

__device__ __forceinline__ void ssm_mats_item(const Frame& F, ArgsP a, int l, int g) {
    const int lg = l * NG + g, tid = fresh_tid(F);
    LAS float* apr = (LAS float*)F.lds;
    LAS float* api = apr + 17 * 64;
    LAS float* bbr = api + 17 * 64;
    LAS float* bbi = bbr + 1024;
    LAS float* crs = bbi + 1024;
    LAS float* cis = crs + 1024;
    LAS float* crt = cis + 1024;
    LAS float* cit = crt + 1024;
    LAS float* Kt = cit + 1024;
    LAS float* lrs = Kt + 4096;
    LAS float* lis = lrs + 64;
    { const float b0r = a->in[I_BRE][(size_t)lg * 1024 + tid], b1r = a->in[I_BRE][(size_t)lg * 1024 + 512 + tid], b0i = a->in[I_BIM][(size_t)lg * 1024 + tid], b1i = a->in[I_BIM][(size_t)lg * 1024 + 512 + tid];
      const float c0r = a->in[I_CRE][(size_t)lg * 1024 + tid], c1r = a->in[I_CRE][(size_t)lg * 1024 + 512 + tid], c0i = a->in[I_CIM][(size_t)lg * 1024 + tid], c1i = a->in[I_CIM][(size_t)lg * 1024 + 512 + tid];
      const float lx = (tid < 64) ? a->in[I_LRE][lg * 64 + tid] : ((tid < 128) ? a->in[I_LIM][lg * 64 + tid - 64] : 0.f);
      bbr[tid] = b0r; bbr[512 + tid] = b1r; bbi[tid] = b0i; bbi[512 + tid] = b1i;
      crs[tid] = c0r; crs[512 + tid] = c1r; cis[tid] = c0i; cis[512 + tid] = c1i;
      { const int hp0 = tid >> 6, n0 = tid & 63; crt[n0 * 16 + hp0] = c0r; crt[n0 * 16 + hp0 + 8] = c1r; cit[n0 * 16 + hp0] = c0i; cit[n0 * 16 + hp0 + 8] = c1i; }
      if (tid < 128) lrs[tid] = lx; }
    const float dtf = expf(a->in[I_LOGDT][lg]);
    __syncthreads();
    for (int e = tid; e < 17 * 64; e += 512) { const int tau = e >> 6, n = e & 63; const float lr = lrs[n], li = lis[n];
        float c, s; cis_d((double)li * (double)dtf * tau, c, s); const float mag = expf(lr * dtf * (float)tau); apr[e] = mag * c; api[e] = mag * s; }
    __syncthreads();
#pragma unroll
    for (int k = 0; k < 2; ++k) { const int e = tid + 512 * k, n = e >> 4; const float lr = lrs[n], li = lis[n];
        const float nr = apr[64 + n] - 1.f, ni = api[64 + n], den = lr * lr + li * li, cor = (nr * lr + ni * li) / den, coi = (ni * lr - nr * li) / den;
        const float br = bbr[e], bi = bbi[e];
        bbr[e] = cor * br - coi * bi; bbi[e] = cor * bi + coi * br; }
    if (tid < 64) ((float2*)(F.ws + WS_A16))[lg * 64 + tid] = make_float2(apr[16 * 64 + tid], api[16 * 64 + tid]);
    __syncthreads();
    { const int tau = tid >> 5, hp = (tid >> 1) & 15, h0 = (tid & 1) * 8; float sum[8];
#pragma unroll
      for (int j = 0; j < 8; ++j) sum[j] = 0.f;
#pragma unroll 4
      for (int n = 0; n < 64; ++n) { const float cr = crt[n * 16 + hp], ci = cit[n * 16 + hp], ar = apr[tau * 64 + n], ai = api[tau * 64 + n], pr = cr * ar - ci * ai, pi = cr * ai + ci * ar;
          const f32x4 b0 = *(const LAS f32x4*)(bbr + n * 16 + h0), b1 = *(const LAS f32x4*)(bbr + n * 16 + h0 + 4), d0 = *(const LAS f32x4*)(bbi + n * 16 + h0), d1 = *(const LAS f32x4*)(bbi + n * 16 + h0 + 4);
#pragma unroll
          for (int j = 0; j < 4; ++j) { sum[j] += pr * b0[j] - pi * d0[j]; sum[4 + j] += pr * b1[j] - pi * d1[j]; } }
#pragma unroll
      for (int j = 0; j < 8; ++j) Kt[(tau << 8) + (hp << 4) + h0 + j] = sum[j]; }
    __syncthreads();
    bf16_t* bt2 = (bf16_t*)(F.ws + WS_BT2) + (size_t)lg * 256 * A2LD;
#pragma unroll 2
    for (int e = tid; e < 256 * A2LD / 8; e += 512) { const int row = e / 48, c0 = (e % 48) * 8, t = row >> 4, hp = row & 15; float v[8];
        if (c0 < 256) { const int j = c0 >> 4, h0 = c0 & 15;
#pragma unroll
            for (int i = 0; i < 8; ++i) v[i] = (t >= j) ? Kt[((t - j) << 8) + (hp << 4) + h0 + i] : 0.f;
        } else { const int nn = c0 - 256;
#pragma unroll
            for (int i = 0; i < 8; ++i) { const int n = (nn + i) & 63; const float cr = crs[hp * 64 + n], ci = cis[hp * 64 + n], ar = apr[(t + 1) * 64 + n], ai = api[(t + 1) * 64 + n];
                v[i] = (nn < 64) ? (cr * ar - ci * ai) : -(cr * ai + ci * ar); } }
        u32x4 w; w.x = pk2(v[0], v[1]); w.y = pk2(v[2], v[3]); w.z = pk2(v[4], v[5]); w.w = pk2(v[6], v[7]);
        *(u32x4*)(bt2 + (size_t)row * A2LD + c0) = w; }
    bf16_t* pm = (bf16_t*)(F.ws + WS_PM) + (size_t)lg * 256 * 256;
#pragma unroll 2
    for (int e = tid; e < 256 * 256 / 8; e += 512) { const int row = e >> 5, c0 = (e & 31) * 8; float v[8];
        if (row < 128) { const int n = row & 63, im = row >> 6, j = c0 >> 4, h0 = c0 & 15; const float ar = apr[(15 - j) * 64 + n], ai = api[(15 - j) * 64 + n];
#pragma unroll
            for (int i = 0; i < 8; ++i) { const float br = bbr[n * 16 + h0 + i], bi = bbi[n * 16 + h0 + i]; v[i] = im ? (ar * bi + ai * br) : (ar * br - ai * bi); }
        } else {
#pragma unroll
            for (int i = 0; i < 8; ++i) v[i] = 0.f; }
        u32x4 w; w.x = pk2(v[0], v[1]); w.y = pk2(v[2], v[3]); w.z = pk2(v[4], v[5]); w.w = pk2(v[6], v[7]);
        *(u32x4*)(pm + (size_t)row * 256 + c0) = w; }
    __syncthreads();
}

__device__ __forceinline__ void p0_prologue(const Frame& F, ArgsP a, int parts = 7) {
    const int tid0 = fresh_tid(F), lane0 = tid0 & 63;
    if (parts & 1) for (int it = F.vcu; it < DEPTH * NG; it += F.G) ssm_mats_item(F, a, it / NG, it % NG);
    if (parts & 2) { float2* rope = (float2*)(F.ws + WS_ROPE);
      for (int e = F.vcu * 512 + tid0; e < SEQ * 128; e += F.G * 512) { const int pos = e >> 7, i = e & 127;
          const double inv = (double)expf(-(float)(2 * i) * (9.210340371976184f / 256.0f)); float c, s; cis_d((double)pos * inv, c, s); rope[e] = make_float2(c, s); } }
    const int gw = F.vcu * 8 + F.wave, NGW = F.G * 8;
    if (parts & 2) for (int m = gw; m < MTOK; m += NGW) {
        const f32x4* xr = (const f32x4*)(a->in[I_X] + (size_t)m * DM) + lane0; float ss = 0.f; f32x4 v[16];
#pragma unroll
        for (int j = 0; j < 16; ++j) { v[j] = xr[64 * j]; ss += (v[j][0] * v[j][0] + v[j][1] * v[j][1]) + (v[j][2] * v[j][2] + v[j][3] * v[j][3]); }
        ss = wave_sum(ss);
        u32x2* o = (u32x2*)((bf16_t*)(F.ws + WS_XB) + (size_t)m * DM) + lane0;
#pragma unroll
        for (int j = 0; j < 16; ++j) { u32x2 w; w.x = pk2(v[j][0], v[j][1]); w.y = pk2(v[j][2], v[j][3]); o[64 * j] = w; }
        ((float*)(F.ws + WS_SSQX))[(size_t)m * 64 + lane0] = (lane0 == 0) ? ss : 0.f;
    }
    constexpr int I_IN = (DM / 64) * (NPROJ / 64), I_GLU = (DS / 64) * (DS / 64), I_OUT = (DM / 64) * (DM / 64), I_L = I_IN + I_GLU + I_OUT;
    if (parts & 4) for (int it = gw; it < DEPTH * I_L; it += NGW) {
        const int l = it / I_L; int r = it % I_L;
        if (r < I_IN) { transpose_item(a->in[I_WIN] + (size_t)l * DM * NPROJ, DM, NPROJ, (bf16_t*)(F.ws + WS_WTIN) + (size_t)l * NPROJ * DM, a->in[I_NORMW] + l * DM, a->in[I_NORMW] + l * DM, 1 << 30, 1, r, lane0); continue; } r -= I_IN;
        if (r < I_GLU) { transpose_item(a->in[I_WGLU] + (size_t)l * DS * DS, DS, DS, (bf16_t*)(F.ws + WS_WTGLU) + (size_t)l * DS * DS, nullptr, nullptr, 1 << 30, 0, r, lane0); continue; } r -= I_GLU;
        transpose_item(a->in[I_WOUT] + (size_t)l * DM * DM, DM, DM, (bf16_t*)(F.ws + WS_WTOUT) + (size_t)l * DM * DM, a->in[I_SNW] + l * DS, a->in[I_RNW] + l * DR, DS, 0, r, lane0);
    }
}

__device__ __forceinline__ void stash_rstd(const Frame& F, const float* slots, int nslot, int panel, float inv_dim) {
    const int tid = fresh_tid(F);
    __syncthreads();
    if (tid < 256) { const f32x4* p = (const f32x4*)(slots + (size_t)(panel * 256 + tid) * nslot); float s = 0.f;
        for (int j = 0; j < nslot / 4; ++j) { const f32x4 t = p[j]; s += (t[0] + t[1]) + (t[2] + t[3]); }
        ((LAS float*)(F.lds + STASH_OFF))[tid] = __builtin_amdgcn_rsqf(s * inv_dim + EPS); }
    __syncthreads();
}

__device__ __forceinline__ void p1_inproj(const Frame& F, int l) {
    const bf16_t* xb = (const bf16_t*)(F.ws + WS_XB); const bf16_t* wt = (const bf16_t*)(F.ws + WS_WTIN) + (size_t)l * NPROJ * DM;
    const LAS float* rs = (const LAS float*)(F.lds + STASH_OFF);
    { pg8::StaticOrder S; S.init(MTOK, 10240, F.G, F.bid); Unit u0; S.next(0, u0);
      stash_rstd(F, (const float*)(F.ws + WS_SSQX), 64, u0.pm, 1.f / DM);
      pg8::Gemm g{xb, wt, DM, DM, DM, -1};
      EpiInProj E{rs, (bf16_t*)(F.ws + WS_A2U), (bf16_t*)(F.ws + WS_GS), (bf16_t*)(F.ws + WS_Q), (bf16_t*)(F.ws + WS_K), (bf16_t*)(F.ws + WS_GR), (const float*)(F.ws + WS_ROPE)};
      pg8::gemm_phase<EpiInProj, pg8::StaticOrder, true, true>(F.lds, g, S, E, fresh_tid(F)); }
    { pg8::StaticOrder S; S.init(DR, MTOK, F.G, F.bid); Unit u0; S.next(0, u0);
      stash_rstd(F, (const float*)(F.ws + WS_SSQX), 64, u0.pn, 1.f / DM);
      pg8::Gemm g{wt + (size_t)10240 * DM, xb, DM, DM, DM, -1};
      EpiVT E{rs, (bf16_t*)(F.ws + WS_VT)};
      pg8::gemm_phase<EpiVT, pg8::StaticOrder, true, true>(F.lds, g, S, E, fresh_tid(F)); }
}

__device__ __forceinline__ void p2_ssm(const Frame& F, ArgsP a, int l) {
    for (int it = F.vcu; it < NG * 2; it += F.G) {
        const int g = it >> 1, bp = it & 1, lg = l * NG + g;
        bf16_t* a2g = (bf16_t*)(F.ws + WS_A2U) + (size_t)g * 512 * A2LD;
        { pg8::Gemm g1{a2g, (const bf16_t*)(F.ws + WS_PM) + (size_t)lg * 256 * 256, 256, A2LD, 256, -1}; pg8::OneUnit S{bp, 0}; EpiSloc E{};
          pg8::gemm_phase<EpiSloc, pg8::OneUnit, false, true>(F.lds, g1, S, E, fresh_tid(F)); }
        LDS_WAIT(); __syncthreads();
        int t2 = fresh_tid(F); asm volatile("" : "+v"(t2));
        if (t2 < 128) {
            const int bb = t2 >> 6, n = t2 & 63; const float2 a16 = ((const float2*)(F.ws + WS_A16))[lg * 64 + n];
            const LAS float* S = (const LAS float*)F.lds + (bb * 128) * SLD; bf16_t* dst = a2g + (size_t)(bp * 256 + bb * 128) * A2LD + 256 + n;
            float sr = 0.f, si = 0.f;
#pragma unroll 8
            for (int c = 0; c < 128; ++c) { dst[(size_t)c * A2LD] = (bf16_t)f2bf(sr); dst[(size_t)c * A2LD + 64] = (bf16_t)f2bf(si);
                const float lr = S[c * SLD + n], li = S[c * SLD + 64 + n]; const float nr = a16.x * sr - a16.y * si + lr, ni = a16.x * si + a16.y * sr + li; sr = nr; si = ni; }
        }
        VM_WAIT(); __syncthreads();
        if (t2 == 0) { __builtin_amdgcn_fence(__ATOMIC_ACQUIRE, "agent"); VM_WAIT(); }
        __syncthreads();
        { pg8::Gemm g2{a2g, (const bf16_t*)(F.ws + WS_BT2) + (size_t)lg * 256 * A2LD, A2LD, A2LD, A2LD, -1}; pg8::OneUnit S{bp, 0};
          EpiSsmOut E{a2g, a->in[I_D] + (size_t)l * DS + g * 16, (bf16_t*)(F.ws + WS_YG), g};
          pg8::gemm_phase<EpiSsmOut, pg8::OneUnit, false, true>(F.lds, g2, S, E, fresh_tid(F)); }
        __syncthreads();
    }
}


typedef float f32x16 __attribute__((ext_vector_type(16)));
constexpr int RT_K0 = 0, RT_V0 = 65536, RT_P = 131072, RT_RED = 147456, RT_OLD = 528;
#define RT_BAR() do { asm volatile("s_waitcnt lgkmcnt(0)" ::: "memory"); __builtin_amdgcn_s_barrier(); asm volatile("" ::: "memory"); } while (0)
__device__ __forceinline__ void p2_ret(const Frame& F) {
    int t_ = fresh_tid(F); asm volatile("" : "+v"(t_));
    const int tid = t_, lane = tid & 63, w = F.wave, wr = w & 3, wc = w >> 2, l31 = lane & 31, hh = lane >> 5;
    LAS unsigned char* lds = F.lds;
    const bf16_t* qg = (const bf16_t*)(F.ws + WS_Q); const bf16_t* kg = (const bf16_t*)(F.ws + WS_K); const bf16_t* vtg = (const bf16_t*)(F.ws + WS_VT);
    const bf16_t* grg = (const bf16_t*)(F.ws + WS_GR); bf16_t* ycat = (bf16_t*)(F.ws + WS_YCAT);
    const unsigned koff = (unsigned)((2 * w + hh) * 4096 + ((l31 ^ ((2 * w + hh) & 15)) << 4));
    const unsigned voff = (unsigned)((8 * w + (lane >> 3)) * 16384 + (((lane & 7) ^ (((lane >> 4) + 4 * w) & 7)) << 4));
    for (int it = F.vcu; it < BATCH * RH * 8; it += F.G) {
        const int bh = it >> 3, p = it & 7, b = bh >> 3, h = bh & 7;
        const float e = __builtin_amdgcn_exp2f((float)(-5 - h));
        const float lg2 = -(e * (1.f + e * (0.5f + e * (0.33333334f + e * (0.25f + e * (0.2f + e * 0.16666667f)))))) * 1.4426950408889634f;
        for (int uu = 0; uu < 2; ++uu) {
            const int qi = uu ? p : 15 - p, ntile = 2 * (qi + 1);
            const size_t tokq = (size_t)b * SEQ + qi * 128;
            bf16x8 qf[16];
            { const bf16_t* qp = qg + (tokq + wr * 32 + l31) * DR + h * 256 + 8 * hh;
#pragma unroll
              for (int s = 0; s < 16; ++s) qf[s] = *(const bf16x8*)(qp + 16 * s); }
            f32x16 oacc[4];
#pragma unroll
            for (int db = 0; db < 4; ++db)
#pragma unroll
                for (int r = 0; r < 16; ++r) oacc[db][r] = 0.f;
#define RT_DMA_K(kt_, bf_, i_) __builtin_amdgcn_global_load_lds((const unsigned*)((const char*)(kg + ((size_t)(b * SEQ + (kt_) * 64) * DR + h * 256)) + koff + (i_) * 65536), (LAS unsigned*)(lds + RT_K0 + (bf_) * 32768 + (w + 8 * (i_)) * 1024), 16, 0, 0)
#define RT_DMA_V(kt_, bf_, i_) __builtin_amdgcn_global_load_lds((const unsigned*)((const char*)(vtg + ((size_t)(h * 256) * MTOK + b * SEQ + (kt_) * 64)) + voff + (i_) * 1048576), (LAS unsigned*)(lds + RT_V0 + (bf_) * 32768 + (w + 8 * (i_)) * 1024), 16, 0, 0)
            RT_DMA_K(0, 0, 0); RT_DMA_K(0, 0, 1); RT_DMA_K(0, 0, 2); RT_DMA_K(0, 0, 3); RT_DMA_V(0, 0, 0); RT_DMA_V(0, 0, 1); RT_DMA_V(0, 0, 2); RT_DMA_V(0, 0, 3);
            asm volatile("s_waitcnt vmcnt(0)" ::: "memory"); RT_BAR();
            for (int kt = 0; kt < ntile; ++kt) {
                const int bf = kt & 1; const bool pre = kt + 1 < ntile;
                int lo_ = lane; asm volatile("" : "+v"(lo_));
                const int l31 = lo_ & 31, hh = lo_ >> 5, m4 = ((l31 >> 1) & 7) << 4, lane = lo_;
                const int kap = (l31 & 0x13) | ((l31 & 4) << 1) | ((l31 & 8) >> 1), x15 = kap & 15;
                f32x16 st;
#pragma unroll
                for (int r = 0; r < 16; ++r) st[r] = 0.f;
                { const LAS unsigned char* kb = lds + RT_K0 + bf * 32768 + (32 * wc + kap) * 512;
#define RT_KRD(dst, s0) do { _Pragma("unroll") for (int j_ = 0; j_ < 4; ++j_) dst[j_] = *(const LAS bf16x8*)(kb + ((((2 * ((s0) + j_)) | hh) ^ x15) << 4)); } while (0)
#define RT_KMM(src, s0) do { _Pragma("unroll") for (int j_ = 0; j_ < 4; ++j_) st = __builtin_amdgcn_mfma_f32_32x32x16_bf16(src[j_], qf[(s0) + j_], st, 0, 0, 0); } while (0)
                  bf16x8 ka[4], kc[4];
                  RT_KRD(ka, 0); __builtin_amdgcn_sched_barrier(0);
                  RT_KRD(kc, 4); RT_KMM(ka, 0); if (pre) RT_DMA_K(kt + 1, bf ^ 1, 0); __builtin_amdgcn_sched_barrier(0);
                  RT_KRD(ka, 8); RT_KMM(kc, 4); if (pre) RT_DMA_K(kt + 1, bf ^ 1, 1); __builtin_amdgcn_sched_barrier(0);
                  RT_KRD(kc, 12); RT_KMM(ka, 8); if (pre) RT_DMA_K(kt + 1, bf ^ 1, 2); __builtin_amdgcn_sched_barrier(0);
                  RT_KMM(kc, 12); if (pre) RT_DMA_K(kt + 1, bf ^ 1, 3); __builtin_amdgcn_sched_barrier(0);
#undef RT_KRD
#undef RT_KMM
                }
                { const bool diag = kt >= 2 * qi;
                  unsigned pk[8];
                  if (!diag) { const float tf = __builtin_amdgcn_exp2f((float)(128 * (qi - (kt >> 1))) * lg2);
#pragma unroll
                      for (int i = 0; i < 8; ++i) pk[i] = cvt_pk_bf16(st[2 * i] * tf, st[2 * i + 1] * tf);
                  } else { const int lim = wr * 32 + l31 + (2 * qi - kt) * 64 - 32 * wc - 8 * hh;
#pragma unroll
                      for (int i = 0; i < 8; ++i) { const int r0 = 2 * i, r1 = 2 * i + 1, o0 = 16 * (r0 >> 3) + (r0 & 7), o1 = 16 * (r1 >> 3) + (r1 & 7);
                          pk[i] = cvt_pk_bf16((o0 <= lim) ? st[r0] : 0.f, (o1 <= lim) ? st[r1] : 0.f); } }
                  LAS unsigned char* pw = lds + RT_P + ((wr * 2 + wc) * 2) * 1024 + lane * 16;
                  *(LAS u32x4*)pw = (u32x4){pk[0], pk[1], pk[2], pk[3]}; *(LAS u32x4*)(pw + 1024) = (u32x4){pk[4], pk[5], pk[6], pk[7]}; }
                RT_BAR();
                { bf16x8 pf[2][2];
#pragma unroll
                  for (int kb2 = 0; kb2 < 2; ++kb2)
#pragma unroll
                      for (int s = 0; s < 2; ++s) pf[kb2][s] = *(const LAS bf16x8*)(lds + RT_P + ((wr * 2 + kb2) * 2 + s) * 1024 + lane * 16);
                  const LAS unsigned char* vb = lds + RT_V0 + bf * 32768 + (128 * wc + l31) * 128;
#define RT_VRD(dst, db) do { _Pragma("unroll") for (int j_ = 0; j_ < 4; ++j_) dst[j_] = *(const LAS bf16x8*)(vb + (db) * 4096 + (((4 * (j_ >> 1) + 2 * (j_ & 1) + hh) << 4) ^ m4)); } while (0)
#define RT_VMM(src, db) do { _Pragma("unroll") for (int j_ = 0; j_ < 4; ++j_) oacc[db] = __builtin_amdgcn_mfma_f32_32x32x16_bf16(pf[j_ >> 1][j_ & 1], src[j_], oacc[db], 0, 0, 0); } while (0)
                  bf16x8 va[4], vc[4];
                  RT_VRD(va, 0); __builtin_amdgcn_sched_barrier(0);
                  RT_VRD(vc, 1); RT_VMM(va, 0); if (pre) RT_DMA_V(kt + 1, bf ^ 1, 0); __builtin_amdgcn_sched_barrier(0);
                  RT_VRD(va, 2); RT_VMM(vc, 1); if (pre) RT_DMA_V(kt + 1, bf ^ 1, 1); __builtin_amdgcn_sched_barrier(0);
                  RT_VRD(vc, 3); RT_VMM(va, 2); if (pre) RT_DMA_V(kt + 1, bf ^ 1, 2); __builtin_amdgcn_sched_barrier(0);
                  RT_VMM(vc, 3); if (pre) RT_DMA_V(kt + 1, bf ^ 1, 3); __builtin_amdgcn_sched_barrier(0);
#undef RT_VRD
#undef RT_VMM
                }
                asm volatile("s_waitcnt vmcnt(0)" ::: "memory"); RT_BAR();
            }
            int le_ = tid; asm volatile("" : "+v"(le_));
            const int tide = le_, l31e = le_ & 31, hhe = (le_ >> 5) & 1;
            float ssr[16];
#pragma unroll
            for (int r = 0; r < 16; ++r) { float s2 = 0.f;
#pragma unroll
                for (int db = 0; db < 4; ++db) { const float o = oacc[db][r]; s2 += o * o; }
                s2 = xor_add<1>(s2); s2 = xor_add<2>(s2); s2 = xor_add<4>(s2); s2 = xor_add<8>(s2); s2 = xor_add<16>(s2); ssr[r] = s2; }
            if (l31e == 0) {
#pragma unroll
                for (int i = 0; i < 4; ++i) *(LAS f32x4*)(lds + RT_RED + w * 128 + hhe * 64 + i * 16) = (f32x4){ssr[4 * i], ssr[4 * i + 1], ssr[4 * i + 2], ssr[4 * i + 3]}; }
            RT_BAR();
#pragma unroll
            for (int i = 0; i < 4; ++i) { const f32x4 t = *(const LAS f32x4*)(lds + RT_RED + (w ^ 4) * 128 + hhe * 64 + i * 16);
#pragma unroll
                for (int j = 0; j < 4; ++j) ssr[4 * i + j] = __builtin_amdgcn_rsqf((ssr[4 * i + j] + t[j]) * (1.f / 256.f) + EPS); }
#pragma unroll
            for (int r = 0; r < 16; ++r) { LAS unsigned char* ow = lds + (wr * 32 + 4 * hhe + (r & 3) + 8 * (r >> 2)) * RT_OLD + (128 * wc + l31e) * 2;
#pragma unroll
                for (int db = 0; db < 4; ++db) *(LAS unsigned short*)(ow + db * 64) = (unsigned short)f2bf(oacc[db][r] * ssr[r]); }
            RT_BAR();
#pragma unroll
            for (int i = 0; i < 8; ++i) { const int idx = i * 512 + tide, row = idx >> 5, ch = idx & 31; const size_t tok = tokq + row;
                const u32x4 o = *(const LAS u32x4*)(lds + row * RT_OLD + ch * 16), gv = *(const u32x4*)(grg + tok * DR + h * 256 + ch * 8);
                u32x4 y;
                y.x = cvt_pk_bf16(bf2f(o.x & 0xffffu) * bf2f(gv.x & 0xffffu), bf2f(o.x >> 16) * bf2f(gv.x >> 16)); y.y = cvt_pk_bf16(bf2f(o.y & 0xffffu) * bf2f(gv.y & 0xffffu), bf2f(o.y >> 16) * bf2f(gv.y >> 16));
                y.z = cvt_pk_bf16(bf2f(o.z & 0xffffu) * bf2f(gv.z & 0xffffu), bf2f(o.z >> 16) * bf2f(gv.z >> 16)); y.w = cvt_pk_bf16(bf2f(o.w & 0xffffu) * bf2f(gv.w & 0xffffu), bf2f(o.w >> 16) * bf2f(gv.w >> 16));
                *(u32x4*)(ycat + tok * DM + DS + h * 256 + ch * 8) = y; }
            asm volatile("s_waitcnt vmcnt(0)" ::: "memory"); RT_BAR();
#undef RT_DMA_K
#undef RT_DMA_V
        }
    }
}

__device__ __forceinline__ void p3_glu(const Frame& F, ArgsP a, int l) {
    pg8::StaticOrder S; S.init(MTOK, DS, F.G, F.bid);
    pg8::Gemm g{(const bf16_t*)(F.ws + WS_YG), (const bf16_t*)(F.ws + WS_WTGLU) + (size_t)l * DS * DS, DS, DS, DS, -1};
    EpiGlu E{(const bf16_t*)(F.ws + WS_YG), (const bf16_t*)(F.ws + WS_GS), a->in[I_BGLU] + (size_t)l * DS, (bf16_t*)(F.ws + WS_YCAT), (float*)(F.ws + WS_SSQ2)};
    pg8::gemm_phase<EpiGlu, pg8::StaticOrder, true, true>(F.lds, g, S, E, fresh_tid(F));
}

__device__ __forceinline__ void p4_out(const Frame& F, ArgsP a, int l) {
    pg8::StaticOrder S; S.init(MTOK, DM, F.G, F.bid); Unit u0; S.next(0, u0);
    stash_rstd(F, (const float*)(F.ws + WS_SSQ2), 32, u0.pm, 1.f / DS);
    pg8::Gemm g{(const bf16_t*)(F.ws + WS_YCAT), (const bf16_t*)(F.ws + WS_WTOUT) + (size_t)l * DM * DM, DM, DM, DM, DS / 64};
    if (l == 0) { EpiOut<false> E{(const LAS float*)(F.lds + STASH_OFF), a->in[I_X], (bf16_t*)(F.ws + WS_XB), (float*)(F.ws + WS_SSQX)};
        pg8::gemm_phase<EpiOut<false>, pg8::StaticOrder, true, true>(F.lds, g, S, E, fresh_tid(F)); }
    else { EpiOut<true> E{(const LAS float*)(F.lds + STASH_OFF), (const void*)(F.ws + WS_XB), (bf16_t*)(F.ws + WS_XB), (float*)(F.ws + WS_SSQX)};
        pg8::gemm_phase<EpiOut<true>, pg8::StaticOrder, true, true>(F.lds, g, S, E, fresh_tid(F)); }
}

__device__ __forceinline__ void p5_final(const Frame& F, ArgsP a) {
    const int lane0 = fresh_tid(F) & 63;
    const int gw = F.vcu * 8 + F.wave, NGW = F.G * 8; const f32x4* fw = (const f32x4*)a->in[I_FNW];
    for (int m = gw; m < MTOK; m += NGW) {
        const float s = wave_sum(((const float*)(F.ws + WS_SSQX))[(size_t)m * 64 + lane0]); const float rstd = __builtin_amdgcn_rsqf(s * (1.f / DM) + EPS);
        const u32x4* xr = (const u32x4*)((const bf16_t*)(F.ws + WS_XB) + (size_t)m * DM) + lane0; f32x4* orow = (f32x4*)(a->out + (size_t)m * DM);
#pragma unroll
        for (int j = 0; j < 8; ++j) { const u32x4 v = xr[64 * j]; const int c4 = (64 * j + lane0) * 2;
            const f32x4 w0 = fw[c4], w1 = fw[c4 + 1];
            orow[c4] = (f32x4){bf2f(v.x & 0xffffu), bf2f(v.x >> 16), bf2f(v.y & 0xffffu), bf2f(v.y >> 16)} * rstd * w0;
            orow[c4 + 1] = (f32x4){bf2f(v.z & 0xffffu), bf2f(v.z >> 16), bf2f(v.w & 0xffffu), bf2f(v.w >> 16)} * rstd * w1; }
    }
}


#define XB_TMO      128
#define XB_XCNT(j)  (256  + 64 * (j))
#define XB_XSUB(j)  (1280 + 64 * (j))
#define XB_XGEN(j)  (2304 + 64 * (j))
#define XB_TOP      3328
#define XB_TOPGEN   3392
#define XCD_BAR_WORDS 3456
#define XB_SPIN_CAP (1u << 18)
__device__ __forceinline__ unsigned xb_ld(unsigned* p)              { return __hip_atomic_load(p, __ATOMIC_RELAXED, __HIP_MEMORY_SCOPE_AGENT); }
__device__ __forceinline__ unsigned xb_add(unsigned* p, unsigned v) { return __hip_atomic_fetch_add(p, v, __ATOMIC_RELAXED, __HIP_MEMORY_SCOPE_AGENT); }
__device__ __forceinline__ unsigned xb_xcc_id() { return (unsigned)__builtin_amdgcn_s_getreg((3 << 11) | 20) & 0xFu; }
#define XB_SPIN(cond, bar) do { unsigned _sp = 0; while (cond) { __builtin_amdgcn_s_sleep(1); \
    if ((++_sp & 255u) == 0u) { if (xb_ld(&(bar)[XB_TMO])) break; if (_sp > XB_SPIN_CAP) { atomicAdd(&(bar)[XB_TMO], 1u); break; } } } } while (0)
struct XcdBarrier { unsigned* bar; unsigned x; volatile LAS unsigned* st; };
__device__ __forceinline__ XcdBarrier xcd_barrier_post(unsigned* bar, volatile LAS unsigned* st, bool leader) {
    XcdBarrier b; b.bar = bar; b.x = xb_xcc_id(); b.st = st;
    if (leader) (void)xb_add(&bar[XB_XCNT(b.x)], 1u);
    return b;
}
__device__ __forceinline__ void xcd_barrier_complete(unsigned* bar, unsigned x, unsigned& nloc, unsigned& nx) {
    const unsigned G = gridDim.x * gridDim.y * gridDim.z;
    unsigned sum, cnt, mine, sp = 0u;
    for (;;) {
        sum = 0u; cnt = 0u; mine = 0u;
#pragma unroll
        for (unsigned j = 0; j < 16; ++j) { const unsigned c = xb_ld(&bar[XB_XCNT(j)]); sum += c; cnt += (c > 0u) ? 1u : 0u; mine = (j == x) ? c : mine; }
        if (sum == G) break;
        __builtin_amdgcn_s_sleep(1);
        if ((++sp & 255u) == 0u) { if (xb_ld(&bar[XB_TMO])) break; if (sp > XB_SPIN_CAP) { atomicAdd(&bar[XB_TMO], 1u); break; } }
    }
    nloc = mine > 0u ? mine : 1u; nx = cnt > 0u ? cnt : 1u;
}
__device__ __forceinline__ void xcd_barrier(const XcdBarrier& b, bool leader) {
    asm volatile("s_waitcnt vmcnt(0)" ::: "memory");
    __syncthreads();
    if (leader) {
        unsigned* bar = b.bar;
        __builtin_amdgcn_s_waitcnt(0);
        unsigned nloc = b.st[0], nx = b.st[1];
        if (nloc == 0u) { xcd_barrier_complete(bar, b.x, nloc, nx); b.st[0] = nloc; b.st[1] = nx; }
        const unsigned old = xb_add(&bar[XB_XSUB(b.x)], 1u);
        const unsigned gen = old / nloc;
        if (old + 1u == (gen + 1u) * nloc) {
            __builtin_amdgcn_fence(__ATOMIC_RELEASE, "agent");
            asm volatile("s_waitcnt vmcnt(0)" ::: "memory");
            const unsigned og = xb_add(&bar[XB_TOP], 1u);
            const unsigned tg = og / nx;
            if (og + 1u == (tg + 1u) * nx) xb_add(&bar[XB_TOPGEN], 1u);
            else XB_SPIN(xb_ld(&bar[XB_TOPGEN]) == tg, bar);
            __builtin_amdgcn_fence(__ATOMIC_ACQUIRE, "agent");
            xb_add(&bar[XB_XGEN(b.x)], 1u);
            asm volatile("s_waitcnt vmcnt(0)" ::: "memory");
        } else {
            XB_SPIN(xb_ld(&bar[XB_XGEN(b.x)]) == gen, bar);
            __builtin_amdgcn_fence(__ATOMIC_ACQUIRE, "agent");
            asm volatile("s_waitcnt vmcnt(0)" ::: "memory");
        }
    }
    __syncthreads();
}

constexpr int NPH = 2 + 4 * DEPTH;
__global__ void __launch_bounds__(512, 2) mk_fwd(Args args) {
    extern __shared__ __attribute__((aligned(16))) unsigned char lds_raw[];
    Frame F; F.lds = (LAS unsigned char*)lds_raw; F.G = gridDim.x;
    volatile LAS unsigned* bst = (volatile LAS unsigned*)(F.lds + BAR_ST_OFF);
    if (threadIdx.x < 2) bst[threadIdx.x] = 0u;
    __syncthreads();
    const XcdBarrier gbar = xcd_barrier_post((unsigned*)(args.ws + WS_CTL), bst, threadIdx.x == 0);
    const int wave0 = __builtin_amdgcn_readfirstlane((int)threadIdx.x >> 6);
    for (int ph = args.ph_lo; ph < args.ph_hi; ++ph) {
        ArgsP ap = (ArgsP)__builtin_amdgcn_kernarg_segment_ptr(); asm volatile("" : "+s"(ap));
        { F.wave = wave0;
          int b_ = blockIdx.x; asm volatile("" : "+s"(b_)); F.bid = b_; F.vcu = (F.G % 8 == 0) ? (b_ % 8) * (F.G / 8) + b_ / 8 : b_;
          size_t z_ = 0; asm volatile("" : "+s"(z_)); F.ws = ap->ws + z_; }
#ifndef PHMASK
#define PHMASK 127
#endif
        if (ph == 0) { if (PHMASK & 1) p0_prologue(F, ap); }
        else if (ph == NPH - 1) { if (PHMASK & 32) p5_final(F, ap); }
        else { const int l = (ph - 1) >> 2, s = (ph - 1) & 3;
            if (s == 0) { if (PHMASK & 2) p1_inproj(F, l); }
            else if (s == 1) {
#if FAST_SSM
                if (PHMASK & 4) p2_ssm(F, ap, l);
#endif
#if FAST_RET
                if (PHMASK & 64) p2_ret(F);
#endif
            }
            else if (s == 2) { if (PHMASK & 8) p3_glu(F, ap, l); }
            else { if (PHMASK & 16) p4_out(F, ap, l); } }
#ifdef REPEAT_MASK
        __syncthreads();
        { const int s2 = (ph - 1) & 3, l2 = (ph - 1) >> 2;
          if (ph == 0) { if (REPEAT_MASK & 1) p0_prologue(F, ap); if (REPEAT_MASK >> 8) p0_prologue(F, ap, REPEAT_MASK >> 8); }
          else if (ph < NPH - 1) {
            if (s2 == 0 && (REPEAT_MASK & 2)) p1_inproj(F, l2);
            if (s2 == 1 && (REPEAT_MASK & 4)) p2_ssm(F, ap, l2);
            if (s2 == 1 && (REPEAT_MASK & 64)) p2_ret(F);
            if (s2 == 2 && (REPEAT_MASK & 8)) p3_glu(F, ap, l2);
            if (s2 == 3 && (REPEAT_MASK & 16)) p4_out(F, ap, l2); } }
#endif
        if (ph + 1 < args.ph_hi) xcd_barrier(gbar, fresh_tid(F) == 0);
    }
}

__global__ void __launch_bounds__(64) naive_ssm(Args args, int l) {
    const int b = blockIdx.x >> 7, g = blockIdx.x & 127, lg = l * NG + g, n = threadIdx.x;
    const double dt = (double)expf(args.in[I_LOGDT][lg]);
    const float lr = args.in[I_LRE][lg * 64 + n], li = args.in[I_LIM][lg * 64 + n];
    float ac, as; cis_d((double)li * dt, ac, as); const float mag = expf(lr * (float)dt); const float ar = mag * ac, ai = mag * as;
    const float nr = ar - 1.f, ni = ai, den = lr * lr + li * li, cor = (nr * lr + ni * li) / den, coi = (ni * lr - nr * li) / den;
    float bbr[16], bbi[16], cr[16], ci[16];
#pragma unroll
    for (int h = 0; h < 16; ++h) { const float br = args.in[I_BRE][(size_t)(lg * 64 + n) * 16 + h], bi = args.in[I_BIM][(size_t)(lg * 64 + n) * 16 + h];
        bbr[h] = cor * br - coi * bi; bbi[h] = cor * bi + coi * br; cr[h] = args.in[I_CRE][(size_t)(lg * 16 + h) * 64 + n]; ci[h] = args.in[I_CIM][(size_t)(lg * 16 + h) * 64 + n]; }
    const float dsk = args.in[I_D][(size_t)l * DS + g * 16 + (n & 15)];
    const bf16_t* a2g = (const bf16_t*)(args.ws + WS_A2U) + (size_t)g * 512 * A2LD; bf16_t* yg = (bf16_t*)(args.ws + WS_YG);
    float sr = 0.f, si = 0.f;
    for (int t = 0; t < SEQ; ++t) {
        const u32x4* up = (const u32x4*)(a2g + (size_t)(b * 128 + (t >> 4)) * A2LD + (t & 15) * 16); const u32x4 u0 = up[0], u1 = up[1];
        float uv[16];
        uv[0] = bf2f(u0.x & 0xffffu); uv[1] = bf2f(u0.x >> 16); uv[2] = bf2f(u0.y & 0xffffu); uv[3] = bf2f(u0.y >> 16); uv[4] = bf2f(u0.z & 0xffffu); uv[5] = bf2f(u0.z >> 16); uv[6] = bf2f(u0.w & 0xffffu); uv[7] = bf2f(u0.w >> 16);
        uv[8] = bf2f(u1.x & 0xffffu); uv[9] = bf2f(u1.x >> 16); uv[10] = bf2f(u1.y & 0xffffu); uv[11] = bf2f(u1.y >> 16); uv[12] = bf2f(u1.z & 0xffffu); uv[13] = bf2f(u1.z >> 16); uv[14] = bf2f(u1.w & 0xffffu); uv[15] = bf2f(u1.w >> 16);
        float bur = 0.f, bui = 0.f;
#pragma unroll
        for (int h = 0; h < 16; ++h) { bur += bbr[h] * uv[h]; bui += bbi[h] * uv[h]; }
        const float nsr = ar * sr - ai * si + bur, nsi = ar * si + ai * sr + bui; sr = nsr; si = nsi;
        float y = 0.f, um = 0.f;
#pragma unroll
        for (int h = 0; h < 16; ++h) { const float p = wave_sum(cr[h] * sr - ci[h] * si); if (n == h) { y = p; um = uv[h]; } }
        if (n < 16) yg[(size_t)(b * SEQ + t) * DS + g * 16 + n] = (bf16_t)f2bf(gelu_tanh_f(y + dsk * um));
    }
}

constexpr int NR_KLD = 264;
__global__ void __launch_bounds__(256) naive_ret(Args args, int l) {
    extern __shared__ __attribute__((aligned(16))) unsigned char sm[];
    bf16_t* Qs = (bf16_t*)sm;
    bf16_t* Ks = Qs + 32 * 256;
    float* Ss = (float*)(Ks + 64 * NR_KLD);
    float* red = Ss + 32 * 64;
    const int qt = blockIdx.x & 63, h = (blockIdx.x >> 6) & 7, b = blockIdx.x >> 9, tid = threadIdx.x, lane = tid & 63, wv = tid >> 6;
    const bf16_t* q = (const bf16_t*)(args.ws + WS_Q); const bf16_t* k = (const bf16_t*)(args.ws + WS_K); const bf16_t* vt = (const bf16_t*)(args.ws + WS_VT); const bf16_t* gr = (const bf16_t*)(args.ws + WS_GR);
    const int tok0 = b * SEQ + qt * 32;
    for (int e = tid; e < 32 * 32; e += 256) { const int r = e >> 5, c = (e & 31) * 8; *(u32x4*)(Qs + r * 256 + c) = *(const u32x4*)(q + (size_t)(tok0 + r) * DR + h * 256 + c); }
    const float lg2 = log2f(1.f - exp2f(-5.f - (float)h));
    float o[32];
#pragma unroll
    for (int r = 0; r < 32; ++r) o[r] = 0.f;
    const int ntile = qt / 2 + 1;
    for (int kt = 0; kt < ntile; ++kt) {
        __syncthreads();
        for (int e = tid; e < 64 * 32; e += 256) { const int r = e >> 5, c = (e & 31) * 8; *(u32x4*)(Ks + r * NR_KLD + c) = *(const u32x4*)(k + (size_t)(b * SEQ + kt * 64 + r) * DR + h * 256 + c); }
        __syncthreads();
        { const int key = lane, rg = wv; float acc[8];
#pragma unroll
          for (int r = 0; r < 8; ++r) acc[r] = 0.f;
          for (int d = 0; d < 256; d += 8) { const u32x4 kv = *(const u32x4*)(Ks + key * NR_KLD + d);
              const float k0 = bf2f(kv.x & 0xffffu), k1 = bf2f(kv.x >> 16), k2 = bf2f(kv.y & 0xffffu), k3 = bf2f(kv.y >> 16), k4 = bf2f(kv.z & 0xffffu), k5 = bf2f(kv.z >> 16), k6 = bf2f(kv.w & 0xffffu), k7 = bf2f(kv.w >> 16);
#pragma unroll
              for (int r = 0; r < 8; ++r) { const u32x4 qv = *(const u32x4*)(Qs + (rg * 8 + r) * 256 + d);
                  acc[r] += bf2f(qv.x & 0xffffu) * k0 + bf2f(qv.x >> 16) * k1 + bf2f(qv.y & 0xffffu) * k2 + bf2f(qv.y >> 16) * k3 + bf2f(qv.z & 0xffffu) * k4 + bf2f(qv.z >> 16) * k5 + bf2f(qv.w & 0xffffu) * k6 + bf2f(qv.w >> 16) * k7; } }
#pragma unroll
          for (int r = 0; r < 8; ++r) { const int i = qt * 32 + rg * 8 + r, j = kt * 64 + key; Ss[(rg * 8 + r) * 64 + key] = (i >= j) ? acc[r] * exp2f((float)(128 * ((i >> 7) - (j >> 7))) * lg2) : 0.f; } }
        __syncthreads();
        { const bf16_t* vr = vt + (size_t)(h * 256 + tid) * MTOK + b * SEQ + kt * 64;
          for (int kk = 0; kk < 64; kk += 8) { const u32x4 vv = *(const u32x4*)(vr + kk);
              const float v0 = bf2f(vv.x & 0xffffu), v1 = bf2f(vv.x >> 16), v2 = bf2f(vv.y & 0xffffu), v3 = bf2f(vv.y >> 16), v4 = bf2f(vv.z & 0xffffu), v5 = bf2f(vv.z >> 16), v6 = bf2f(vv.w & 0xffffu), v7 = bf2f(vv.w >> 16);
#pragma unroll
              for (int r = 0; r < 32; ++r) { const f32x4 s0 = *(const f32x4*)(Ss + r * 64 + kk), s1 = *(const f32x4*)(Ss + r * 64 + kk + 4);
                  o[r] += s0[0] * v0 + s0[1] * v1 + s0[2] * v2 + s0[3] * v3 + s1[0] * v4 + s1[1] * v5 + s1[2] * v6 + s1[3] * v7; } } }
    }
    __syncthreads();
#pragma unroll
    for (int r = 0; r < 32; ++r) { const float p = wave_sum(o[r] * o[r]); if (lane == 0) red[r * 4 + wv] = p; }
    __syncthreads();
    bf16_t* ycat = (bf16_t*)(args.ws + WS_YCAT);
#pragma unroll
    for (int r = 0; r < 32; ++r) { const float ss = (red[r * 4] + red[r * 4 + 1]) + (red[r * 4 + 2] + red[r * 4 + 3]); const float rstd = __builtin_amdgcn_rsqf(ss * (1.f / 256.f) + EPS);
        const size_t tok = (size_t)(tok0 + r); ycat[tok * DM + DS + h * 256 + tid] = (bf16_t)f2bf(o[r] * rstd * bf2f(gr[tok * DR + h * 256 + tid])); }
}

extern "C" void kernel_launch(void* const* d_in, const int* in_sizes, int n_in, void* d_out, int out_size, void* d_ws, size_t ws_size, hipStream_t stream) {
    static int grid = 0;
    if (grid == 0) {
        if (n_in != 17 || in_sizes[0] != MTOK * DM || out_size != MTOK * DM || ws_size < WS_END) { fprintf(stderr, "kernel_launch: unexpected problem (n_in %d, x %d, out %d, ws %zu)\n", n_in, n_in > 0 ? in_sizes[0] : -1, out_size, ws_size); grid = -1; return; }
        int dev = 0, cus = 0, per_cu = 0;
        hipGetDevice(&dev); hipDeviceGetAttribute(&cus, hipDeviceAttributeMultiprocessorCount, dev);
        if (hipFuncSetAttribute((const void*)mk_fwd, hipFuncAttributeMaxDynamicSharedMemorySize, LDS_BYTES) != hipSuccess) { fprintf(stderr, "kernel_launch: hipFuncSetAttribute failed\n"); grid = -1; return; }
        hipFuncSetAttribute((const void*)naive_ret, hipFuncAttributeMaxDynamicSharedMemorySize, 65536);
        hipOccupancyMaxActiveBlocksPerMultiprocessor(&per_cu, (const void*)mk_fwd, 512, LDS_BYTES);
        (void)hipGetLastError();
        if (per_cu < 1) fprintf(stderr, "kernel_launch: occupancy query says %d blocks per CU\n", per_cu);
        grid = cus;
        if (grid != 256) fprintf(stderr, "kernel_launch: %d CUs (phase balance assumes 256)\n", grid);
        for (int c = 0; c < grid; ++c) { pg8::StaticOrder S; Unit u0, u;
            S.init(MTOK, 10240, grid, c); S.next(0, u0); for (int i = 1; S.next(i, u); ++i) if (u.pm != u0.pm) { fprintf(stderr, "kernel_launch: in-proj unit order breaks the one-panel-per-workgroup assumption\n"); grid = -1; return; }
            S.init(DR, MTOK, grid, c); S.next(0, u0); for (int i = 1; S.next(i, u); ++i) if (u.pn != u0.pn) { fprintf(stderr, "kernel_launch: V^T unit order breaks the assumption\n"); grid = -1; return; }
            S.init(MTOK, DM, grid, c); S.next(0, u0); for (int i = 1; S.next(i, u); ++i) if (u.pm != u0.pm) { fprintf(stderr, "kernel_launch: out-proj unit order breaks the assumption\n"); grid = -1; return; } }
    }
    if (grid < 0) return;
    Args a{};
    for (int i = 0; i < 17; ++i) a.in[i] = (const float*)d_in[i];
    a.out = (float*)d_out; a.ws = (unsigned char*)d_ws;
    if (hipMemsetAsync((char*)d_ws + WS_CTL, 0, 16384, stream) != hipSuccess) { fprintf(stderr, "kernel_launch: hipMemsetAsync of the barrier words failed\n"); return; }
    auto launch = [&](int lo, int hi) { a.ph_lo = lo; a.ph_hi = hi;
        hipLaunchKernelGGL(mk_fwd, dim3(grid), dim3(512), LDS_BYTES, stream, a);
        const hipError_t e = hipPeekAtLastError();
        if (e != hipSuccess) fprintf(stderr, "kernel_launch: launch [%d,%d) failed: %s\n", lo, hi, hipGetErrorString(e)); };
#if FAST_SSM && FAST_RET && ONE_LAUNCH
    launch(0, NPH);
#else
    launch(0, 1);
    for (int l = 0; l < DEPTH; ++l) {
        launch(1 + 4 * l, 2 + 4 * l);
        launch(2 + 4 * l, 3 + 4 * l);
#if !FAST_SSM
        hipLaunchKernelGGL(naive_ssm, dim3(BATCH * NG), dim3(64), 0, stream, a, l);
#endif
#if !FAST_RET
        hipLaunchKernelGGL(naive_ret, dim3(BATCH * RH * 64), dim3(256), 32 * 256 * 2 + 64 * NR_KLD * 2 + 32 * 64 * 4 + 32 * 4 * 4, stream, a, l);
#endif
        launch(3 + 4 * l, 4 + 4 * l);
        launch(4 + 4 * l, 5 + 4 * l);
    }
    launch(NPH - 1, NPH);
#endif
}
```
